# Optimizing an MI355X kernel written in HIP

```python
import math
import jax, jax.numpy as jnp
from jax import lax
import numpy as np

D_MODEL = 1024
BATCH = 8
SEQ = 8192
DEPTH = 1

DSA_HEADS = D_MODEL // 128
DSA_HEAD_DIM = 64
DSA_LATENT = D_MODEL // 8
IDX_HEADS = 4
IDX_DIM = 32
TOPK_MAX = 256
DIFF_HEADS = D_MODEL // 256
DIFF_QK_DIM = 64
DIFF_V_DIM = 2 * DIFF_QK_DIM
DSA_OUT = DSA_HEADS * DSA_HEAD_DIM
DIFF_OUT = DIFF_HEADS * DIFF_V_DIM
MIX_WIDTH = DSA_OUT + DIFF_OUT
IN_SPLITS = (DSA_HEADS * DSA_HEAD_DIM,
             DSA_LATENT,
             IDX_HEADS * IDX_DIM,
             IDX_DIM,
             IDX_HEADS,
             DIFF_HEADS * 2 * DIFF_QK_DIM,
             DIFF_HEADS * 2 * DIFF_QK_DIM,
             DIFF_HEADS * DIFF_V_DIM)
IN_WIDTH = sum(IN_SPLITS)
Q_BLOCK = 128
N_GROUPS = 4
EXPERTS_PER_GROUP = 8
N_EXPERTS = N_GROUPS * EXPERTS_PER_GROUP
EXPERT_TOPK = 2
D_EXPERT = D_MODEL // 4
EPS = 1e-6

kernel_name = "hybrid_dsa_diffattn_hmoe_block"


def rms_norm(x, g):
    xf = x.astype(jnp.float32)
    y = xf * lax.rsqrt(jnp.mean(xf * xf, axis=-1, keepdims=True) + EPS)
    return (y * g.astype(jnp.float32)).astype(x.dtype)


def alibi_slopes(n):
    return jnp.asarray([2.0 ** (-8.0 * (i + 1) / n) for i in range(n)], dtype=jnp.float32)


def lambda_init(layer):
    return 0.8 - 0.6 * math.exp(-0.3 * layer)


def to_blocks(a):
    b, s = a.shape[:2]
    a = a.reshape((b, s // Q_BLOCK, Q_BLOCK) + a.shape[2:])
    return jnp.moveaxis(a, 1, 0)


def from_blocks(a):
    a = jnp.moveaxis(a, 0, 1)
    return a.reshape((a.shape[0], -1) + a.shape[3:])


def dsa_attention(q, c_kv, q_idx, k_idx, w_idx, w_uk, w_uv, slopes):
    L = q.shape[1]
    n_blocks = L // Q_BLOCK
    topk = min(TOPK_MAX, L // 4)
    key_pos = jnp.arange(L)
    q_abs = jnp.einsum('bshd,hcd->bshc', q, w_uk)
    scale = DSA_HEAD_DIM ** -0.5
    idx_scale = IDX_DIM ** -0.5

    def block(args):
        blk, qa, qi, wi = args
        q_pos = blk * Q_BLOCK + jnp.arange(Q_BLOCK)
        causal = key_pos[None, :] <= q_pos[:, None]
        rel = jax.nn.relu(jnp.einsum('bqhd,bsd->bqhs', qi, k_idx) * idx_scale)
        score = jnp.einsum('bqhs,bqh->bqs', rel, wi)
        score = jnp.where(causal[None], score, -jnp.inf)
        _, sel = lax.top_k(score, topk)
        kv_sel = jax.vmap(lambda ck, i: ck[i])(c_kv, sel)
        s = jnp.einsum('bqhc,bqkc->bqhk', qa, kv_sel).astype(jnp.float32) * scale
        dist = (q_pos[None, :, None] - sel).astype(jnp.float32)
        s = s - slopes[None, None, :, None] * dist[:, :, None, :]
        s = jnp.where((dist >= 0)[:, :, None, :], s, -jnp.inf)
        p = jax.nn.softmax(s, axis=-1).astype(kv_sel.dtype)
        o_lat = jnp.einsum('bqhk,bqkc->bqhc', p, kv_sel)
        return jnp.einsum('bqhc,hcd->bqhd', o_lat, w_uv)

    out = lax.map(block, (jnp.arange(n_blocks), to_blocks(q_abs), to_blocks(q_idx), to_blocks(w_idx)))
    return from_blocks(out)


def diff_attention(q, k, v, lam, lam_init, sub_g, slopes):
    L = q.shape[1]
    n_blocks = L // Q_BLOCK
    key_pos = jnp.arange(L)
    scale = DIFF_QK_DIM ** -0.5

    def block(args):
        blk, qb = args
        q_pos = blk * Q_BLOCK + jnp.arange(Q_BLOCK)
        dist = (q_pos[:, None] - key_pos[None, :]).astype(jnp.float32)
        s = jnp.einsum('bqhmd,bshmd->bhmqs', qb, k).astype(jnp.float32) * scale
        s = s - slopes[None, :, None, None, None] * dist
        s = jnp.where(dist >= 0, s, -jnp.inf)
        p = jax.nn.softmax(s, axis=-1)
        a = p[:, :, 0] - lam * p[:, :, 1]
        return jnp.einsum('bhqs,bshe->bqhe', a.astype(v.dtype), v)

    o = from_blocks(lax.map(block, (jnp.arange(n_blocks), to_blocks(q))))
    return rms_norm(o, sub_g) * (1.0 - lam_init)


def hier_moe(h, w_group, b_group, w_router, b_router, w_gate, w_up, w_down):
    T = h.shape[0]
    g_logits = jnp.dot(h, w_group).astype(jnp.float32) + b_group.astype(jnp.float32)
    g_prob = jax.nn.softmax(g_logits, axis=-1)
    g_sel = jnp.argmax(g_logits, axis=-1)
    p_g = jnp.take_along_axis(g_prob, g_sel[:, None], axis=-1)
    e_logits = (jnp.dot(h, w_router).astype(jnp.float32) + b_router.astype(jnp.float32))
    e_logits = e_logits.reshape(T, N_GROUPS, EXPERTS_PER_GROUP)
    e_logits = jnp.take_along_axis(e_logits, g_sel[:, None, None], axis=1)[:, 0]
    top_v, top_i = lax.top_k(e_logits, EXPERT_TOPK)
    top_w = jax.nn.softmax(top_v, axis=-1) * p_g
    eid = g_sel[:, None] * EXPERTS_PER_GROUP + top_i
    gates = jnp.sum(jax.nn.one_hot(eid, N_EXPERTS, dtype=jnp.float32) * top_w[..., None], axis=1)
    gates = gates.astype(h.dtype)
    y = jnp.zeros_like(h)
    for e in range(N_EXPERTS):
        hid = jax.nn.silu(jnp.dot(h, w_gate[e])) * jnp.dot(h, w_up[e])
        y = y + gates[:, e:e + 1] * jnp.dot(hid, w_down[e])
    return y


def setup_inputs(seed: int = 0) -> dict:
    key = jax.random.key(seed)
    ks = jax.random.split(key, 26)
    f32 = jnp.float32
    D = D_MODEL

    def nrm(k, shape, std):
        return jax.random.normal(k, shape, f32) * std

    def gain(k, shape):
        return 1.0 + 0.05 * jax.random.normal(k, shape, f32)

    return {
        "x": nrm(ks[0], (BATCH, SEQ, D), 1.0),
        "c": nrm(ks[1], (BATCH, D), 1.0),
        "w_ada": nrm(ks[2], (DEPTH, D, 6 * D), 0.5 * D ** -0.5),
        "b_ada": nrm(ks[3], (DEPTH, 6 * D), 0.02),
        "g_attn": gain(ks[4], (DEPTH, D)),
        "w_in": nrm(ks[5], (DEPTH, D, IN_WIDTH), D ** -0.5),
        "g_kv": gain(ks[6], (DEPTH, DSA_LATENT)),
        "w_uk": nrm(ks[7], (DEPTH, DSA_HEADS, DSA_LATENT, DSA_HEAD_DIM), DSA_LATENT ** -0.5),
        "w_uv": nrm(ks[8], (DEPTH, DSA_HEADS, DSA_LATENT, DSA_HEAD_DIM), DSA_LATENT ** -0.5),
        "lam_q1": nrm(ks[9], (DEPTH, DIFF_QK_DIM), 0.1),
        "lam_k1": nrm(ks[10], (DEPTH, DIFF_QK_DIM), 0.1),
        "lam_q2": nrm(ks[11], (DEPTH, DIFF_QK_DIM), 0.1),
        "lam_k2": nrm(ks[12], (DEPTH, DIFF_QK_DIM), 0.1),
        "g_sub": gain(ks[13], (DEPTH, DIFF_V_DIM)),
        "w_out": nrm(ks[14], (DEPTH, MIX_WIDTH, D), MIX_WIDTH ** -0.5),
        "g_moe": gain(ks[15], (DEPTH, D)),
        "w_group": nrm(ks[16], (DEPTH, D, N_GROUPS), D ** -0.5),
        "b_group": nrm(ks[17], (DEPTH, N_GROUPS), 0.01),
        "w_router": nrm(ks[18], (DEPTH, D, N_EXPERTS), D ** -0.5),
        "b_router": nrm(ks[19], (DEPTH, N_EXPERTS), 0.01),
        "w_gate": nrm(ks[20], (DEPTH, N_EXPERTS, D, D_EXPERT), D ** -0.5),
        "w_up": nrm(ks[21], (DEPTH, N_EXPERTS, D, D_EXPERT), D ** -0.5),
        "w_down": nrm(ks[22], (DEPTH, N_EXPERTS, D_EXPERT, D), D_EXPERT ** -0.5),
        "g_final": gain(ks[23], (D,)),
    }


def reference(x, c, w_ada, b_ada, g_attn, w_in, g_kv, w_uk, w_uv, lam_q1, lam_k1, lam_q2, lam_k2,
              g_sub, w_out, g_moe, w_group, b_group, w_router, b_router, w_gate, w_up, w_down, g_final):
    B, S, D = x.shape
    dsa_slopes = alibi_slopes(DSA_HEADS)
    diff_slopes = alibi_slopes(DIFF_HEADS)
    split_pts = list(np.cumsum(IN_SPLITS)[:-1])
    c_act = jax.nn.silu(c)
    for l in range(DEPTH):
        mod = jnp.dot(c_act, w_ada[l]) + b_ada[l]
        shift_a, scale_a, gate_a, shift_m, scale_m, gate_m = jnp.split(mod, 6, axis=-1)

        h = rms_norm(x, g_attn[l]) * (1.0 + scale_a[:, None]) + shift_a[:, None]
        proj = jnp.dot(h, w_in[l])
        dq, dlat, iq, ik, iw, fq, fk, fv = jnp.split(proj, split_pts, axis=-1)
        dq = dq.reshape(B, S, DSA_HEADS, DSA_HEAD_DIM)
        dlat = rms_norm(dlat, g_kv[l])
        iq = iq.reshape(B, S, IDX_HEADS, IDX_DIM)
        iw = iw * (IDX_HEADS ** -0.5)
        fq = fq.reshape(B, S, DIFF_HEADS, 2, DIFF_QK_DIM)
        fk = fk.reshape(B, S, DIFF_HEADS, 2, DIFF_QK_DIM)
        fv = fv.reshape(B, S, DIFF_HEADS, DIFF_V_DIM)

        o_dsa = dsa_attention(dq, dlat, iq, ik, iw, w_uk[l], w_uv[l], dsa_slopes)
        lam0 = lambda_init(l)
        lam = (jnp.exp(jnp.sum(lam_q1[l].astype(jnp.float32) * lam_k1[l].astype(jnp.float32)))
               - jnp.exp(jnp.sum(lam_q2[l].astype(jnp.float32) * lam_k2[l].astype(jnp.float32)))
               + lam0)
        o_diff = diff_attention(fq, fk, fv, lam, lam0, g_sub[l], diff_slopes)
        o = jnp.concatenate([o_dsa.reshape(B, S, DSA_OUT), o_diff.reshape(B, S, DIFF_OUT)], axis=-1)
        x = x + gate_a[:, None] * jnp.dot(o, w_out[l])

        h = rms_norm(x, g_moe[l]) * (1.0 + scale_m[:, None]) + shift_m[:, None]
        y = hier_moe(h.reshape(B * S, D), w_group[l], b_group[l], w_router[l], b_router[l],
                     w_gate[l], w_up[l], w_down[l]).reshape(B, S, D)
        x = x + gate_m[:, None] * y
    return rms_norm(x, g_final)
```

```cpp
#include <hip/hip_runtime.h>
#include <cstdio>
#include <cstdint>

#define LAS __attribute__((address_space(3)))
#define GAS __attribute__((address_space(1)))
typedef unsigned short bf16_t;
typedef short bf16x8 __attribute__((ext_vector_type(8)));
typedef short s16x4 __attribute__((ext_vector_type(4)));
typedef float f32x2 __attribute__((ext_vector_type(2)));
typedef float f32x4 __attribute__((ext_vector_type(4)));
typedef float f32x16 __attribute__((ext_vector_type(16)));
typedef unsigned u32x2 __attribute__((ext_vector_type(2)));
typedef unsigned u32x4 __attribute__((ext_vector_type(4)));
typedef __bf16 bf16x2_t __attribute__((ext_vector_type(2)));

#ifndef MK_SPLIT
#define MK_SPLIT 0
#endif

constexpr int NB = 8, SEQ = 8192, NT = NB * SEQ, DM = 1024;
constexpr int NPROJ = 2560;
constexpr int NEXP = 32, DEXP = 256;
constexpr int PMAX = 2 * NT + NEXP * 256;
constexpr float LOG2E = 1.4426950408889634f;
constexpr float RMS_EPS = 1e-6f;
constexpr float DIFF_C2 = 0.125f * LOG2E;
constexpr float IW_SCALE = 0.5f * 0.17677669529663687f;
constexpr int NWAVES = 8, NTHREADS = 512;

constexpr size_t MiB = 1u << 20;
constexpr size_t WS_CTL = 0, CTL_ZERO_BYTES = 1 * MiB;
constexpr size_t WS_MOD = 1 * MiB;
constexpr size_t WS_WIN = 2 * MiB;
constexpr size_t WS_WOUT = 8 * MiB;
constexpr size_t WS_WRT = 10 * MiB;
constexpr size_t WS_WUK = 11 * MiB;
constexpr size_t WS_WUVT = 11 * MiB + 512 * 1024;
constexpr size_t WS_WUP = 12 * MiB;
constexpr size_t WS_WDN = 44 * MiB;
constexpr size_t WS_XN = 64 * MiB;
constexpr size_t WS_DQ = 192 * MiB, WS_FQ = 256 * MiB, WS_FK = 320 * MiB, WS_FV = 384 * MiB;
constexpr size_t WS_YS = 192 * MiB;
constexpr size_t WS_O = 464 * MiB;
constexpr size_t WS_DLAT = 592 * MiB;
constexpr size_t WS_CKV = 608 * MiB;
constexpr size_t WS_IQ = 624 * MiB;
constexpr size_t WS_IK = 640 * MiB;
constexpr size_t WS_IW = 644 * MiB;
constexpr size_t WS_LOG = 646 * MiB;
constexpr size_t WS_REID = 662 * MiB;
constexpr size_t WS_RSLOT = 663 * MiB;
constexpr size_t WS_TOK = 664 * MiB;
constexpr size_t WS_GL = 672 * MiB;
constexpr size_t WS_HS = 680 * MiB;
constexpr size_t WS_END = 752 * MiB;
static_assert(WS_YS + (size_t)PMAX * 2048 <= WS_O && WS_HS + (size_t)PMAX * 512 <= WS_END, "d_ws map");
constexpr int CW_BAR = 4096;
constexpr int CW_ECNT = 16384;

constexpr int LDS_BYTES = 155648;
constexpr int MISC_OFF = LDS_BYTES - 512;

__device__ __forceinline__ unsigned f2bf(float f) { unsigned u = __builtin_bit_cast(unsigned, f); return (u + 0x7fffu + ((u >> 16) & 1u)) >> 16; }
__device__ __forceinline__ unsigned pk2(float lo, float hi) { f32x2 v = {lo, hi}; bf16x2_t b = __builtin_convertvector(v, bf16x2_t); return __builtin_bit_cast(unsigned, b); }
__device__ __forceinline__ float bf2f(unsigned short h) { return __builtin_bit_cast(float, (unsigned)h << 16); }
__device__ __forceinline__ float bflo(unsigned w) { return __builtin_bit_cast(float, w << 16); }
__device__ __forceinline__ float bfhi(unsigned w) { return __builtin_bit_cast(float, w & 0xffff0000u); }
__device__ __forceinline__ int crow(int r, int hi) { return (r & 3) + 8 * (r >> 2) + 4 * hi; }
__device__ __forceinline__ unsigned off_b(unsigned row, unsigned ch) { return 256u * row + 16u * (ch ^ (((row & 3u) << 2) | ((row >> 2) & 3u))); }
__device__ __forceinline__ float wave_sum(float v) {
#pragma unroll
    for (int o = 1; o < 64; o <<= 1) v += __shfl_xor(v, o);
    return v;
}
#define LDS_WAIT() asm volatile("s_waitcnt lgkmcnt(0)" ::: "memory")
#define VM_WAIT() asm volatile("s_waitcnt vmcnt(0)" ::: "memory")
#define MFMA32(a, b, c) __builtin_amdgcn_mfma_f32_32x32x16_bf16((a), (b), (c), 0, 0, 0)
#define MFMA16(a, b, c) __builtin_amdgcn_mfma_f32_16x16x32_bf16((a), (b), (c), 0, 0, 0)
__device__ __forceinline__ s16x4 tr_read(LAS const char* p) { return __builtin_bit_cast(s16x4, __builtin_amdgcn_ds_read_tr16_b64_v4i16((LAS s16x4*)p)); }
__device__ __forceinline__ bf16x8 cat8(s16x4 a, s16x4 b) { return (bf16x8){a[0], a[1], a[2], a[3], b[0], b[1], b[2], b[3]}; }

namespace pg8 {
constexpr int BM = 256, BK = 64, HALF = 128, HTB = HALF * BK * 2, STAGE_BYTES = 8 * HTB, NXCD = 8, WGM = 8;
__device__ __forceinline__ int lds_byte(int r, int c) { const int st = (r >> 4) * 2 + (c >> 5), rr = r & 15, cc = c & 31, ob = rr * 64 + cc * 2; return st * 1024 + (ob ^ (((ob >> 9) & 1) << 5)); }
__device__ __forceinline__ void stage_rc(int b, int& R, int& C) { const int st = b / 1024, sb = b % 1024, swz = sb ^ (((sb >> 9) & 1) << 5); R = (st >> 1) * 16 + swz / 64; C = (st & 1) * 32 + (swz % 64) / 2; }
__device__ __forceinline__ int perm32(int rho) { const int n = rho >> 4, i = rho & 15; return 8 * (i >> 2) + 4 * n + (i & 3); }

struct Unit { int pm, pn, a0, a1; };

struct StaticOrder {
    int nM, nN, nwg, G, c, K;
    __device__ void init(int M, int N, int K_, int G_, int c_) { nM = M / BM; nN = N / BM; nwg = nM * nN; G = G_; c = c_; K = K_; }
    __device__ bool next(int i, Unit& u) const {
        const long L = (long)i * G + c; if (L >= nwg) return false;
        int wgid = (int)L; { const int q = nwg / NXCD, r = nwg % NXCD, xcd = wgid % NXCD, off = wgid / NXCD; wgid = (xcd < r ? xcd * (q + 1) : r * (q + 1) + (xcd - r) * q) + off; }
        const int nig = WGM * nN, gid = wgid / nig, fm = gid * WGM, gsz = (nM - fm) < WGM ? (nM - fm) : WGM;
        u.pm = fm + ((wgid % nig) % gsz); u.pn = (wgid % nig) / gsz; u.a0 = 0; u.a1 = 0; return true;
    }
    __device__ __forceinline__ unsigned a_off(const Unit& u, int R) const { return (unsigned)(u.pm * BM + R) * (unsigned)(K * 2); }
};

template <class Epi, class Sched, bool ALIGN_EPI>
__device__ __forceinline__ void gemm_phase(LAS unsigned char* lds, const bf16_t* Ap, const bf16_t* Btp, const int K, const Sched& S, const Epi& E) {
    const int tid = threadIdx.x, wid = __builtin_amdgcn_readfirstlane(tid >> 6), lane = tid & 63, wr = wid >> 2, wc = wid & 3, fr = lane & 15, fq = lane >> 4;
    const int nt = K / BK;
    int RA[2], CA[2]; unsigned voffB[2];
#pragma unroll
    for (int i = 0; i < 2; ++i) { int R, C; stage_rc(tid * 16 + i * 8192, R, C); const int Rb = Epi::PERM ? ((R & ~31) + perm32(R & 31)) : R;
        RA[i] = R; CA[i] = C * 2; voffB[i] = (unsigned)(Rb * K + C) * 2u; }
    const size_t kstep = (size_t)(BK * 2);
    const size_t hstep = (size_t)HALF * K * 2;
    const size_t tstep = 2 * hstep;
    const unsigned ldsw = (unsigned)wid * 1024u;
    const int aoff = lds_byte(wr * 64 + fr, fq * 8), boff = lds_byte(wc * 32 + fr, fq * 8);
#define PG8_SA(b, h) (((b) * 2 + (h)) * HTB)
#define PG8_SB(b, h) ((4 + (b) * 2 + (h)) * HTB)
#define PG8_STAGE_B(bufoff, gbase) do { _Pragma("unroll") for (int _i = 0; _i < 2; ++_i) \
        __builtin_amdgcn_global_load_lds((const unsigned*)((const char*)(gbase) + voffB[_i]), (LAS unsigned*)(lds + (bufoff) + ldsw + _i * 8192), 16, 0, 0); } while (0)
#define PG8_STAGE_A(bufoff, offs, h, kb) do { _Pragma("unroll") for (int _i = 0; _i < 2; ++_i) \
        __builtin_amdgcn_global_load_lds((const unsigned*)((const char*)Ap + (size_t)(offs)[h][_i] + (size_t)(kb)), (LAS unsigned*)(lds + (bufoff) + ldsw + _i * 8192), 16, 0, 0); } while (0)
#define PG8_LDA(dst, b, h) do { _Pragma("unroll") for (int m = 0; m < 4; ++m) _Pragma("unroll") for (int k = 0; k < 2; ++k) dst[m][k] = *(const LAS bf16x8*)(lds + PG8_SA(b, h) + aoff + m * 2048 + k * 1024); } while (0)
#define PG8_LDB(dst, b, h) do { _Pragma("unroll") for (int n = 0; n < 2; ++n) _Pragma("unroll") for (int k = 0; k < 2; ++k) dst[n][k] = *(const LAS bf16x8*)(lds + PG8_SB(b, h) + boff + n * 2048 + k * 1024); } while (0)
#define PG8_MMA(ai, bj, At, Bt) do { __builtin_amdgcn_s_setprio(1); _Pragma("unroll") for (int m = 0; m < 4; ++m) _Pragma("unroll") for (int n = 0; n < 2; ++n) _Pragma("unroll") for (int k = 0; k < 2; ++k) \
        acc[ai][bj][m][n] = __builtin_amdgcn_mfma_f32_16x16x32_bf16(Bt[n][k], At[m][k], acc[ai][bj][m][n], 0, 0, 0); __builtin_amdgcn_s_setprio(0); } while (0)
#define PG8_WAIT_V(n) asm volatile("s_waitcnt vmcnt(" #n ")" ::: "memory")
#define PG8_WAIT_L(n) asm volatile("s_waitcnt lgkmcnt(" #n ")" ::: "memory")
#define PG8_BAR __builtin_amdgcn_s_barrier()
#define PG8_SCHED __builtin_amdgcn_sched_barrier(0)
#define PG8_OFFS(dst, u) do { _Pragma("unroll") for (int _h = 0; _h < 2; ++_h) _Pragma("unroll") for (int _i = 0; _i < 2; ++_i) dst[_h][_i] = S.a_off(u, _h * HALF + RA[_i]) + (unsigned)CA[_i]; } while (0)
    Unit cur, nxt; int ui = 0;
    if (!S.next(0, cur)) return;
    f32x4 acc[2][2][4][2];
#pragma unroll
    for (int a = 0; a < 2; ++a)
#pragma unroll
        for (int b = 0; b < 2; ++b)
#pragma unroll
            for (int m = 0; m < 4; ++m)
#pragma unroll
                for (int n = 0; n < 2; ++n) acc[a][b][m][n] = (f32x4){0.f, 0.f, 0.f, 0.f};
    bf16x8 At[4][2], B0[2][2], B1[2][2];
    unsigned offc[2][2], offn[2][2];
    PG8_OFFS(offc, cur);
    const char* cB = (const char*)Btp + (size_t)cur.pn * tstep;
    PG8_STAGE_B(PG8_SB(0, 0), cB); PG8_STAGE_B(PG8_SB(0, 1), cB + hstep); PG8_STAGE_A(PG8_SA(0, 0), offc, 0, 0); PG8_STAGE_A(PG8_SA(0, 1), offc, 1, 0);
    if (wr == 1) PG8_BAR;
    PG8_WAIT_V(2); PG8_BAR;
    PG8_STAGE_B(PG8_SB(1, 0), cB + kstep); PG8_STAGE_A(PG8_SA(1, 0), offc, 0, kstep); PG8_STAGE_B(PG8_SB(1, 1), cB + hstep + kstep);
    PG8_WAIT_V(6); PG8_BAR;
    for (;;) {
        const bool has_next = S.next(ui + 1, nxt);
        if (has_next) { PG8_OFFS(offn, nxt); }
        else {
#pragma unroll
            for (int _h = 0; _h < 2; ++_h)
#pragma unroll
                for (int _i = 0; _i < 2; ++_i) offn[_h][_i] = offc[_h][_i];
        }
        const char* nB = has_next ? (const char*)Btp + (size_t)nxt.pn * tstep : cB;
#pragma unroll 1
        for (int t = 0; t < nt; t += 2) {
            const bool last = (t == nt - 2);
            const size_t k1 = (size_t)(t + 1) * kstep;
            const size_t k2 = last ? 0 : (size_t)(t + 2) * kstep, k3 = k2 + kstep;
            unsigned o2[2][2];
#pragma unroll
            for (int _h = 0; _h < 2; ++_h)
#pragma unroll
                for (int _i = 0; _i < 2; ++_i) o2[_h][_i] = last ? offn[_h][_i] : offc[_h][_i];
            const char* b2 = last ? nB : cB + (size_t)(t + 2) * kstep; const char* b3 = b2 + kstep;
            PG8_LDB(B0, 0, 0); PG8_LDB(B1, 0, 1); PG8_SCHED; PG8_LDA(At, 0, 0); PG8_STAGE_A(PG8_SA(1, 1), offc, 1, k1);
            PG8_WAIT_V(8); PG8_WAIT_L(0); PG8_BAR; PG8_MMA(0, 0, At, B0); PG8_MMA(0, 1, At, B1); PG8_BAR; PG8_SCHED;
            PG8_LDA(At, 0, 1); PG8_STAGE_B(PG8_SB(0, 0), b2); PG8_STAGE_B(PG8_SB(0, 1), b2 + hstep); PG8_STAGE_A(PG8_SA(0, 0), o2, 0, k2);
            PG8_WAIT_V(8); PG8_WAIT_L(0); PG8_BAR; PG8_MMA(1, 0, At, B0); PG8_MMA(1, 1, At, B1); PG8_BAR; PG8_SCHED;
            PG8_LDB(B0, 1, 0); PG8_LDB(B1, 1, 1); PG8_SCHED; PG8_LDA(At, 1, 0); PG8_STAGE_A(PG8_SA(0, 1), o2, 1, k2);
            PG8_WAIT_V(8); PG8_WAIT_L(0); PG8_BAR; PG8_MMA(0, 0, At, B0); PG8_MMA(0, 1, At, B1); PG8_BAR; PG8_SCHED;
            PG8_LDA(At, 1, 1); PG8_STAGE_B(PG8_SB(1, 0), b3); PG8_STAGE_B(PG8_SB(1, 1), b3 + hstep); PG8_STAGE_A(PG8_SA(1, 0), o2, 0, k3);
            PG8_WAIT_V(8); PG8_WAIT_L(0); PG8_BAR; PG8_MMA(1, 0, At, B0); PG8_MMA(1, 1, At, B1); PG8_BAR; PG8_SCHED;
        }
        if constexpr (ALIGN_EPI) { if (wr == 0) PG8_BAR; }
        E(acc, cur, wr, wc, fr, fq);
        if (!has_next) break;
#pragma unroll
        for (int a = 0; a < 2; ++a)
#pragma unroll
            for (int b = 0; b < 2; ++b)
#pragma unroll
                for (int m = 0; m < 4; ++m)
#pragma unroll
                    for (int n = 0; n < 2; ++n) acc[a][b][m][n] = (f32x4){0.f, 0.f, 0.f, 0.f};
        cur = nxt; cB = nB; ++ui;
#pragma unroll
        for (int _h = 0; _h < 2; ++_h)
#pragma unroll
            for (int _i = 0; _i < 2; ++_i) offc[_h][_i] = offn[_h][_i];
        if constexpr (ALIGN_EPI) { if (wr == 1) PG8_BAR; }
    }
    PG8_WAIT_V(0);
    if constexpr (!ALIGN_EPI) { if (wr == 0) PG8_BAR; }
    PG8_BAR;
#undef PG8_SA
#undef PG8_SB
#undef PG8_STAGE_A
#undef PG8_STAGE_B
#undef PG8_LDA
#undef PG8_LDB
#undef PG8_MMA
#undef PG8_WAIT_V
#undef PG8_WAIT_L
#undef PG8_BAR
#undef PG8_SCHED
#undef PG8_OFFS
}
}

#define XB_TMO      128
#define XB_XCNT(j)  (256  + 64 * (j))
#define XB_XSUB(j)  (1280 + 64 * (j))
#define XB_XGEN(j)  (2304 + 64 * (j))
#define XB_TOP      3328
#define XB_TOPGEN   3392
#define XCD_BAR_WORDS 3456
#define XB_SPIN_CAP (1u << 18)
__device__ __forceinline__ unsigned xb_ld(unsigned* p)              { return __hip_atomic_load(p, __ATOMIC_RELAXED, __HIP_MEMORY_SCOPE_AGENT); }
__device__ __forceinline__ unsigned xb_add(unsigned* p, unsigned v) { return __hip_atomic_fetch_add(p, v, __ATOMIC_RELAXED, __HIP_MEMORY_SCOPE_AGENT); }
__device__ __forceinline__ unsigned xb_xcc_id() { return (unsigned)__builtin_amdgcn_s_getreg((3 << 11) | 20) & 0xFu; }
#define XB_SPIN(cond, bar) do { unsigned _sp = 0; while (cond) { __builtin_amdgcn_s_sleep(1); \
    if ((++_sp & 255u) == 0u) { if (xb_ld(&(bar)[XB_TMO])) break; if (_sp > XB_SPIN_CAP) { atomicAdd(&(bar)[XB_TMO], 1u); break; } } } } while (0)
struct XcdBarrier { unsigned* bar; unsigned x; volatile LAS unsigned* st; };
__device__ __forceinline__ XcdBarrier xcd_barrier_post(unsigned* bar, volatile LAS unsigned* st) {
    XcdBarrier b; b.bar = bar; b.x = xb_xcc_id(); b.st = st;
    if (threadIdx.x == 0) (void)xb_add(&bar[XB_XCNT(b.x)], 1u);
    return b;
}
__device__ __forceinline__ void xcd_barrier_complete(unsigned* bar, unsigned x, unsigned& nloc, unsigned& nx) {
    const unsigned G = gridDim.x * gridDim.y * gridDim.z;
    unsigned sum, cnt, mine, sp = 0u;
    for (;;) {
        sum = 0u; cnt = 0u; mine = 0u;
#pragma unroll
        for (unsigned j = 0; j < 16; ++j) { const unsigned c = xb_ld(&bar[XB_XCNT(j)]); sum += c; cnt += (c > 0u) ? 1u : 0u; mine = (j == x) ? c : mine; }
        if (sum == G) break;
        __builtin_amdgcn_s_sleep(1);
        if ((++sp & 255u) == 0u) { if (xb_ld(&bar[XB_TMO])) break; if (sp > XB_SPIN_CAP) { atomicAdd(&bar[XB_TMO], 1u); break; } }
    }
    nloc = mine > 0u ? mine : 1u; nx = cnt > 0u ? cnt : 1u;
}
__device__ __forceinline__ void xcd_barrier(const XcdBarrier& b) {
    asm volatile("s_waitcnt vmcnt(0)" ::: "memory");
    __syncthreads();
    if (threadIdx.x == 0) {
        unsigned* bar = b.bar;
        __builtin_amdgcn_s_waitcnt(0);
        unsigned nloc = b.st[0], nx = b.st[1];
        if (nloc == 0u) { xcd_barrier_complete(bar, b.x, nloc, nx); b.st[0] = nloc; b.st[1] = nx; }
        const unsigned old = xb_add(&bar[XB_XSUB(b.x)], 1u);
        const unsigned gen = old / nloc;
        if (old + 1u == (gen + 1u) * nloc) {
            __builtin_amdgcn_fence(__ATOMIC_RELEASE, "agent");
            asm volatile("s_waitcnt vmcnt(0)" ::: "memory");
            const unsigned og = xb_add(&bar[XB_TOP], 1u);
            const unsigned tg = og / nx;
            if (og + 1u == (tg + 1u) * nx) xb_add(&bar[XB_TOPGEN], 1u);
            else XB_SPIN(xb_ld(&bar[XB_TOPGEN]) == tg, bar);
            __builtin_amdgcn_fence(__ATOMIC_ACQUIRE, "agent");
            xb_add(&bar[XB_XGEN(b.x)], 1u);
            asm volatile("s_waitcnt vmcnt(0)" ::: "memory");
        } else {
            XB_SPIN(xb_ld(&bar[XB_XGEN(b.x)]) == gen, bar);
            __builtin_amdgcn_fence(__ATOMIC_ACQUIRE, "agent");
            asm volatile("s_waitcnt vmcnt(0)" ::: "memory");
        }
    }
    __syncthreads();
}

struct Args { const float* in[24]; float* out; unsigned char* ws; int ph_lo, ph_hi; };
struct Frame {
    LAS unsigned char* lds;
    volatile LAS unsigned* MISC;
    const Args* a;
    unsigned char* ws;
    unsigned* ctl;
    int tid, lane, wave, vcu, G;
};
#define FIN(i) (F.a->in[i])
#define F_x FIN(0)
#define F_c FIN(1)
#define F_w_ada FIN(2)
#define F_b_ada FIN(3)
#define F_g_attn FIN(4)
#define F_w_in FIN(5)
#define F_g_kv FIN(6)
#define F_w_uk FIN(7)
#define F_w_uv FIN(8)
#define F_lq1 FIN(9)
#define F_lk1 FIN(10)
#define F_lq2 FIN(11)
#define F_lk2 FIN(12)
#define F_g_sub FIN(13)
#define F_w_out FIN(14)
#define F_g_moe FIN(15)
#define F_w_group FIN(16)
#define F_b_group FIN(17)
#define F_w_router FIN(18)
#define F_b_router FIN(19)
#define F_w_gate FIN(20)
#define F_w_up FIN(21)
#define F_w_down FIN(22)
#define F_g_final FIN(23)
#define F_out (F.a->out)
#define F_mod ((float*)(F.ws + WS_MOD))
#define F_Win ((bf16_t*)(F.ws + WS_WIN))
#define F_Wout ((bf16_t*)(F.ws + WS_WOUT))
#define F_Wrt ((bf16_t*)(F.ws + WS_WRT))
#define F_Wuk ((bf16_t*)(F.ws + WS_WUK))
#define F_WuvT ((bf16_t*)(F.ws + WS_WUVT))
#define F_Wup ((bf16_t*)(F.ws + WS_WUP))
#define F_Wdn ((bf16_t*)(F.ws + WS_WDN))
#define F_XN ((bf16_t*)(F.ws + WS_XN))
#define F_DQ ((bf16_t*)(F.ws + WS_DQ))
#define F_FQ ((bf16_t*)(F.ws + WS_FQ))
#define F_FK ((bf16_t*)(F.ws + WS_FK))
#define F_FV ((bf16_t*)(F.ws + WS_FV))
#define F_YS ((bf16_t*)(F.ws + WS_YS))
#define F_O ((bf16_t*)(F.ws + WS_O))
#define F_DLAT ((bf16_t*)(F.ws + WS_DLAT))
#define F_CKV ((bf16_t*)(F.ws + WS_CKV))
#define F_IQ ((bf16_t*)(F.ws + WS_IQ))
#define F_IK ((bf16_t*)(F.ws + WS_IK))
#define F_HS ((bf16_t*)(F.ws + WS_HS))
#define F_IW ((float*)(F.ws + WS_IW))
#define F_LOG ((float*)(F.ws + WS_LOG))
#define F_GL ((float*)(F.ws + WS_GL))
#define F_REID ((int*)(F.ws + WS_REID))
#define F_RSLOT ((int*)(F.ws + WS_RSLOT))
#define F_TOK ((int*)(F.ws + WS_TOK))

__device__ __forceinline__ void p0_mod(Frame& F) {
    LAS float* ca = (LAS float*)(F.lds);
    LAS float* red = (LAS float*)(F.lds + 32768);
    for (int i = F.tid; i < NB * DM; i += NTHREADS) { const float v = F_c[i]; ca[i] = v / (1.f + __expf(-v)); }
    __syncthreads();
    const int kr = F.lane >> 3, c4 = F.lane & 7;
    for (int item = blockIdx.x; item < 192; item += F.G) {
        const int n0 = item * 32;
        float acc[4][8];
#pragma unroll
        for (int j = 0; j < 4; ++j)
#pragma unroll
            for (int b = 0; b < 8; ++b) acc[j][b] = 0.f;
#pragma unroll 4
        for (int it = 0; it < 16; ++it) {
            const int k = F.wave * 128 + it * 8 + kr;
            const f32x4 w = *(const f32x4*)(F_w_ada + (size_t)k * 6144 + n0 + c4 * 4);
#pragma unroll
            for (int b = 0; b < 8; ++b) { const float cv = ca[b * DM + k];
#pragma unroll
                for (int j = 0; j < 4; ++j) acc[j][b] += w[j] * cv; }
        }
#pragma unroll
        for (int j = 0; j < 4; ++j)
#pragma unroll
            for (int b = 0; b < 8; ++b) { float v = acc[j][b]; v += __shfl_xor(v, 8); v += __shfl_xor(v, 16); v += __shfl_xor(v, 32);
                if (kr == 0) red[(F.wave * 32 + c4 * 4 + j) * 8 + b] = v; }
        __syncthreads();
        if (F.tid < 256) { const int col = F.tid >> 3, b = F.tid & 7; float s = 0.f;
#pragma unroll
            for (int w = 0; w < 8; ++w) s += red[(w * 32 + col) * 8 + b];
            F_mod[b * 6144 + n0 + col] = s + F_b_ada[n0 + col]; }
        __syncthreads();
    }
}
__device__ __forceinline__ void tr_block(const float* W, int ldw, int k0, int c0, int nv, bf16_t* WT, int ldt, int r0, LAS float* scr, int lane) {
#pragma unroll 8
    for (int i = 0; i < 32; ++i) { const int kk = 2 * i + (lane >> 5), n = lane & 31; scr[kk * 33 + n] = (n < nv) ? W[(size_t)(k0 + kk) * ldw + c0 + n] : 0.f; }
    LDS_WAIT(); asm volatile("" ::: "memory");
    const int c = lane & 7;
#pragma unroll
    for (int j = 0; j < 4; ++j) { const int n = (lane >> 3) + 8 * j; const LAS float* s = scr + (8 * c) * 33 + n;
        u32x4 o; o.x = pk2(s[0 * 33], s[1 * 33]); o.y = pk2(s[2 * 33], s[3 * 33]); o.z = pk2(s[4 * 33], s[5 * 33]); o.w = pk2(s[6 * 33], s[7 * 33]);
        *(u32x4*)(WT + (size_t)(r0 + n) * ldt + k0 + 8 * c) = o; }
    LDS_WAIT(); asm volatile("" ::: "memory");
}
__device__ __forceinline__ void p0_weights(Frame& F) {
    LAS float* scr = (LAS float*)(F.lds + F.wave * 16384);
    const int gw = F.vcu * NWAVES + F.wave, NGW = F.G * NWAVES;
    constexpr int I_IN = 16 * 80, I_OUT = 16 * 32, I_RT = 16 * 8, I_UV = 32, I_UP = 32 * 2 * 2 * 4 * 16, I_DN = 32 * 4 * 32;
    constexpr int NITEMS = I_IN + I_OUT + I_RT + I_UV + I_UP + I_DN;
    for (int it = gw; it < NITEMS; it += NGW) {
        int r = it;
        if (r < I_IN) { const int kb = r / 80, nb = r % 80, n0 = nb * 32; int c0 = 0, nv = 32;
            if (n0 < 512) c0 = n0; else if (n0 < 1024) c0 = 804 + (n0 - 512); else if (n0 < 1536) c0 = 1316 + (n0 - 1024); else if (n0 < 2048) c0 = 1828 + (n0 - 1536);
            else if (n0 < 2176) c0 = 512 + (n0 - 2048); else if (n0 < 2304) c0 = 640 + (n0 - 2176); else if (n0 == 2304) c0 = 768; else if (n0 == 2336) { c0 = 800; nv = 4; } else { c0 = 0; nv = 0; }
            tr_block(F_w_in, 2340, kb * 64, c0, nv, F_Win, DM, n0, scr, F.lane); continue; } r -= I_IN;
        if (r < I_OUT) { const int kb = r / 32, nb = r % 32; tr_block(F_w_out, DM, kb * 64, nb * 32, 32, F_Wout, DM, nb * 32, scr, F.lane); continue; } r -= I_OUT;
        if (r < I_RT) { const int kb = r / 8, nb = r % 8;
            if (nb == 0) tr_block(F_w_router, 32, kb * 64, 0, 32, F_Wrt, DM, 0, scr, F.lane);
            else if (nb == 1) tr_block(F_w_group, 4, kb * 64, 0, 4, F_Wrt, DM, 32, scr, F.lane);
            else tr_block(F_w_group, 4, kb * 64, 0, 0, F_Wrt, DM, nb * 32, scr, F.lane);
            continue; } r -= I_RT;
        if (r < I_UV) { const int h = r >> 2, kb = (r >> 1) & 1, nb = r & 1; tr_block(F_w_uv + h * 8192, 64, kb * 64, nb * 32, 32, F_WuvT + h * 8192, 128, nb * 32, scr, F.lane); continue; } r -= I_UV;
        if (r < I_UP) { const int kb = r & 15, nb4 = (r >> 4) & 3, gu = (r >> 6) & 1, jt = (r >> 7) & 1, e = r >> 8;
            tr_block((gu ? F_w_up : F_w_gate) + (size_t)e * 262144, 256, kb * 64, jt * 128 + nb4 * 32, 32, F_Wup, DM, e * 512 + jt * 256 + gu * 128 + nb4 * 32, scr, F.lane); continue; } r -= I_UP;
        { const int nb = r & 31, kb = (r >> 5) & 3, e = r >> 7;
            tr_block(F_w_down + (size_t)e * 262144, DM, kb * 64, nb * 32, 32, F_Wdn + (size_t)e * 262144, 256, nb * 32, scr, F.lane); }
    }
    for (int i = (blockIdx.x * NTHREADS + F.tid) * 4; i < 65536; i += F.G * NTHREADS * 4) { const f32x4 v = *(const f32x4*)(F_w_uk + i); u32x2 o; o.x = pk2(v[0], v[1]); o.y = pk2(v[2], v[3]); *(u32x2*)(F_Wuk + i) = o; }
}

__device__ __forceinline__ void modnorm_rows(Frame& F, const float* src, const float* g, int shift_off, int scale_off, bf16_t* dst) {
    const int gw = F.vcu * NWAVES + F.wave, NGW = F.G * NWAVES;
    for (int m = gw; m < NT; m += NGW) {
        const int b = m / SEQ;
        const f32x4* xr = (const f32x4*)(src + (size_t)m * DM) + F.lane;
        f32x4 v[4]; float s = 0.f;
#pragma unroll
        for (int j = 0; j < 4; ++j) { v[j] = xr[64 * j]; s += (v[j].x * v[j].x + v[j].y * v[j].y) + (v[j].z * v[j].z + v[j].w * v[j].w); }
        const float rstd = 1.f / sqrtf(wave_sum(s) * (1.f / DM) + RMS_EPS);
        u32x2* o8 = (u32x2*)(dst + (size_t)m * DM) + F.lane;
#pragma unroll
        for (int j = 0; j < 4; ++j) {
            const f32x4 gg = *((const f32x4*)g + F.lane + 64 * j);
            const f32x4 sc = *((const f32x4*)(F_mod + b * 6144 + scale_off) + F.lane + 64 * j);
            const f32x4 sh = *((const f32x4*)(F_mod + b * 6144 + shift_off) + F.lane + 64 * j);
            const f32x4 y = (v[j] * rstd) * gg * (sc + 1.f) + sh;
            u32x2 o; o.x = pk2(y.x, y.y); o.y = pk2(y.z, y.w); o8[64 * j] = o;
        }
    }
}
__device__ __forceinline__ void ckv_rows(Frame& F) {
    const int gw = F.vcu * NWAVES + F.wave, NGW = F.G * NWAVES;
    const int sub = F.lane >> 5, l32 = F.lane & 31;
    const f32x4 gg = *((const f32x4*)F_g_kv + l32);
    for (int it = gw; it < NT / 2; it += NGW) {
        const size_t row = (size_t)it * 2 + sub;
        const u32x2 w = *((const u32x2*)(F_DLAT + row * 128) + l32);
        const float a = bflo(w.x), b = bfhi(w.x), c = bflo(w.y), d = bfhi(w.y);
        float s = (a * a + b * b) + (c * c + d * d);
#pragma unroll
        for (int o = 1; o < 32; o <<= 1) s += __shfl_xor(s, o);
        const float rstd = 1.f / sqrtf(s * (1.f / 128.f) + RMS_EPS);
        u32x2 o; o.x = pk2(a * rstd * gg.x, b * rstd * gg.y); o.y = pk2(c * rstd * gg.z, d * rstd * gg.w);
        *((u32x2*)(F_CKV + row * 128) + l32) = o;
    }
}

struct EpiProj {
    static constexpr bool PERM = true;
    bf16_t *DQ, *FQ, *FK, *FV, *DLAT, *IQ, *IK; float* IW;
    __device__ __forceinline__ void operator()(const f32x4 (&acc)[2][2][4][2], const pg8::Unit& u, int wr, int wc, int fr, int fq) const {
        const int row0 = u.pm * 256 + wr * 64 + fr;
#pragma unroll
        for (int bj = 0; bj < 2; ++bj) {
            const int sg = 2 * u.pn + bj;
            if (sg < 18) {
                bf16_t* base; int ld, col; float sc = 1.f;
                if (sg < 16) { const int t = sg >> 2; base = (t == 0) ? DQ : (t == 1) ? FQ : (t == 2) ? FK : FV; ld = 512; col = (sg & 3) * 128 + wc * 32 + 8 * fq; if (t == 1) sc = DIFF_C2; }
                else { base = (sg == 16) ? DLAT : IQ; ld = 128; col = wc * 32 + 8 * fq; }
#pragma unroll
                for (int ai = 0; ai < 2; ++ai)
#pragma unroll
                    for (int m = 0; m < 4; ++m) { const f32x4 v0 = acc[ai][bj][m][0] * sc, v1 = acc[ai][bj][m][1] * sc;
                        u32x4 w; w.x = pk2(v0[0], v0[1]); w.y = pk2(v0[2], v0[3]); w.z = pk2(v1[0], v1[1]); w.w = pk2(v1[2], v1[3]);
                        *(u32x4*)(base + (size_t)(row0 + ai * 128 + m * 16) * ld + col) = w; }
            } else if (sg == 18) {
                if (wc == 0) {
#pragma unroll
                    for (int ai = 0; ai < 2; ++ai)
#pragma unroll
                        for (int m = 0; m < 4; ++m) { const f32x4 v0 = acc[ai][bj][m][0], v1 = acc[ai][bj][m][1];
                            u32x4 w; w.x = pk2(v0[0], v0[1]); w.y = pk2(v0[2], v0[3]); w.z = pk2(v1[0], v1[1]); w.w = pk2(v1[2], v1[3]);
                            *(u32x4*)(IK + (size_t)(row0 + ai * 128 + m * 16) * 32 + 8 * fq) = w; }
                } else if (wc == 1 && fq == 0) {
#pragma unroll
                    for (int ai = 0; ai < 2; ++ai)
#pragma unroll
                        for (int m = 0; m < 4; ++m) *(f32x4*)(IW + (size_t)(row0 + ai * 128 + m * 16) * 4) = acc[ai][bj][m][0] * IW_SCALE;
                }
            }
        }
    }
};
struct EpiX1 {
    static constexpr bool PERM = false;
    const float* x; const float* mod; float* x1;
    __device__ __forceinline__ void operator()(const f32x4 (&acc)[2][2][4][2], const pg8::Unit& u, int wr, int wc, int fr, int fq) const {
        const int row0 = u.pm * 256 + wr * 64 + fr; const int b = (u.pm * 256) / SEQ;
#pragma unroll
        for (int bj = 0; bj < 2; ++bj)
#pragma unroll
            for (int n = 0; n < 2; ++n) { const int col = u.pn * 256 + bj * 128 + wc * 32 + n * 16 + 4 * fq;
                const f32x4 gv = *(const f32x4*)(mod + b * 6144 + 2048 + col);
#pragma unroll
                for (int ai = 0; ai < 2; ++ai)
#pragma unroll
                    for (int m = 0; m < 4; ++m) { const size_t off = (size_t)(row0 + ai * 128 + m * 16) * DM + col;
                        const f32x4 xv = *(const f32x4*)(x + off); *(f32x4*)(x1 + off) = xv + gv * acc[ai][bj][m][n]; } }
    }
};
struct EpiLogits {
    static constexpr bool PERM = false;
    float* LOG; const float* b_router; const float* b_group;
    __device__ __forceinline__ void operator()(const f32x4 (&acc)[2][2][4][2], const pg8::Unit& u, int wr, int wc, int fr, int fq) const {
        if (wc > 1) return;
        const int row0 = u.pm * 256 + wr * 64 + fr;
#pragma unroll
        for (int n = 0; n < 2; ++n) { const int col = wc * 32 + n * 16 + 4 * fq;
            if (col < 36) { const f32x4 bv = (col < 32) ? *(const f32x4*)(b_router + col) : *(const f32x4*)(b_group);
#pragma unroll
                for (int ai = 0; ai < 2; ++ai)
#pragma unroll
                    for (int m = 0; m < 4; ++m) *(f32x4*)(LOG + (size_t)(row0 + ai * 128 + m * 16) * 64 + col) = acc[ai][0][m][n] + bv; } }
    }
};
__device__ __forceinline__ float silu_f(float v) { return v * __builtin_amdgcn_rcpf(1.f + __expf(-v)); }
struct EpiUp {
    static constexpr bool PERM = true;
    bf16_t* HS;
    __device__ __forceinline__ void operator()(const f32x4 (&acc)[2][2][4][2], const pg8::Unit& u, int wr, int wc, int fr, int fq) const {
        const int row0 = u.pm * 256 + wr * 64 + fr; const int col = (u.pn & 1) * 128 + wc * 32 + 8 * fq;
#pragma unroll
        for (int ai = 0; ai < 2; ++ai)
#pragma unroll
            for (int m = 0; m < 4; ++m) { const f32x4 g0 = acc[ai][0][m][0], g1 = acc[ai][0][m][1], u0 = acc[ai][1][m][0], u1 = acc[ai][1][m][1];
                u32x4 w; w.x = pk2(silu_f(g0[0]) * u0[0], silu_f(g0[1]) * u0[1]); w.y = pk2(silu_f(g0[2]) * u0[2], silu_f(g0[3]) * u0[3]);
                w.z = pk2(silu_f(g1[0]) * u1[0], silu_f(g1[1]) * u1[1]); w.w = pk2(silu_f(g1[2]) * u1[2], silu_f(g1[3]) * u1[3]);
                *(u32x4*)(HS + (size_t)(row0 + ai * 128 + m * 16) * 256 + col) = w; }
    }
};
struct EpiDown {
    static constexpr bool PERM = true;
    bf16_t* YS; const float* GL; const LAS int* ecnt;
    __device__ __forceinline__ void operator()(const f32x4 (&acc)[2][2][4][2], const pg8::Unit& u, int wr, int wc, int fr, int fq) const {
        const int r0 = wr * 64 + fr; const int e = u.a0; const int cnt = ecnt[e];
        const int colb = (u.pn & 3) * 256 + wc * 32 + 8 * fq;
#pragma unroll
        for (int ai = 0; ai < 2; ++ai)
#pragma unroll
            for (int m = 0; m < 4; ++m) { const int r = r0 + ai * 128 + m * 16; int slot = u.a1 + r; slot = slot < cnt ? slot : cnt - 1;
                const float g = GL[(size_t)e * NT + slot];
#pragma unroll
                for (int bj = 0; bj < 2; ++bj) { const f32x4 v0 = acc[ai][bj][m][0] * g, v1 = acc[ai][bj][m][1] * g;
                    u32x4 w; w.x = pk2(v0[0], v0[1]); w.y = pk2(v0[2], v0[3]); w.z = pk2(v1[0], v1[1]); w.w = pk2(v1[2], v1[3]);
                    *(u32x4*)(YS + (size_t)(u.pm * 256 + r) * DM + colb + bj * 128) = w; } }
    }
};

struct MoeTab { LAS int* ecnt; LAS int* toff; };
__device__ __forceinline__ MoeTab moe_tables(Frame& F) {
    MoeTab t; t.ecnt = (LAS int*)(F.lds + MISC_OFF + 128); t.toff = t.ecnt + 32;
    __syncthreads();
    if (F.tid < 32) t.ecnt[F.tid] = (int)__hip_atomic_load(F.ctl + CW_ECNT + 64 * F.tid, __ATOMIC_RELAXED, __HIP_MEMORY_SCOPE_AGENT);
    __syncthreads();
    if (F.tid == 0) { int s = 0; for (int e = 0; e < 32; ++e) { t.toff[e] = s; s += (t.ecnt[e] + 255) >> 8; } t.toff[32] = s; }
    __syncthreads();
    return t;
}
template <int NPN, bool GATHER> struct MoeOrder {
    MoeTab tab; int G, c, K; const int* TOK;
    __device__ bool next(int i, pg8::Unit& u) const {
        const long L = (long)i * G + c; const int total = tab.toff[32] * NPN; if (L >= total) return false;
        const int rt = (int)(L / NPN), pl = (int)(L % NPN);
        int e = 0;
#pragma unroll 1
        for (int j = 1; j < 32; ++j) e = (tab.toff[j] <= rt) ? j : e;
        u.pm = rt; u.pn = e * NPN + pl; u.a0 = e; u.a1 = (rt - tab.toff[e]) * 256; return true;
    }
    __device__ __forceinline__ unsigned a_off(const pg8::Unit& u, int R) const {
        if constexpr (GATHER) { const int cnt = tab.ecnt[u.a0]; int slot = u.a1 + R; slot = slot < cnt ? slot : cnt - 1; return (unsigned)TOK[(size_t)u.a0 * NT + slot] * (unsigned)(K * 2); }
        else return (unsigned)(u.pm * 256 + R) * (unsigned)(K * 2);
    }
};
__device__ __forceinline__ void route_tokens(Frame& F) {
    LAS int* lc = (LAS int*)(F.lds);
    LAS int* lb = lc + 32;
    for (int chunk = blockIdx.x; chunk < NT / NTHREADS; chunk += F.G) {
        const int tok = chunk * NTHREADS + F.tid;
        if (F.tid < 32) lc[F.tid] = 0;
        __syncthreads();
        const float* lg = F_LOG + (size_t)tok * 64;
        float gl[4];
        { const f32x4 v = *(const f32x4*)(lg + 32); gl[0] = v[0]; gl[1] = v[1]; gl[2] = v[2]; gl[3] = v[3]; }
        int gs = 0; float gm = gl[0];
#pragma unroll
        for (int j = 1; j < 4; ++j) if (gl[j] > gm) { gm = gl[j]; gs = j; }
        float den = 0.f;
#pragma unroll
        for (int j = 0; j < 4; ++j) den += __expf(gl[j] - gm);
        const float pg = 1.f / den;
        float el[8];
        { const f32x4 a = *(const f32x4*)(lg + gs * 8), b = *(const f32x4*)(lg + gs * 8 + 4); el[0] = a[0]; el[1] = a[1]; el[2] = a[2]; el[3] = a[3]; el[4] = b[0]; el[5] = b[1]; el[6] = b[2]; el[7] = b[3]; }
        int i0 = 0; float v0 = el[0];
#pragma unroll
        for (int j = 1; j < 8; ++j) if (el[j] > v0) { v0 = el[j]; i0 = j; }
        int i1 = -1; float v1 = -INFINITY;
#pragma unroll
        for (int j = 0; j < 8; ++j) if (j != i0 && (i1 < 0 || el[j] > v1)) { v1 = el[j]; i1 = j; }
        const float ex = __expf(v1 - v0); const float w0 = pg / (1.f + ex), w1 = w0 * ex;
        const int e0 = gs * 8 + i0, e1 = gs * 8 + i1;
        const int r0 = __hip_atomic_fetch_add(lc + e0, 1, __ATOMIC_RELAXED, __HIP_MEMORY_SCOPE_WORKGROUP), r1 = __hip_atomic_fetch_add(lc + e1, 1, __ATOMIC_RELAXED, __HIP_MEMORY_SCOPE_WORKGROUP);
        __syncthreads();
        if (F.tid < 32) lb[F.tid] = (int)__hip_atomic_fetch_add(F.ctl + CW_ECNT + 64 * F.tid, (unsigned)lc[F.tid], __ATOMIC_RELAXED, __HIP_MEMORY_SCOPE_AGENT);
        __syncthreads();
        const int s0 = lb[e0] + r0, s1 = lb[e1] + r1;
        F_TOK[(size_t)e0 * NT + s0] = tok; F_TOK[(size_t)e1 * NT + s1] = tok;
        F_GL[(size_t)e0 * NT + s0] = w0; F_GL[(size_t)e1 * NT + s1] = w1;
        *(int2*)(F_REID + (size_t)tok * 2) = make_int2(e0, e1);
        *(int2*)(F_RSLOT + (size_t)tok * 2) = make_int2(s0, s1);
        __syncthreads();
    }
}
__device__ __forceinline__ void combine_rows(Frame& F, const MoeTab& tab) {
    const int gw = F.vcu * NWAVES + F.wave, NGW = F.G * NWAVES;
    for (int m = gw; m < NT; m += NGW) {
        const int b = m / SEQ;
        const int2 ee = *(const int2*)(F_REID + (size_t)m * 2), ss = *(const int2*)(F_RSLOT + (size_t)m * 2);
        const size_t p0 = (size_t)tab.toff[ee.x] * 256 + ss.x, p1 = (size_t)tab.toff[ee.y] * 256 + ss.y;
        const f32x4* xr = (const f32x4*)(F_out + (size_t)m * DM) + F.lane;
        const u32x2* y0 = (const u32x2*)(F_YS + p0 * DM) + F.lane; const u32x2* y1 = (const u32x2*)(F_YS + p1 * DM) + F.lane;
        f32x4 v[4]; float s = 0.f;
#pragma unroll
        for (int j = 0; j < 4; ++j) { const f32x4 xv = xr[64 * j]; const u32x2 a = y0[64 * j], c = y1[64 * j];
            const f32x4 gm = *((const f32x4*)(F_mod + b * 6144 + 5120) + F.lane + 64 * j);
            const f32x4 ys = {bflo(a.x) + bflo(c.x), bfhi(a.x) + bfhi(c.x), bflo(a.y) + bflo(c.y), bfhi(a.y) + bfhi(c.y)};
            v[j] = xv + gm * ys; s += (v[j].x * v[j].x + v[j].y * v[j].y) + (v[j].z * v[j].z + v[j].w * v[j].w); }
        const float rstd = 1.f / sqrtf(wave_sum(s) * (1.f / DM) + RMS_EPS);
        f32x4* orow = (f32x4*)(F_out + (size_t)m * DM) + F.lane;
#pragma unroll
        for (int j = 0; j < 4; ++j) { const f32x4 gg = *((const f32x4*)F_g_final + F.lane + 64 * j); orow[64 * j] = (v[j] * rstd) * gg; }
    }
}

__device__ __forceinline__ void diff_unit(Frame& F, int b, int h, int qb, float lam, float lam_init, float slope2) {
    const int tid = F.tid, lane = F.lane, wave = F.wave;
    const int r32 = lane & 31, hi = lane >> 5;
    const int st = wave >> 2, wq = wave & 3;
    const int q0 = qb * 128, nt = 2 * qb + 2;
    LAS unsigned char* L = F.lds;
    const int qpos = q0 + 32 * wq + r32;
    bf16x8 qf[4];
    { const bf16_t* qp = F_FQ + ((size_t)(b * SEQ + qpos) * 512 + h * 128 + st * 64 + hi * 8);
#pragma unroll
      for (int s = 0; s < 4; ++s) qf[s] = *(const bf16x8*)(qp + 16 * s); }
    const int srow0 = tid >> 4, sch = tid & 15;
    const size_t gk = ((size_t)(b * SEQ) * 512 + h * 128) + (size_t)srow0 * 512 + sch * 8;
    const unsigned sdst0 = off_b(srow0, sch), sdst1 = off_b(srow0 + 32, sch);
    u32x4 kr0, kr1, vr0, vr1;
#define DIFF_LOAD(t) do { const size_t go = gk + (size_t)(t) * 64 * 512; kr0 = *(const u32x4*)(F_FK + go); kr1 = *(const u32x4*)(F_FK + go + 32 * 512); vr0 = *(const u32x4*)(F_FV + go); vr1 = *(const u32x4*)(F_FV + go + 32 * 512); } while (0)
#define DIFF_STORE(buf) do { *(LAS u32x4*)(L + (buf) * 16384 + sdst0) = kr0; *(LAS u32x4*)(L + (buf) * 16384 + sdst1) = kr1; *(LAS u32x4*)(L + 32768 + (buf) * 16384 + sdst0) = vr0; *(LAS u32x4*)(L + 32768 + (buf) * 16384 + sdst1) = vr1; } while (0)
    DIFF_LOAD(0); DIFF_STORE(0);
    __syncthreads();
    const unsigned kswz = ((unsigned)(r32 & 3) << 2) | ((unsigned)(r32 >> 2) & 3u);
    unsigned koff[4];
#pragma unroll
    for (int s = 0; s < 4; ++s) koff[s] = 256u * r32 + 16u * (((unsigned)(8 * st + 2 * s + hi)) ^ kswz);
    const int qq = (lane & 15) >> 2, pp = lane & 3, blk = (lane >> 4) & 1;
    unsigned vo[2][4];
#pragma unroll
    for (int tt = 0; tt < 2; ++tt)
#pragma unroll
        for (int cb = 0; cb < 4; ++cb) vo[tt][cb] = 256u * (unsigned)(8 * tt + 4 * hi + qq) + 16u * (((unsigned)(4 * cb + 2 * blk + (pp >> 1))) ^ (((unsigned)qq << 2) | ((unsigned)(2 * tt + hi) & 3u))) + 8u * (unsigned)(pp & 1);
    float mrow = -INFINITY, lrow = 0.f;
    f32x16 o[4];
#pragma unroll
    for (int cb = 0; cb < 4; ++cb)
#pragma unroll
        for (int r = 0; r < 16; ++r) o[cb][r] = 0.f;
    for (int t = 0; t < nt; ++t) {
        const int buf = t & 1;
        if (t + 1 < nt) DIFF_LOAD(t + 1);
        const LAS unsigned char* Kb = L + buf * 16384;
        const LAS unsigned char* Vb = L + 32768 + buf * 16384;
        f32x16 p[2];
#pragma unroll
        for (int kh = 0; kh < 2; ++kh) {
            const float cbias = slope2 * (float)(64 * t + 32 * kh + 4 * hi - (q0 + 127));
            f32x16 c;
#pragma unroll
            for (int r = 0; r < 16; ++r) c[r] = fmaf(slope2, (float)((r & 3) + 8 * (r >> 2)), cbias);
#pragma unroll
            for (int s = 0; s < 4; ++s) { const bf16x8 a = *(const LAS bf16x8*)(Kb + kh * 8192 + koff[s]); c = MFMA32(a, qf[s], c); }
            p[kh] = c;
        }
        if (t >= nt - 2) {
#pragma unroll
            for (int kh = 0; kh < 2; ++kh)
#pragma unroll
                for (int r = 0; r < 16; ++r) { const int kpos = 64 * t + 32 * kh + crow(r, hi); if (kpos > qpos) p[kh][r] = -INFINITY; }
        }
        float mx = p[0][0];
#pragma unroll
        for (int r = 1; r < 16; ++r) mx = fmaxf(mx, p[0][r]);
#pragma unroll
        for (int r = 0; r < 16; ++r) mx = fmaxf(mx, p[1][r]);
        mx = fmaxf(mx, __shfl_xor(mx, 32));
        const float mnew = fmaxf(mrow, mx);
        const float alpha = __builtin_amdgcn_exp2f(mrow - mnew);
        mrow = mnew;
        float ps = 0.f;
#pragma unroll
        for (int kh = 0; kh < 2; ++kh)
#pragma unroll
            for (int r = 0; r < 16; ++r) { const float e = __builtin_amdgcn_exp2f(p[kh][r] - mnew); p[kh][r] = e; ps += e; }
        lrow = lrow * alpha + ps;
#pragma unroll
        for (int cb = 0; cb < 4; ++cb)
#pragma unroll
            for (int r = 0; r < 16; ++r) o[cb][r] *= alpha;
        bf16x8 pa[4];
#pragma unroll
        for (int ks = 0; ks < 4; ++ks) { const int kh = ks >> 1, r0 = (ks & 1) * 8;
            u32x4 w; w.x = pk2(p[kh][r0], p[kh][r0 + 1]); w.y = pk2(p[kh][r0 + 2], p[kh][r0 + 3]); w.z = pk2(p[kh][r0 + 4], p[kh][r0 + 5]); w.w = pk2(p[kh][r0 + 6], p[kh][r0 + 7]);
            pa[ks] = __builtin_bit_cast(bf16x8, w); }
#pragma unroll
        for (int cb = 0; cb < 4; ++cb)
#pragma unroll
            for (int ks = 0; ks < 4; ++ks) {
                const s16x4 v0 = tr_read((const LAS char*)(Vb + vo[0][cb] + 4096 * ks));
                const s16x4 v1 = tr_read((const LAS char*)(Vb + vo[1][cb] + 4096 * ks));
                o[cb] = MFMA32(cat8(v0, v1), pa[ks], o[cb]);
            }
        if (t + 1 < nt) DIFF_STORE(buf ^ 1);
        __syncthreads();
    }
#undef DIFF_LOAD
#undef DIFF_STORE
    lrow += __shfl_xor(lrow, 32);
    const float rl = 1.f / lrow;
    LAS float* X = (LAS float*)L;
    if (st == 1) {
#pragma unroll
        for (int cb = 0; cb < 4; ++cb)
#pragma unroll
            for (int r = 0; r < 16; ++r) X[(wq * 64 + cb * 16 + r) * 64 + lane] = o[cb][r] * rl;
    }
    __syncthreads();
    if (st == 0) {
        float ss = 0.f;
#pragma unroll
        for (int cb = 0; cb < 4; ++cb)
#pragma unroll
            for (int r = 0; r < 16; ++r) { const float d = o[cb][r] * rl - lam * X[(wq * 64 + cb * 16 + r) * 64 + lane]; o[cb][r] = d; ss += d * d; }
        ss += __shfl_xor(ss, 32);
        const float rstd = (1.f - lam_init) / sqrtf(ss * (1.f / 128.f) + RMS_EPS);
        bf16_t* orow = F_O + (size_t)(b * SEQ + qpos) * DM + 512 + h * 128;
#pragma unroll
        for (int cb = 0; cb < 4; ++cb)
#pragma unroll
            for (int r4 = 0; r4 < 4; ++r4) { const int c0 = 32 * cb + 8 * r4 + 4 * hi;
                const f32x4 gg = *(const f32x4*)(F_g_sub + c0);
                u32x2 w; w.x = pk2(o[cb][4 * r4] * rstd * gg[0], o[cb][4 * r4 + 1] * rstd * gg[1]); w.y = pk2(o[cb][4 * r4 + 2] * rstd * gg[2], o[cb][4 * r4 + 3] * rstd * gg[3]);
                *(u32x2*)(orow + c0) = w; }
    }
    __syncthreads();
}
__device__ __forceinline__ void diff_phase(Frame& F) {
    const float lam_init = 0.8f - 0.6f * 1.0f;
    float a = F_lq1[F.lane] * F_lk1[F.lane], c = F_lq2[F.lane] * F_lk2[F.lane];
    a = wave_sum(a); c = wave_sum(c);
    const float lam = __expf(a) - __expf(c) + lam_init;
    const int combo = F.vcu >> 3, s = F.vcu & 7;
    const int b = combo >> 2, h = combo & 3;
    const float slope2 = exp2f(-2.0f * (float)(h + 1)) * LOG2E;
    if (F.G != 256) return;
    for (int j = 0; j < 4; ++j) { const int p = s + 8 * j;
        diff_unit(F, b, h, 63 - p, lam, lam_init, slope2);
        diff_unit(F, b, h, p, lam, lam_init, slope2); }
}

constexpr int DSA_NBIN = 1024;
constexpr int DSA_POOLCAP = 12288;
constexpr int DSA_SEL_OFF = 131072, DSA_SM_OFF = 147456, DSA_GI_OFF = 65536;
constexpr float DSA_SCALE2 = 0.125f * LOG2E;

__device__ __forceinline__ unsigned f32_sortable(float f) { const unsigned u = __builtin_bit_cast(unsigned, f); return u ^ ((u >> 31) ? 0xffffffffu : 0x80000000u); }

template <int PASS>
__device__ __forceinline__ void dsa_pass(Frame& F, int b, int q0, const bf16x8 (&qf)[4][2], const float (&w)[4]) {
    const int lane = F.lane, r32 = lane & 31, hi = lane >> 5;
    LAS unsigned* hist = (LAS unsigned*)F.lds;
    LAS unsigned long long* pool = (LAS unsigned long long*)F.lds;
    LAS unsigned short* sel = (LAS unsigned short*)(F.lds + DSA_SEL_OFF);
    LAS int* sm = (LAS int*)(F.lds + DSA_SM_OFF);
    const int qpos = q0 + r32;
    const int nkb = (q0 >> 5) + 1;
    int tb = 0, po = 0;
    if (PASS == 2) { tb = sm[r32]; po = sm[96 + r32]; }
    for (int kb = F.wave; kb < nkb; kb += NWAVES) {
        const bf16_t* kp = F_IK + ((size_t)(b * SEQ + 32 * kb + r32) * 32 + hi * 8);
        const bf16x8 a0 = *(const bf16x8*)kp, a1 = *(const bf16x8*)(kp + 16);
        f32x16 sc;
#pragma unroll
        for (int r = 0; r < 16; ++r) sc[r] = 0.f;
#pragma unroll
        for (int h = 0; h < 4; ++h) {
            f32x16 acc;
#pragma unroll
            for (int r = 0; r < 16; ++r) acc[r] = 0.f;
            acc = MFMA32(a0, qf[h][0], acc); acc = MFMA32(a1, qf[h][1], acc);
#pragma unroll
            for (int r = 0; r < 16; ++r) sc[r] = fmaf(fmaxf(acc[r], 0.f), w[h], sc[r]);
        }
        const bool diag = (kb == nkb - 1);
#pragma unroll
        for (int r = 0; r < 16; ++r) {
            const int key = 32 * kb + crow(r, hi);
            const float s = sc[r] + 0.f;
            int bin = (int)(s * 32.f + 512.f); bin = bin < 0 ? 0 : (bin > DSA_NBIN - 1 ? DSA_NBIN - 1 : bin);
            const bool valid = !diag || key <= qpos;
            if (PASS == 1) { if (valid) (void)__hip_atomic_fetch_add(hist + r32 * DSA_NBIN + bin, 1u, __ATOMIC_RELAXED, __HIP_MEMORY_SCOPE_WORKGROUP); }
            else if (valid) {
                if (bin > tb) { const int slot = __hip_atomic_fetch_add(sm + 128 + r32, 1, __ATOMIC_RELAXED, __HIP_MEMORY_SCOPE_WORKGROUP); sel[r32 * 256 + slot] = (unsigned short)key; }
                else if (bin == tb) { const int slot = po + __hip_atomic_fetch_add(sm + 160 + r32, 1, __ATOMIC_RELAXED, __HIP_MEMORY_SCOPE_WORKGROUP);
                    if (slot < DSA_POOLCAP) pool[slot] = ((unsigned long long)f32_sortable(s) << 16) | (unsigned long long)(0xffffu - (unsigned)key); }
            }
        }
    }
}

__device__ __forceinline__ void dsa_topk(Frame& F, int b, int qt) {
    const int lane = F.lane, r32 = lane & 31, hi = lane >> 5, wave = F.wave;
    const int q0 = qt * 32;
    LAS unsigned* hist = (LAS unsigned*)F.lds;
    LAS unsigned long long* pool = (LAS unsigned long long*)F.lds;
    LAS unsigned short* sel = (LAS unsigned short*)(F.lds + DSA_SEL_OFF);
    LAS int* sm = (LAS int*)(F.lds + DSA_SM_OFF);
    if (q0 + 32 <= 256) {
        for (int i = F.tid; i < 32 * 256; i += NTHREADS) { const int q = i >> 8, j = i & 255; sel[i] = (j <= q0 + q) ? (unsigned short)j : (unsigned short)0xffffu; }
        __syncthreads();
        return;
    }
    bf16x8 qf[4][2]; float w[4];
    { const bf16_t* qp = F_IQ + ((size_t)(b * SEQ + q0 + r32) * 128 + hi * 8);
#pragma unroll
      for (int h = 0; h < 4; ++h) { qf[h][0] = *(const bf16x8*)(qp + h * 32); qf[h][1] = *(const bf16x8*)(qp + h * 32 + 16); }
      const f32x4 wv = *(const f32x4*)(F_IW + (size_t)(b * SEQ + q0 + r32) * 4); w[0] = wv[0]; w[1] = wv[1]; w[2] = wv[2]; w[3] = wv[3]; }
    for (int i = F.tid; i < 32 * DSA_NBIN / 4; i += NTHREADS) ((LAS u32x4*)hist)[i] = (u32x4){0u, 0u, 0u, 0u};
    for (int i = F.tid; i < 32 * 256 / 8; i += NTHREADS) ((LAS u32x4*)sel)[i] = (u32x4){0xffffffffu, 0xffffffffu, 0xffffffffu, 0xffffffffu};
    if (F.tid < 64) sm[128 + F.tid] = 0;
    __syncthreads();
    dsa_pass<1>(F, b, q0, qf, w);
    __syncthreads();
#pragma unroll 1
    for (int qi = 0; qi < 4; ++qi) {
        const int q = 4 * wave + qi;
        unsigned hv[16];
#pragma unroll
        for (int j4 = 0; j4 < 4; ++j4) { const u32x4 v = *(const LAS u32x4*)(hist + q * DSA_NBIN + 16 * lane + 4 * j4); hv[4 * j4] = v.x; hv[4 * j4 + 1] = v.y; hv[4 * j4 + 2] = v.z; hv[4 * j4 + 3] = v.w; }
        unsigned lsum = 0;
#pragma unroll
        for (int j = 0; j < 16; ++j) lsum += hv[j];
        unsigned incl = lsum;
#pragma unroll
        for (int o = 1; o < 64; o <<= 1) { const unsigned v = __shfl_down(incl, o); incl += (lane + o < 64) ? v : 0u; }
        const unsigned excl = incl - lsum;
        if (excl < 256u && incl >= 256u) {
            unsigned run = excl; int tbin = 0; unsigned nab = 0, cc = 0; bool found = false;
#pragma unroll
            for (int j = 15; j >= 0; --j) { if (!found) { if (run + hv[j] >= 256u) { found = true; tbin = 16 * lane + j; nab = run; cc = hv[j]; } else run += hv[j]; } }
            sm[q] = tbin; sm[32 + q] = (int)nab; sm[64 + q] = (int)cc;
        }
    }
    __syncthreads();
    if (wave == 0) {
        int c = (lane < 32) ? sm[64 + lane] : 0; int incl = c;
#pragma unroll
        for (int o = 1; o < 32; o <<= 1) { const int v = __shfl_up(incl, o); incl += (lane >= o) ? v : 0; }
        if (lane < 32) sm[96 + lane] = incl - c;
    }
    __syncthreads();
    dsa_pass<2>(F, b, q0, qf, w);
    __syncthreads();
#pragma unroll 1
    for (int qi = 0; qi < 4; ++qi) {
        const int q = 4 * wave + qi;
        const int base = sm[96 + q]; int c = sm[64 + q]; const int r = 256 - sm[32 + q];
        if (base + c > DSA_POOLCAP) c = (DSA_POOLCAP - base) > 0 ? (DSA_POOLCAP - base) : 0;
        unsigned long long P = 0ull;
        if (c > r) {
#pragma unroll 1
            for (int bit = 47; bit >= 0; --bit) {
                const unsigned long long trial = P | (1ull << bit);
                int cnt = 0;
                for (int i0 = 0; i0 < c; i0 += 64) { const int i = i0 + lane; const bool pr = (i < c) && (pool[base + (i < c ? i : 0)] >= trial); cnt += __builtin_popcountll(__ballot(pr)); }
                if (cnt >= r) P = trial;
            }
        }
        for (int i0 = 0; i0 < c; i0 += 64) { const int i = i0 + lane;
            if (i < c) { const unsigned long long v = pool[base + i];
                if (v >= P) { const int slot = __hip_atomic_fetch_add(sm + 128 + q, 1, __ATOMIC_RELAXED, __HIP_MEMORY_SCOPE_WORKGROUP); if (slot < 256) sel[q * 256 + slot] = (unsigned short)(0xffffu - (unsigned)(v & 0xffffull)); } } }
    }
    __syncthreads();
}

__device__ __forceinline__ void dsa_attend(Frame& F, int b, int qt) {
    const int lane = F.lane, r32 = lane & 31, hi = lane >> 5, wave = F.wave;
    const int q0 = qt * 32; const size_t t0 = (size_t)b * SEQ + q0;
    LAS unsigned char* QA = F.lds;
    LAS unsigned char* GI = F.lds + DSA_GI_OFF + wave * 8192;
    LAS unsigned short* sel = (LAS unsigned short*)(F.lds + DSA_SEL_OFF);
    { const int h = wave;
      bf16x8 bq[4];
      { const bf16_t* qp = F_DQ + ((t0 + r32) * 512 + h * 64 + hi * 8);
#pragma unroll
        for (int s = 0; s < 4; ++s) bq[s] = *(const bf16x8*)(qp + 16 * s); }
#pragma unroll
      for (int cb = 0; cb < 4; ++cb) {
          f32x16 acc;
#pragma unroll
          for (int r = 0; r < 16; ++r) acc[r] = 0.f;
          const bf16_t* wp = F_Wuk + ((size_t)(h * 128 + cb * 32 + r32) * 64 + hi * 8);
#pragma unroll
          for (int s = 0; s < 4; ++s) acc = MFMA32(*(const bf16x8*)(wp + 16 * s), bq[s], acc);
#pragma unroll
          for (int r4 = 0; r4 < 4; ++r4) { u32x2 wv; wv.x = pk2(acc[4 * r4], acc[4 * r4 + 1]); wv.y = pk2(acc[4 * r4 + 2], acc[4 * r4 + 3]);
              *(LAS u32x2*)(QA + ((r32 * 8 + h) * 128 + 32 * cb + 8 * r4 + 4 * hi) * 2) = wv; }
      } }
    __syncthreads();
    const int n = lane & 15, g = lane >> 4;
    const float slope2 = exp2f(-(float)((n & 7) + 1)) * LOG2E;
    const int qq = n >> 2, pp = n & 3;
#pragma unroll 1
    for (int qi = 0; qi < 4; ++qi) {
        const int q = 4 * wave + qi; const int qpos = q0 + q;
        bf16x8 bq[4];
#pragma unroll
        for (int s = 0; s < 4; ++s) { bf16x8 v = *(const LAS bf16x8*)(QA + ((q * 8 + (n & 7)) * 128 + 32 * s + 8 * g) * 2); if (n >= 8) v = (bf16x8){0, 0, 0, 0, 0, 0, 0, 0}; bq[s] = v; }
        float mrow = -INFINITY, lrow = 0.f;
        f32x4 o[8];
#pragma unroll
        for (int cb = 0; cb < 8; ++cb) o[cb] = (f32x4){0.f, 0.f, 0.f, 0.f};
#pragma unroll 1
        for (int ch = 0; ch < 8; ++ch) {
            bf16x8 af[2][4];
#pragma unroll
            for (int rb = 0; rb < 2; ++rb) { unsigned key = sel[q * 256 + 32 * ch + 16 * rb + n]; key = key == 0xffffu ? 0u : key;
                const bf16_t* kp = F_CKV + ((size_t)b * SEQ + key) * 128 + 8 * g;
#pragma unroll
                for (int s = 0; s < 4; ++s) af[rb][s] = *(const bf16x8*)(kp + 32 * s); }
            unsigned short kk[2][4];
#pragma unroll
            for (int rb = 0; rb < 2; ++rb) { const u32x2 v = *(const LAS u32x2*)(sel + q * 256 + 32 * ch + 16 * rb + 4 * g); kk[rb][0] = (unsigned short)(v.x & 0xffffu); kk[rb][1] = (unsigned short)(v.x >> 16); kk[rb][2] = (unsigned short)(v.y & 0xffffu); kk[rb][3] = (unsigned short)(v.y >> 16); }
#pragma unroll
            for (int rb = 0; rb < 2; ++rb)
#pragma unroll
                for (int s = 0; s < 4; ++s) *(LAS bf16x8*)(GI + off_b(16 * rb + n, 4 * s + g)) = af[rb][s];
            f32x4 sacc[2];
#pragma unroll
            for (int rb = 0; rb < 2; ++rb) { sacc[rb] = (f32x4){0.f, 0.f, 0.f, 0.f};
#pragma unroll
                for (int s = 0; s < 4; ++s) sacc[rb] = MFMA16(af[rb][s], bq[s], sacc[rb]); }
            float mx = -INFINITY;
#pragma unroll
            for (int rb = 0; rb < 2; ++rb)
#pragma unroll
                for (int i = 0; i < 4; ++i) { const unsigned key = kk[rb][i]; const bool ok = (key != 0xffffu) && ((int)key <= qpos);
                    const float v = ok ? sacc[rb][i] * DSA_SCALE2 - slope2 * (float)(qpos - (int)key) : -INFINITY; sacc[rb][i] = v; mx = fmaxf(mx, v); }
            mx = fmaxf(mx, __shfl_xor(mx, 16)); mx = fmaxf(mx, __shfl_xor(mx, 32));
            const float mnew = fmaxf(mrow, mx);
            const float alpha = (mnew == -INFINITY) ? 1.f : __builtin_amdgcn_exp2f(mrow - mnew);
            float ps = 0.f; float pv[8];
#pragma unroll
            for (int rb = 0; rb < 2; ++rb)
#pragma unroll
                for (int i = 0; i < 4; ++i) { const float e = (mnew == -INFINITY) ? 0.f : __builtin_amdgcn_exp2f(sacc[rb][i] - mnew); pv[4 * rb + i] = e; ps += e; }
            mrow = mnew; lrow = lrow * alpha + ps;
#pragma unroll
            for (int cb = 0; cb < 8; ++cb) o[cb] *= alpha;
            u32x4 pw; pw.x = pk2(pv[0], pv[1]); pw.y = pk2(pv[2], pv[3]); pw.z = pk2(pv[4], pv[5]); pw.w = pk2(pv[6], pv[7]);
            const bf16x8 bp = __builtin_bit_cast(bf16x8, pw);
#pragma unroll
            for (int cb = 0; cb < 8; ++cb) {
                const s16x4 v0 = tr_read((const LAS char*)(GI + off_b(4u * g + qq, 2u * cb + (pp >> 1)) + 8u * (pp & 1)));
                const s16x4 v1 = tr_read((const LAS char*)(GI + off_b(16u + 4u * g + qq, 2u * cb + (pp >> 1)) + 8u * (pp & 1)));
                o[cb] = MFMA16(cat8(v0, v1), bp, o[cb]);
            }
        }
        lrow += __shfl_xor(lrow, 16); lrow += __shfl_xor(lrow, 32);
        const float rl = 1.f / lrow;
        if (n < 8) {
#pragma unroll
            for (int cb = 0; cb < 8; ++cb) { u32x2 wv; wv.x = pk2(o[cb][0] * rl, o[cb][1] * rl); wv.y = pk2(o[cb][2] * rl, o[cb][3] * rl);
                *(LAS u32x2*)(QA + ((q * 8 + n) * 128 + 16 * cb + 4 * g) * 2) = wv; }
        }
    }
    __syncthreads();
    { const int h = wave;
      bf16x8 bo[8];
#pragma unroll
      for (int s = 0; s < 8; ++s) bo[s] = *(const LAS bf16x8*)(QA + ((r32 * 8 + h) * 128 + 16 * s + 8 * hi) * 2);
#pragma unroll
      for (int db = 0; db < 2; ++db) {
          f32x16 acc;
#pragma unroll
          for (int r = 0; r < 16; ++r) acc[r] = 0.f;
          const bf16_t* wp = F_WuvT + ((size_t)(h * 64 + db * 32 + r32) * 128 + hi * 8);
#pragma unroll
          for (int s = 0; s < 8; ++s) acc = MFMA32(*(const bf16x8*)(wp + 16 * s), bo[s], acc);
          bf16_t* op = F_O + (t0 + r32) * DM + h * 64 + 32 * db + 4 * hi;
#pragma unroll
          for (int r4 = 0; r4 < 4; ++r4) { u32x2 wv; wv.x = pk2(acc[4 * r4], acc[4 * r4 + 1]); wv.y = pk2(acc[4 * r4 + 2], acc[4 * r4 + 3]); *(u32x2*)(op + 8 * r4) = wv; }
      } }
    __syncthreads();
}
__device__ __forceinline__ void dsa_phase(Frame& F) {
    if (F.G != 256) return;
    const int b = F.vcu >> 5, s = F.vcu & 31;
    for (int j = 0; j < 4; ++j) { const int p = s + 32 * j;
        dsa_topk(F, b, 255 - p); dsa_attend(F, b, 255 - p);
        dsa_topk(F, b, p); dsa_attend(F, b, p); }
}

constexpr int N_PHASES = 12;
__global__ void __launch_bounds__(NTHREADS, 2) fwd_kernel(Args args) {
    extern __shared__ __attribute__((aligned(16))) unsigned char lds[];
    Frame F;
    F.lds = (LAS unsigned char*)lds;
    F.MISC = (volatile LAS unsigned*)(F.lds + MISC_OFF);
    F.tid = threadIdx.x; F.lane = F.tid & 63; F.wave = __builtin_amdgcn_readfirstlane(F.tid >> 6);
    F.G = gridDim.x; { const int bx = blockIdx.x; F.vcu = (F.G % 8 == 0) ? (bx % 8) * (F.G / 8) + bx / 8 : bx; }
    F.a = &args; F.ws = args.ws; F.ctl = (unsigned*)(args.ws + WS_CTL);
    for (int u = F.tid; u < (LDS_BYTES - MISC_OFF) / 4; u += NTHREADS) ((LAS unsigned*)(F.lds + MISC_OFF))[u] = 0u;
    __syncthreads();
    XcdBarrier bar; bar.bar = (unsigned*)(F.ctl + CW_BAR); bar.x = 0; bar.st = nullptr;
    if (!MK_SPLIT) bar = xcd_barrier_post((unsigned*)(F.ctl + CW_BAR), F.MISC + 8);
    const int lo = args.ph_lo, hi = args.ph_hi;
#ifndef PH_MASK
#define PH_MASK 0xfff
#endif
#define IN(k) (((PH_MASK >> (k)) & 1) && lo <= (k) && (k) < hi)
#define SEAM(k) do { if (IN(k) && IN((k) + 1)) xcd_barrier(bar); } while (0)

    if (IN(0)) { p0_mod(F); __syncthreads(); p0_weights(F); }
    SEAM(0);
    if (IN(1)) modnorm_rows(F, F_x, F_g_attn, 0, 1024, F_XN);
    SEAM(1);
    if (IN(2)) { pg8::StaticOrder S; S.init(NT, NPROJ, DM, F.G, (int)blockIdx.x); EpiProj E{F_DQ, F_FQ, F_FK, F_FV, F_DLAT, F_IQ, F_IK, F_IW};
        pg8::gemm_phase<EpiProj, pg8::StaticOrder, true>(F.lds, F_XN, F_Win, DM, S, E); }
    SEAM(2);
    if (IN(3)) { ckv_rows(F); diff_phase(F); }
    SEAM(3);
    if (IN(4)) dsa_phase(F);
    SEAM(4);
    if (IN(5)) { pg8::StaticOrder S; S.init(NT, DM, DM, F.G, (int)blockIdx.x); EpiX1 E{F_x, F_mod, F_out};
        pg8::gemm_phase<EpiX1, pg8::StaticOrder, true>(F.lds, F_O, F_Wout, DM, S, E); }
    SEAM(5);
    if (IN(6)) modnorm_rows(F, F_out, F_g_moe, 3072, 4096, F_XN);
    SEAM(6);
    if (IN(7)) { pg8::StaticOrder S; S.init(NT, 256, DM, F.G, (int)blockIdx.x); EpiLogits E{F_LOG, F_b_router, F_b_group};
        pg8::gemm_phase<EpiLogits, pg8::StaticOrder, false>(F.lds, F_XN, F_Wrt, DM, S, E); }
    SEAM(7);
    if (IN(8)) route_tokens(F);
    SEAM(8);
    if (IN(9)) { const MoeTab tab = moe_tables(F); MoeOrder<2, true> S{tab, F.G, (int)blockIdx.x, DM, F_TOK}; EpiUp E{F_HS};
        pg8::gemm_phase<EpiUp, MoeOrder<2, true>, true>(F.lds, F_XN, F_Wup, DM, S, E); }
    SEAM(9);
    if (IN(10)) { const MoeTab tab = moe_tables(F); MoeOrder<4, false> S{tab, F.G, (int)blockIdx.x, DEXP, F_TOK}; EpiDown E{F_YS, F_GL, tab.ecnt};
        pg8::gemm_phase<EpiDown, MoeOrder<4, false>, true>(F.lds, F_HS, F_Wdn, DEXP, S, E); }
    SEAM(10);
    if (IN(11)) { const MoeTab tab = moe_tables(F); combine_rows(F, tab); }
#undef IN
#undef SEAM
}

extern "C" void kernel_launch(void* const* d_in, const int* in_sizes, int n_in, void* d_out, int out_size, void* d_ws, size_t ws_size, hipStream_t stream) {
    static int grid = 0;
    if (grid == 0) {
        if (n_in != 24 || in_sizes[0] != NT * DM || out_size != NT * DM || ws_size < WS_END) { fprintf(stderr, "kernel_launch: unexpected problem (n_in %d, in0 %d, out %d, ws %zu)\n", n_in, n_in > 0 ? in_sizes[0] : -1, out_size, ws_size); grid = -1; return; }
        int dev = 0, cus = 0, per_cu = 0;
        if (hipGetDevice(&dev) != hipSuccess || hipDeviceGetAttribute(&cus, hipDeviceAttributeMultiprocessorCount, dev) != hipSuccess) { grid = -1; return; }
        if (hipFuncSetAttribute((const void*)fwd_kernel, hipFuncAttributeMaxDynamicSharedMemorySize, LDS_BYTES) != hipSuccess) { fprintf(stderr, "kernel_launch: hipFuncSetAttribute failed\n"); grid = -1; return; }
        if (hipOccupancyMaxActiveBlocksPerMultiprocessor(&per_cu, (const void*)fwd_kernel, NTHREADS, LDS_BYTES) != hipSuccess || per_cu < 1) { fprintf(stderr, "kernel_launch: occupancy query reports %d\n", per_cu); }
        (void)hipGetLastError();
        grid = cus;
    }
    if (grid < 0) return;
    if (hipMemsetAsync((char*)d_ws + WS_CTL, 0, CTL_ZERO_BYTES, stream) != hipSuccess) return;
    Args a{};
    for (int i = 0; i < 24; ++i) a.in[i] = (const float*)d_in[i];
    a.out = (float*)d_out; a.ws = (unsigned char*)d_ws;
#if MK_SPLIT
    for (int p = 0; p < N_PHASES; ++p) { a.ph_lo = p; a.ph_hi = p + 1; hipLaunchKernelGGL(fwd_kernel, dim3(grid), dim3(NTHREADS), LDS_BYTES, stream, a); }
#else
    a.ph_lo = 0; a.ph_hi = N_PHASES;
    hipLaunchKernelGGL(fwd_kernel, dim3(grid), dim3(NTHREADS), LDS_BYTES, stream, a);
#endif
}
```

```cpp
#include <hip/hip_runtime.h>
#include <cstdio>
#include <cstdint>

#define LAS __attribute__((address_space(3)))
#define GAS __attribute__((address_space(1)))
typedef unsigned short bf16_t;
typedef short bf16x8 __attribute__((ext_vector_type(8)));
typedef short s16x4 __attribute__((ext_vector_type(4)));
typedef float f32x2 __attribute__((ext_vector_type(2)));
typedef float f32x4 __attribute__((ext_vector_type(4)));
typedef float f32x16 __attribute__((ext_vector_type(16)));
typedef unsigned u32x2 __attribute__((ext_vector_type(2)));
typedef unsigned u32x4 __attribute__((ext_vector_type(4)));
typedef __bf16 bf16x2_t __attribute__((ext_vector_type(2)));

#ifndef MK_SPLIT
#define MK_SPLIT 0
#endif

constexpr int NB = 8, SEQ = 8192, NT = NB * SEQ, DM = 1024;
constexpr int NPROJ = 2560;
constexpr int NEXP = 32, DEXP = 256;
constexpr int PMAX = 2 * NT + NEXP * 256;
constexpr float LOG2E = 1.4426950408889634f;
constexpr float RMS_EPS = 1e-6f;
constexpr float DIFF_C2 = 0.125f * LOG2E;
constexpr float IW_SCALE = 0.5f * 0.17677669529663687f;
constexpr int NWAVES = 8, NTHREADS = 512;

constexpr size_t MiB = 1u << 20;
constexpr size_t WS_CTL = 0, CTL_ZERO_BYTES = 128 * 1024;
constexpr size_t WS_MOD = 1 * MiB;
constexpr size_t WS_KN2 = 1 * MiB + 512 * 1024;
constexpr size_t WS_WIN = 2 * MiB;
constexpr size_t WS_WOUT = 8 * MiB;
constexpr size_t WS_WRT = 10 * MiB;
constexpr size_t WS_WUK = 11 * MiB;
constexpr size_t WS_WUVT = 11 * MiB + 512 * 1024;
constexpr size_t WS_WUP = 12 * MiB;
constexpr size_t WS_WDN = 44 * MiB;
constexpr size_t WS_XN = 64 * MiB;
constexpr size_t WS_DQ = 192 * MiB, WS_FQ = 256 * MiB, WS_FK = 320 * MiB, WS_FV = 384 * MiB;
constexpr size_t WS_YS = 192 * MiB;
constexpr size_t WS_O = 464 * MiB;
constexpr size_t WS_DLAT = 592 * MiB;
constexpr size_t WS_CKV = 608 * MiB;
constexpr size_t WS_IQ = 624 * MiB;
constexpr size_t WS_IK = 640 * MiB;
constexpr size_t WS_IW = 644 * MiB;
constexpr size_t WS_LOG = 646 * MiB;
constexpr size_t WS_REID = 662 * MiB;
constexpr size_t WS_RSLOT = 663 * MiB;
constexpr size_t WS_TOK = 664 * MiB;
constexpr size_t WS_GL = 672 * MiB;
constexpr size_t WS_HS = 680 * MiB;
constexpr size_t WS_END = 752 * MiB;
static_assert(WS_YS + (size_t)PMAX * 2048 <= WS_O && WS_HS + (size_t)PMAX * 512 <= WS_END, "d_ws map");
constexpr int CW_BAR = 4096;
constexpr int CW_ECNT = 16384;
constexpr int CW_WQ = 20480;

constexpr int LDS_BYTES = 155648;
constexpr int MISC_OFF = LDS_BYTES - 512;

__device__ __forceinline__ unsigned f2bf(float f) { unsigned u = __builtin_bit_cast(unsigned, f); return (u + 0x7fffu + ((u >> 16) & 1u)) >> 16; }
__device__ __forceinline__ unsigned pk2(float lo, float hi) { f32x2 v = {lo, hi}; bf16x2_t b = __builtin_convertvector(v, bf16x2_t); return __builtin_bit_cast(unsigned, b); }
__device__ __forceinline__ float bf2f(unsigned short h) { return __builtin_bit_cast(float, (unsigned)h << 16); }
__device__ __forceinline__ float bflo(unsigned w) { return __builtin_bit_cast(float, w << 16); }
__device__ __forceinline__ float bfhi(unsigned w) { return __builtin_bit_cast(float, w & 0xffff0000u); }
__device__ __forceinline__ int crow(int r, int hi) { return (r & 3) + 8 * (r >> 2) + 4 * hi; }
__device__ __forceinline__ unsigned off_b(unsigned row, unsigned ch) { return 256u * row + 16u * (ch ^ (((row & 3u) << 2) | ((row >> 2) & 3u))); }
__device__ __forceinline__ float wave_sum(float v) {
#pragma unroll
    for (int o = 1; o < 64; o <<= 1) v += __shfl_xor(v, o);
    return v;
}
#define LDS_WAIT() asm volatile("s_waitcnt lgkmcnt(0)" ::: "memory")
#define VM_WAIT() asm volatile("s_waitcnt vmcnt(0)" ::: "memory")
#define MFMA32(a, b, c) __builtin_amdgcn_mfma_f32_32x32x16_bf16((a), (b), (c), 0, 0, 0)
#define MFMA16(a, b, c) __builtin_amdgcn_mfma_f32_16x16x32_bf16((a), (b), (c), 0, 0, 0)
__device__ __forceinline__ s16x4 tr_read(LAS const char* p) { return __builtin_bit_cast(s16x4, __builtin_amdgcn_ds_read_tr16_b64_v4i16((LAS s16x4*)p)); }
__device__ __forceinline__ bf16x8 cat8(s16x4 a, s16x4 b) { return (bf16x8){a[0], a[1], a[2], a[3], b[0], b[1], b[2], b[3]}; }

namespace pg8 {
constexpr int BM = 256, BK = 64, HALF = 128, HTB = HALF * BK * 2, STAGE_BYTES = 8 * HTB, NXCD = 8, WGM = 8;
__device__ __forceinline__ int lds_byte(int r, int c) { const int st = (r >> 4) * 2 + (c >> 5), rr = r & 15, cc = c & 31, ob = rr * 64 + cc * 2; return st * 1024 + (ob ^ (((ob >> 9) & 1) << 5)); }
__device__ __forceinline__ void stage_rc(int b, int& R, int& C) { const int st = b / 1024, sb = b % 1024, swz = sb ^ (((sb >> 9) & 1) << 5); R = (st >> 1) * 16 + swz / 64; C = (st & 1) * 32 + (swz % 64) / 2; }
__device__ __forceinline__ int perm32(int rho) { const int n = rho >> 4, i = rho & 15; return 8 * (i >> 2) + 4 * n + (i & 3); }

struct Unit { int pm, pn, a0, a1; };

struct StaticOrder {
    int nM, nN, nwg, G, c, K;
    __device__ void init(int M, int N, int K_, int G_, int c_) { nM = M / BM; nN = N / BM; nwg = nM * nN; G = G_; c = c_; K = K_; }
    __device__ bool next(int i, Unit& u) const {
        const long L = (long)i * G + c; if (L >= nwg) return false;
        int wgid = (int)L; { const int q = nwg / NXCD, r = nwg % NXCD, xcd = wgid % NXCD, off = wgid / NXCD; wgid = (xcd < r ? xcd * (q + 1) : r * (q + 1) + (xcd - r) * q) + off; }
        const int nig = WGM * nN, gid = wgid / nig, fm = gid * WGM, gsz = (nM - fm) < WGM ? (nM - fm) : WGM;
        u.pm = fm + ((wgid % nig) % gsz); u.pn = (wgid % nig) / gsz; u.a0 = 0; u.a1 = 0; return true;
    }
    __device__ __forceinline__ unsigned a_off(const Unit& u, int R) const { return (unsigned)(u.pm * BM + R) * (unsigned)(K * 2); }
};

template <class Epi, class Sched, bool ALIGN_EPI>
__device__ __forceinline__ void gemm_phase(LAS unsigned char* lds, const bf16_t* Ap, const bf16_t* Btp, const int K, const Sched& S, const Epi& E) {
    const int tid = threadIdx.x, wid = __builtin_amdgcn_readfirstlane(tid >> 6), lane = tid & 63, wr = wid >> 2, wc = wid & 3, fr = lane & 15, fq = lane >> 4;
    const int nt = K / BK;
    int RA[2], CA[2]; unsigned voffB[2];
#pragma unroll
    for (int i = 0; i < 2; ++i) { int R, C; stage_rc(tid * 16 + i * 8192, R, C); const int Rb = Epi::PERM ? ((R & ~31) + perm32(R & 31)) : R;
        RA[i] = R; CA[i] = C * 2; voffB[i] = (unsigned)(Rb * K + C) * 2u; }
    const size_t kstep = (size_t)(BK * 2);
    const size_t hstep = (size_t)HALF * K * 2;
    const size_t tstep = 2 * hstep;
    const unsigned ldsw = (unsigned)wid * 1024u;
    const int aoff = lds_byte(wr * 64 + fr, fq * 8), boff = lds_byte(wc * 32 + fr, fq * 8);
#define PG8_SA(b, h) (((b) * 2 + (h)) * HTB)
#define PG8_SB(b, h) ((4 + (b) * 2 + (h)) * HTB)
#define PG8_STAGE_B(bufoff, gbase) do { _Pragma("unroll") for (int _i = 0; _i < 2; ++_i) \
        __builtin_amdgcn_global_load_lds((const unsigned*)((const char*)(gbase) + voffB[_i]), (LAS unsigned*)(lds + (bufoff) + ldsw + _i * 8192), 16, 0, 0); } while (0)
#define PG8_STAGE_A(bufoff, offs, h, kb) do { _Pragma("unroll") for (int _i = 0; _i < 2; ++_i) \
        __builtin_amdgcn_global_load_lds((const unsigned*)((const char*)Ap + (size_t)(offs)[h][_i] + (size_t)(kb)), (LAS unsigned*)(lds + (bufoff) + ldsw + _i * 8192), 16, 0, 0); } while (0)
#define PG8_LDA(dst, b, h) do { _Pragma("unroll") for (int m = 0; m < 4; ++m) _Pragma("unroll") for (int k = 0; k < 2; ++k) dst[m][k] = *(const LAS bf16x8*)(lds + PG8_SA(b, h) + aoff + m * 2048 + k * 1024); } while (0)
#define PG8_LDB(dst, b, h) do { _Pragma("unroll") for (int n = 0; n < 2; ++n) _Pragma("unroll") for (int k = 0; k < 2; ++k) dst[n][k] = *(const LAS bf16x8*)(lds + PG8_SB(b, h) + boff + n * 2048 + k * 1024); } while (0)
#define PG8_MMA(ai, bj, At, Bt) do { __builtin_amdgcn_s_setprio(1); _Pragma("unroll") for (int m = 0; m < 4; ++m) _Pragma("unroll") for (int n = 0; n < 2; ++n) _Pragma("unroll") for (int k = 0; k < 2; ++k) \
        acc[ai][bj][m][n] = __builtin_amdgcn_mfma_f32_16x16x32_bf16(Bt[n][k], At[m][k], acc[ai][bj][m][n], 0, 0, 0); __builtin_amdgcn_s_setprio(0); } while (0)
#define PG8_WAIT_V(n) asm volatile("s_waitcnt vmcnt(" #n ")" ::: "memory")
#define PG8_WAIT_L(n) asm volatile("s_waitcnt lgkmcnt(" #n ")" ::: "memory")
#define PG8_BAR __builtin_amdgcn_s_barrier()
#define PG8_SCHED __builtin_amdgcn_sched_barrier(0)
#define PG8_OFFS(dst, u) do { _Pragma("unroll") for (int _h = 0; _h < 2; ++_h) _Pragma("unroll") for (int _i = 0; _i < 2; ++_i) dst[_h][_i] = S.a_off(u, _h * HALF + RA[_i]) + (unsigned)CA[_i]; } while (0)
    Unit cur, nxt; int ui = 0;
    if (!S.next(0, cur)) return;
    f32x4 acc[2][2][4][2];
#pragma unroll
    for (int a = 0; a < 2; ++a)
#pragma unroll
        for (int b = 0; b < 2; ++b)
#pragma unroll
            for (int m = 0; m < 4; ++m)
#pragma unroll
                for (int n = 0; n < 2; ++n) acc[a][b][m][n] = (f32x4){0.f, 0.f, 0.f, 0.f};
    bf16x8 At[4][2], B0[2][2], B1[2][2];
    unsigned offc[2][2], offn[2][2];
    PG8_OFFS(offc, cur);
    const char* cB = (const char*)Btp + (size_t)cur.pn * tstep;
    PG8_STAGE_B(PG8_SB(0, 0), cB); PG8_STAGE_B(PG8_SB(0, 1), cB + hstep); PG8_STAGE_A(PG8_SA(0, 0), offc, 0, 0); PG8_STAGE_A(PG8_SA(0, 1), offc, 1, 0);
    if (wr == 1) PG8_BAR;
    PG8_WAIT_V(2); PG8_BAR;
    PG8_STAGE_B(PG8_SB(1, 0), cB + kstep); PG8_STAGE_A(PG8_SA(1, 0), offc, 0, kstep); PG8_STAGE_B(PG8_SB(1, 1), cB + hstep + kstep);
    PG8_WAIT_V(6); PG8_BAR;
    for (;;) {
        const bool has_next = S.next(ui + 1, nxt);
        if (has_next) { PG8_OFFS(offn, nxt); }
        else {
#pragma unroll
            for (int _h = 0; _h < 2; ++_h)
#pragma unroll
                for (int _i = 0; _i < 2; ++_i) offn[_h][_i] = offc[_h][_i];
        }
        const char* nB = has_next ? (const char*)Btp + (size_t)nxt.pn * tstep : cB;
#pragma unroll 1
        for (int t = 0; t < nt; t += 2) {
            const bool last = (t == nt - 2);
            const size_t k1 = (size_t)(t + 1) * kstep;
            const size_t k2 = last ? 0 : (size_t)(t + 2) * kstep, k3 = k2 + kstep;
            unsigned o2[2][2];
#pragma unroll
            for (int _h = 0; _h < 2; ++_h)
#pragma unroll
                for (int _i = 0; _i < 2; ++_i) o2[_h][_i] = last ? offn[_h][_i] : offc[_h][_i];
            const char* b2 = last ? nB : cB + (size_t)(t + 2) * kstep; const char* b3 = b2 + kstep;
            PG8_LDB(B0, 0, 0); PG8_LDB(B1, 0, 1); PG8_SCHED; PG8_LDA(At, 0, 0); PG8_STAGE_A(PG8_SA(1, 1), offc, 1, k1);
            PG8_WAIT_V(8); PG8_WAIT_L(0); PG8_BAR; PG8_MMA(0, 0, At, B0); PG8_MMA(0, 1, At, B1); PG8_BAR; PG8_SCHED;
            PG8_LDA(At, 0, 1); PG8_STAGE_B(PG8_SB(0, 0), b2); PG8_STAGE_B(PG8_SB(0, 1), b2 + hstep); PG8_STAGE_A(PG8_SA(0, 0), o2, 0, k2);
            PG8_WAIT_V(8); PG8_WAIT_L(0); PG8_BAR; PG8_MMA(1, 0, At, B0); PG8_MMA(1, 1, At, B1); PG8_BAR; PG8_SCHED;
            PG8_LDB(B0, 1, 0); PG8_LDB(B1, 1, 1); PG8_SCHED; PG8_LDA(At, 1, 0); PG8_STAGE_A(PG8_SA(0, 1), o2, 1, k2);
            PG8_WAIT_V(8); PG8_WAIT_L(0); PG8_BAR; PG8_MMA(0, 0, At, B0); PG8_MMA(0, 1, At, B1); PG8_BAR; PG8_SCHED;
            PG8_LDA(At, 1, 1); PG8_STAGE_B(PG8_SB(1, 0), b3); PG8_STAGE_B(PG8_SB(1, 1), b3 + hstep); PG8_STAGE_A(PG8_SA(1, 0), o2, 0, k3);
            PG8_WAIT_V(8); PG8_WAIT_L(0); PG8_BAR; PG8_MMA(1, 0, At, B0); PG8_MMA(1, 1, At, B1); PG8_BAR; PG8_SCHED;
        }
        if constexpr (ALIGN_EPI) { if (wr == 0) PG8_BAR; }
        E(acc, cur, wr, wc, fr, fq);
        if (!has_next) break;
#pragma unroll
        for (int a = 0; a < 2; ++a)
#pragma unroll
            for (int b = 0; b < 2; ++b)
#pragma unroll
                for (int m = 0; m < 4; ++m)
#pragma unroll
                    for (int n = 0; n < 2; ++n) acc[a][b][m][n] = (f32x4){0.f, 0.f, 0.f, 0.f};
        cur = nxt; cB = nB; ++ui;
#pragma unroll
        for (int _h = 0; _h < 2; ++_h)
#pragma unroll
            for (int _i = 0; _i < 2; ++_i) offc[_h][_i] = offn[_h][_i];
        if constexpr (ALIGN_EPI) { if (wr == 1) PG8_BAR; }
    }
    PG8_WAIT_V(0);
    if constexpr (!ALIGN_EPI) { if (wr == 0) PG8_BAR; }
    PG8_BAR;
#undef PG8_SA
#undef PG8_SB
#undef PG8_STAGE_A
#undef PG8_STAGE_B
#undef PG8_LDA
#undef PG8_LDB
#undef PG8_MMA
#undef PG8_WAIT_V
#undef PG8_WAIT_L
#undef PG8_BAR
#undef PG8_SCHED
#undef PG8_OFFS
}
}

#define XB_TMO      128
#define XB_XCNT(j)  (256  + 64 * (j))
#define XB_XSUB(j)  (1280 + 64 * (j))
#define XB_XGEN(j)  (2304 + 64 * (j))
#define XB_TOP      3328
#define XB_TOPGEN   3392
#define XCD_BAR_WORDS 3456
#define XB_SPIN_CAP (1u << 18)
__device__ __forceinline__ unsigned xb_ld(unsigned* p)              { return __hip_atomic_load(p, __ATOMIC_RELAXED, __HIP_MEMORY_SCOPE_AGENT); }
__device__ __forceinline__ unsigned xb_add(unsigned* p, unsigned v) { return __hip_atomic_fetch_add(p, v, __ATOMIC_RELAXED, __HIP_MEMORY_SCOPE_AGENT); }
__device__ __forceinline__ unsigned xb_xcc_id() { return (unsigned)__builtin_amdgcn_s_getreg((3 << 11) | 20) & 0xFu; }
#define XB_SPIN(cond, bar) do { unsigned _sp = 0; while (cond) { __builtin_amdgcn_s_sleep(1); \
    if ((++_sp & 255u) == 0u) { if (xb_ld(&(bar)[XB_TMO])) break; if (_sp > XB_SPIN_CAP) { atomicAdd(&(bar)[XB_TMO], 1u); break; } } } } while (0)
struct XcdBarrier { unsigned* bar; unsigned x; volatile LAS unsigned* st; };
__device__ __forceinline__ XcdBarrier xcd_barrier_post(unsigned* bar, volatile LAS unsigned* st) {
    XcdBarrier b; b.bar = bar; b.x = xb_xcc_id(); b.st = st;
    if (threadIdx.x == 0) (void)xb_add(&bar[XB_XCNT(b.x)], 1u);
    return b;
}
__device__ __forceinline__ void xcd_barrier_complete(unsigned* bar, unsigned x, unsigned& nloc, unsigned& nx) {
    const unsigned G = gridDim.x * gridDim.y * gridDim.z;
    unsigned sum, cnt, mine, sp = 0u;
    for (;;) {
        sum = 0u; cnt = 0u; mine = 0u;
#pragma unroll
        for (unsigned j = 0; j < 16; ++j) { const unsigned c = xb_ld(&bar[XB_XCNT(j)]); sum += c; cnt += (c > 0u) ? 1u : 0u; mine = (j == x) ? c : mine; }
        if (sum == G) break;
        __builtin_amdgcn_s_sleep(1);
        if ((++sp & 255u) == 0u) { if (xb_ld(&bar[XB_TMO])) break; if (sp > XB_SPIN_CAP) { atomicAdd(&bar[XB_TMO], 1u); break; } }
    }
    nloc = mine > 0u ? mine : 1u; nx = cnt > 0u ? cnt : 1u;
}
__device__ __forceinline__ void xcd_barrier(const XcdBarrier& b) {
    asm volatile("s_waitcnt vmcnt(0)" ::: "memory");
    __syncthreads();
    if (threadIdx.x == 0) {
        unsigned* bar = b.bar;
        __builtin_amdgcn_s_waitcnt(0);
        unsigned nloc = b.st[0], nx = b.st[1];
        if (nloc == 0u) { xcd_barrier_complete(bar, b.x, nloc, nx); b.st[0] = nloc; b.st[1] = nx; }
        const unsigned old = xb_add(&bar[XB_XSUB(b.x)], 1u);
        const unsigned gen = old / nloc;
        if (old + 1u == (gen + 1u) * nloc) {
            __builtin_amdgcn_fence(__ATOMIC_RELEASE, "agent");
            asm volatile("s_waitcnt vmcnt(0)" ::: "memory");
            const unsigned og = xb_add(&bar[XB_TOP], 1u);
            const unsigned tg = og / nx;
            if (og + 1u == (tg + 1u) * nx) xb_add(&bar[XB_TOPGEN], 1u);
            else XB_SPIN(xb_ld(&bar[XB_TOPGEN]) == tg, bar);
            __builtin_amdgcn_fence(__ATOMIC_ACQUIRE, "agent");
            xb_add(&bar[XB_XGEN(b.x)], 1u);
            asm volatile("s_waitcnt vmcnt(0)" ::: "memory");
        } else {
            XB_SPIN(xb_ld(&bar[XB_XGEN(b.x)]) == gen, bar);
            __builtin_amdgcn_fence(__ATOMIC_ACQUIRE, "agent");
            asm volatile("s_waitcnt vmcnt(0)" ::: "memory");
        }
    }
    __syncthreads();
}

struct Args { const float* in[24]; float* out; unsigned char* ws; int ph_lo, ph_hi; };
struct Frame {
    LAS unsigned char* lds;
    volatile LAS unsigned* MISC;
    const Args* a;
    unsigned char* ws;
    unsigned* ctl;
    int tid, lane, wave, vcu, G;
};
#define FIN(i) (F.a->in[i])
#define F_x FIN(0)
#define F_c FIN(1)
#define F_w_ada FIN(2)
#define F_b_ada FIN(3)
#define F_g_attn FIN(4)
#define F_w_in FIN(5)
#define F_g_kv FIN(6)
#define F_w_uk FIN(7)
#define F_w_uv FIN(8)
#define F_lq1 FIN(9)
#define F_lk1 FIN(10)
#define F_lq2 FIN(11)
#define F_lk2 FIN(12)
#define F_g_sub FIN(13)
#define F_w_out FIN(14)
#define F_g_moe FIN(15)
#define F_w_group FIN(16)
#define F_b_group FIN(17)
#define F_w_router FIN(18)
#define F_b_router FIN(19)
#define F_w_gate FIN(20)
#define F_w_up FIN(21)
#define F_w_down FIN(22)
#define F_g_final FIN(23)
#define F_out (F.a->out)
#define F_mod ((float*)(F.ws + WS_MOD))
#define F_Win ((bf16_t*)(F.ws + WS_WIN))
#define F_Wout ((bf16_t*)(F.ws + WS_WOUT))
#define F_Wrt ((bf16_t*)(F.ws + WS_WRT))
#define F_Wuk ((bf16_t*)(F.ws + WS_WUK))
#define F_WuvT ((bf16_t*)(F.ws + WS_WUVT))
#define F_Wup ((bf16_t*)(F.ws + WS_WUP))
#define F_Wdn ((bf16_t*)(F.ws + WS_WDN))
#define F_XN ((bf16_t*)(F.ws + WS_XN))
#define F_DQ ((bf16_t*)(F.ws + WS_DQ))
#define F_FQ ((bf16_t*)(F.ws + WS_FQ))
#define F_FK ((bf16_t*)(F.ws + WS_FK))
#define F_FV ((bf16_t*)(F.ws + WS_FV))
#define F_YS ((bf16_t*)(F.ws + WS_YS))
#define F_O ((bf16_t*)(F.ws + WS_O))
#define F_DLAT ((bf16_t*)(F.ws + WS_DLAT))
#define F_CKV ((bf16_t*)(F.ws + WS_CKV))
#define F_IQ ((bf16_t*)(F.ws + WS_IQ))
#define F_IK ((bf16_t*)(F.ws + WS_IK))
#define F_HS ((bf16_t*)(F.ws + WS_HS))
#define F_IW ((float*)(F.ws + WS_IW))
#define F_LOG ((float*)(F.ws + WS_LOG))
#define F_GL ((float*)(F.ws + WS_GL))
#define F_REID ((int*)(F.ws + WS_REID))
#define F_RSLOT ((int*)(F.ws + WS_RSLOT))
#define F_TOK ((int*)(F.ws + WS_TOK))

__device__ __forceinline__ void p0_mod(Frame& F) {
    LAS float* ca = (LAS float*)(F.lds);
    LAS float* red = (LAS float*)(F.lds + 32768);
    for (int i = F.tid; i < NB * DM; i += NTHREADS) { const float v = F_c[i]; ca[i] = v / (1.f + __expf(-v)); }
    __syncthreads();
    const int kr = F.lane >> 3, c4 = F.lane & 7;
    for (int item = blockIdx.x; item < 192; item += F.G) {
        const int n0 = item * 32;
        float acc[4][8];
#pragma unroll
        for (int j = 0; j < 4; ++j)
#pragma unroll
            for (int b = 0; b < 8; ++b) acc[j][b] = 0.f;
#pragma unroll 4
        for (int it = 0; it < 16; ++it) {
            const int k = F.wave * 128 + it * 8 + kr;
            const f32x4 w = *(const f32x4*)(F_w_ada + (size_t)k * 6144 + n0 + c4 * 4);
#pragma unroll
            for (int b = 0; b < 8; ++b) { const float cv = ca[b * DM + k];
#pragma unroll
                for (int j = 0; j < 4; ++j) acc[j][b] += w[j] * cv; }
        }
#pragma unroll
        for (int j = 0; j < 4; ++j)
#pragma unroll
            for (int b = 0; b < 8; ++b) { float v = acc[j][b]; v += __shfl_xor(v, 8); v += __shfl_xor(v, 16); v += __shfl_xor(v, 32);
                if (kr == 0) red[(F.wave * 32 + c4 * 4 + j) * 8 + b] = v; }
        __syncthreads();
        if (F.tid < 256) { const int col = F.tid >> 3, b = F.tid & 7; float s = 0.f;
#pragma unroll
            for (int w = 0; w < 8; ++w) s += red[(w * 32 + col) * 8 + b];
            F_mod[b * 6144 + n0 + col] = s + F_b_ada[n0 + col]; }
        __syncthreads();
    }
}
__device__ __forceinline__ void tr_block(const float* W, int ldw, int k0, int c0, int nv, bf16_t* WT, int ldt, int r0, LAS float* scr, int lane) {
#pragma unroll 8
    for (int i = 0; i < 32; ++i) { const int kk = 2 * i + (lane >> 5), n = lane & 31; scr[kk * 33 + n] = (n < nv) ? W[(size_t)(k0 + kk) * ldw + c0 + n] : 0.f; }
    LDS_WAIT(); asm volatile("" ::: "memory");
    const int c = lane & 7;
#pragma unroll
    for (int j = 0; j < 4; ++j) { const int n = (lane >> 3) + 8 * j; const LAS float* s = scr + (8 * c) * 33 + n;
        u32x4 o; o.x = pk2(s[0 * 33], s[1 * 33]); o.y = pk2(s[2 * 33], s[3 * 33]); o.z = pk2(s[4 * 33], s[5 * 33]); o.w = pk2(s[6 * 33], s[7 * 33]);
        *(u32x4*)(WT + (size_t)(r0 + n) * ldt + k0 + 8 * c) = o; }
    LDS_WAIT(); asm volatile("" ::: "memory");
}
__device__ __forceinline__ void p0_weights(Frame& F) {
    LAS float* scr = (LAS float*)(F.lds + F.wave * 16384);
    const int gw = F.vcu * NWAVES + F.wave, NGW = F.G * NWAVES;
    constexpr int I_IN = 16 * 80, I_OUT = 16 * 32, I_RT = 16 * 8, I_UV = 32, I_UP = 32 * 2 * 2 * 4 * 16, I_DN = 32 * 4 * 32;
    constexpr int NITEMS = I_IN + I_OUT + I_RT + I_UV + I_UP + I_DN;
    for (int it = gw; it < NITEMS; it += NGW) {
        int r = it;
        if (r < I_IN) { const int kb = r / 80, nb = r % 80, n0 = nb * 32; int c0 = 0, nv = 32;
            if (n0 < 512) c0 = n0; else if (n0 < 1024) c0 = 804 + (n0 - 512); else if (n0 < 1536) c0 = 1316 + (n0 - 1024); else if (n0 < 2048) c0 = 1828 + (n0 - 1536);
            else if (n0 < 2176) c0 = 512 + (n0 - 2048); else if (n0 < 2304) c0 = 640 + (n0 - 2176); else if (n0 == 2304) c0 = 768; else if (n0 == 2336) { c0 = 800; nv = 4; } else { c0 = 0; nv = 0; }
            tr_block(F_w_in, 2340, kb * 64, c0, nv, F_Win, DM, n0, scr, F.lane); continue; } r -= I_IN;
        if (r < I_OUT) { const int kb = r / 32, nb = r % 32; tr_block(F_w_out, DM, kb * 64, nb * 32, 32, F_Wout, DM, nb * 32, scr, F.lane); continue; } r -= I_OUT;
        if (r < I_RT) { const int kb = r / 8, nb = r % 8;
            if (nb == 0) tr_block(F_w_router, 32, kb * 64, 0, 32, F_Wrt, DM, 0, scr, F.lane);
            else if (nb == 1) tr_block(F_w_group, 4, kb * 64, 0, 4, F_Wrt, DM, 32, scr, F.lane);
            else tr_block(F_w_group, 4, kb * 64, 0, 0, F_Wrt, DM, nb * 32, scr, F.lane);
            continue; } r -= I_RT;
        if (r < I_UV) { const int h = r >> 2, kb = (r >> 1) & 1, nb = r & 1; tr_block(F_w_uv + h * 8192, 64, kb * 64, nb * 32, 32, F_WuvT + h * 8192, 128, nb * 32, scr, F.lane); continue; } r -= I_UV;
        if (r < I_UP) { const int kb = r & 15, nb4 = (r >> 4) & 3, gu = (r >> 6) & 1, jt = (r >> 7) & 1, e = r >> 8;
            tr_block((gu ? F_w_up : F_w_gate) + (size_t)e * 262144, 256, kb * 64, jt * 128 + nb4 * 32, 32, F_Wup, DM, e * 512 + jt * 256 + gu * 128 + nb4 * 32, scr, F.lane); continue; } r -= I_UP;
        { const int nb = r & 31, kb = (r >> 5) & 3, e = r >> 7;
            tr_block(F_w_down + (size_t)e * 262144, DM, kb * 64, nb * 32, 32, F_Wdn + (size_t)e * 262144, 256, nb * 32, scr, F.lane); }
    }
    for (int i = (blockIdx.x * NTHREADS + F.tid) * 4; i < 65536; i += F.G * NTHREADS * 4) { const f32x4 v = *(const f32x4*)(F_w_uk + i); u32x2 o; o.x = pk2(v[0], v[1]); o.y = pk2(v[2], v[3]); *(u32x2*)(F_Wuk + i) = o; }
}

__device__ __forceinline__ void modnorm_rows(Frame& F, const float* src, const float* g, int shift_off, int scale_off, bf16_t* dst) {
    const int gw = F.vcu * NWAVES + F.wave, NGW = F.G * NWAVES;
    for (int m = gw; m < NT; m += 2 * NGW) {
        const int m2 = m + NGW; const bool has2 = m2 < NT; const int mb = has2 ? m2 : m;
        const f32x4* xr = (const f32x4*)(src + (size_t)m * DM) + F.lane; const f32x4* xr2 = (const f32x4*)(src + (size_t)mb * DM) + F.lane;
        f32x4 v[4], u[4]; float s = 0.f, s2 = 0.f;
#pragma unroll
        for (int j = 0; j < 4; ++j) { v[j] = xr[64 * j]; u[j] = xr2[64 * j]; }
#pragma unroll
        for (int j = 0; j < 4; ++j) { s += (v[j].x * v[j].x + v[j].y * v[j].y) + (v[j].z * v[j].z + v[j].w * v[j].w); s2 += (u[j].x * u[j].x + u[j].y * u[j].y) + (u[j].z * u[j].z + u[j].w * u[j].w); }
#pragma unroll
        for (int o = 1; o < 64; o <<= 1) { s += __shfl_xor(s, o); s2 += __shfl_xor(s2, o); }
        const float rstd = 1.f / sqrtf(s * (1.f / DM) + RMS_EPS), rstd2 = 1.f / sqrtf(s2 * (1.f / DM) + RMS_EPS);
        const int b = m / SEQ, b2 = mb / SEQ;
        u32x2* o8 = (u32x2*)(dst + (size_t)m * DM) + F.lane; u32x2* o82 = (u32x2*)(dst + (size_t)mb * DM) + F.lane;
#pragma unroll
        for (int j = 0; j < 4; ++j) {
            const f32x4 gg = *((const f32x4*)g + F.lane + 64 * j);
            { const f32x4 sc = *((const f32x4*)(F_mod + b * 6144 + scale_off) + F.lane + 64 * j); const f32x4 sh = *((const f32x4*)(F_mod + b * 6144 + shift_off) + F.lane + 64 * j);
              const f32x4 y = (v[j] * rstd) * gg * (sc + 1.f) + sh; u32x2 o; o.x = pk2(y.x, y.y); o.y = pk2(y.z, y.w); o8[64 * j] = o; }
            if (has2) { const f32x4 sc = *((const f32x4*)(F_mod + b2 * 6144 + scale_off) + F.lane + 64 * j); const f32x4 sh = *((const f32x4*)(F_mod + b2 * 6144 + shift_off) + F.lane + 64 * j);
              const f32x4 y = (u[j] * rstd2) * gg * (sc + 1.f) + sh; u32x2 o; o.x = pk2(y.x, y.y); o.y = pk2(y.z, y.w); o82[64 * j] = o; }
        }
    }
}
__device__ __forceinline__ void ckv_rows(Frame& F) {
    const int gw = F.vcu * NWAVES + F.wave, NGW = F.G * NWAVES;
    const int sub = F.lane >> 5, l32 = F.lane & 31;
    const f32x4 gg = *((const f32x4*)F_g_kv + l32);
    for (int it = gw; it < NT / 2; it += NGW) {
        const size_t row = (size_t)it * 2 + sub;
        const u32x2 w = *((const u32x2*)(F_DLAT + row * 128) + l32);
        const float a = bflo(w.x), b = bfhi(w.x), c = bflo(w.y), d = bfhi(w.y);
        float s = (a * a + b * b) + (c * c + d * d);
#pragma unroll
        for (int o = 1; o < 32; o <<= 1) s += __shfl_xor(s, o);
        const float rstd = 1.f / sqrtf(s * (1.f / 128.f) + RMS_EPS);
        u32x2 o; o.x = pk2(a * rstd * gg.x, b * rstd * gg.y); o.y = pk2(c * rstd * gg.z, d * rstd * gg.w);
        *((u32x2*)(F_CKV + row * 128) + l32) = o;
    }
}

struct EpiProj {
    static constexpr bool PERM = true;
    bf16_t *DQ, *FQ, *FK, *FV, *DLAT, *IQ, *IK; float* IW;
    __device__ __forceinline__ void operator()(const f32x4 (&acc)[2][2][4][2], const pg8::Unit& u, int wr, int wc, int fr, int fq) const {
        const int row0 = u.pm * 256 + wr * 64 + fr;
#pragma unroll
        for (int bj = 0; bj < 2; ++bj) {
            const int sg = 2 * u.pn + bj;
            if (sg < 18) {
                bf16_t* base; int ld, col; float sc = 1.f;
                if (sg < 16) { const int t = sg >> 2; base = (t == 0) ? DQ : (t == 1) ? FQ : (t == 2) ? FK : FV; ld = 512; col = (sg & 3) * 128 + wc * 32 + 8 * fq; if (t == 1) sc = DIFF_C2; }
                else { base = (sg == 16) ? DLAT : IQ; ld = 128; col = wc * 32 + 8 * fq; }
#pragma unroll
                for (int ai = 0; ai < 2; ++ai)
#pragma unroll
                    for (int m = 0; m < 4; ++m) { const f32x4 v0 = acc[ai][bj][m][0] * sc, v1 = acc[ai][bj][m][1] * sc;
                        u32x4 w; w.x = pk2(v0[0], v0[1]); w.y = pk2(v0[2], v0[3]); w.z = pk2(v1[0], v1[1]); w.w = pk2(v1[2], v1[3]);
                        *(u32x4*)(base + (size_t)(row0 + ai * 128 + m * 16) * ld + col) = w; }
            } else if (sg == 18) {
                if (wc == 0) {
#pragma unroll
                    for (int ai = 0; ai < 2; ++ai)
#pragma unroll
                        for (int m = 0; m < 4; ++m) { const f32x4 v0 = acc[ai][bj][m][0], v1 = acc[ai][bj][m][1];
                            u32x4 w; w.x = pk2(v0[0], v0[1]); w.y = pk2(v0[2], v0[3]); w.z = pk2(v1[0], v1[1]); w.w = pk2(v1[2], v1[3]);
                            *(u32x4*)(IK + (size_t)(row0 + ai * 128 + m * 16) * 32 + 8 * fq) = w; }
                } else if (wc == 1 && fq == 0) {
#pragma unroll
                    for (int ai = 0; ai < 2; ++ai)
#pragma unroll
                        for (int m = 0; m < 4; ++m) *(f32x4*)(IW + (size_t)(row0 + ai * 128 + m * 16) * 4) = acc[ai][bj][m][0] * IW_SCALE;
                }
            }
        }
    }
};
struct EpiX1 {
    static constexpr bool PERM = false;
    const float* x; const float* mod; float* x1;
    __device__ __forceinline__ void operator()(const f32x4 (&acc)[2][2][4][2], const pg8::Unit& u, int wr, int wc, int fr, int fq) const {
        const int row0 = u.pm * 256 + wr * 64 + fr; const int b = (u.pm * 256) / SEQ;
#pragma unroll
        for (int bj = 0; bj < 2; ++bj)
#pragma unroll
            for (int n = 0; n < 2; ++n) { const int col = u.pn * 256 + bj * 128 + wc * 32 + n * 16 + 4 * fq;
                const f32x4 gv = *(const f32x4*)(mod + b * 6144 + 2048 + col);
#pragma unroll
                for (int ai = 0; ai < 2; ++ai)
#pragma unroll
                    for (int m = 0; m < 4; ++m) { const size_t off = (size_t)(row0 + ai * 128 + m * 16) * DM + col;
                        const f32x4 xv = *(const f32x4*)(x + off); *(f32x4*)(x1 + off) = xv + gv * acc[ai][bj][m][n]; } }
    }
};
struct EpiLogits {
    static constexpr bool PERM = false;
    float* LOG; const float* b_router; const float* b_group;
    __device__ __forceinline__ void operator()(const f32x4 (&acc)[2][2][4][2], const pg8::Unit& u, int wr, int wc, int fr, int fq) const {
        if (wc > 1) return;
        const int row0 = u.pm * 256 + wr * 64 + fr;
#pragma unroll
        for (int n = 0; n < 2; ++n) { const int col = wc * 32 + n * 16 + 4 * fq;
            if (col < 36) { const f32x4 bv = (col < 32) ? *(const f32x4*)(b_router + col) : *(const f32x4*)(b_group);
#pragma unroll
                for (int ai = 0; ai < 2; ++ai)
#pragma unroll
                    for (int m = 0; m < 4; ++m) *(f32x4*)(LOG + (size_t)(row0 + ai * 128 + m * 16) * 64 + col) = acc[ai][0][m][n] + bv; } }
    }
};
__device__ __forceinline__ float silu_f(float v) { return v * __builtin_amdgcn_rcpf(1.f + __expf(-v)); }
struct EpiUp {
    static constexpr bool PERM = true;
    bf16_t* HS;
    __device__ __forceinline__ void operator()(const f32x4 (&acc)[2][2][4][2], const pg8::Unit& u, int wr, int wc, int fr, int fq) const {
        const int row0 = u.pm * 256 + wr * 64 + fr; const int col = (u.pn & 1) * 128 + wc * 32 + 8 * fq;
#pragma unroll
        for (int ai = 0; ai < 2; ++ai)
#pragma unroll
            for (int m = 0; m < 4; ++m) { const f32x4 g0 = acc[ai][0][m][0], g1 = acc[ai][0][m][1], u0 = acc[ai][1][m][0], u1 = acc[ai][1][m][1];
                u32x4 w; w.x = pk2(silu_f(g0[0]) * u0[0], silu_f(g0[1]) * u0[1]); w.y = pk2(silu_f(g0[2]) * u0[2], silu_f(g0[3]) * u0[3]);
                w.z = pk2(silu_f(g1[0]) * u1[0], silu_f(g1[1]) * u1[1]); w.w = pk2(silu_f(g1[2]) * u1[2], silu_f(g1[3]) * u1[3]);
                *(u32x4*)(HS + (size_t)(row0 + ai * 128 + m * 16) * 256 + col) = w; }
    }
};
struct EpiDown {
    static constexpr bool PERM = true;
    bf16_t* YS; const float* GL; const LAS int* ecnt;
    __device__ __forceinline__ void operator()(const f32x4 (&acc)[2][2][4][2], const pg8::Unit& u, int wr, int wc, int fr, int fq) const {
        const int r0 = wr * 64 + fr; const int e = u.a0; const int cnt = ecnt[e];
        const int colb = (u.pn & 3) * 256 + wc * 32 + 8 * fq;
#pragma unroll
        for (int ai = 0; ai < 2; ++ai)
#pragma unroll
            for (int m = 0; m < 4; ++m) { const int r = r0 + ai * 128 + m * 16; int slot = u.a1 + r; slot = slot < cnt ? slot : cnt - 1;
                const float g = GL[(size_t)e * NT + slot];
#pragma unroll
                for (int bj = 0; bj < 2; ++bj) { const f32x4 v0 = acc[ai][bj][m][0] * g, v1 = acc[ai][bj][m][1] * g;
                    u32x4 w; w.x = pk2(v0[0], v0[1]); w.y = pk2(v0[2], v0[3]); w.z = pk2(v1[0], v1[1]); w.w = pk2(v1[2], v1[3]);
                    *(u32x4*)(YS + (size_t)(u.pm * 256 + r) * DM + colb + bj * 128) = w; } }
    }
};

struct MoeTab { LAS int* ecnt; LAS int* toff; };
__device__ __forceinline__ MoeTab moe_tables(Frame& F) {
    MoeTab t; t.ecnt = (LAS int*)(F.lds + MISC_OFF + 128); t.toff = t.ecnt + 32;
    __syncthreads();
    if (F.tid < 32) t.ecnt[F.tid] = (int)__hip_atomic_load(F.ctl + CW_ECNT + 64 * F.tid, __ATOMIC_RELAXED, __HIP_MEMORY_SCOPE_AGENT);
    __syncthreads();
    if (F.tid == 0) { int s = 0; for (int e = 0; e < 32; ++e) { t.toff[e] = s; s += (t.ecnt[e] + 255) >> 8; } t.toff[32] = s; }
    __syncthreads();
    return t;
}
template <int NPN, bool GATHER> struct MoeOrder {
    MoeTab tab; int G, c, K; const int* TOK;
    __device__ bool next(int i, pg8::Unit& u) const {
        const long L = (long)i * G + c; const int total = tab.toff[32] * NPN; if (L >= total) return false;
        const int rt = (int)(L / NPN), pl = (int)(L % NPN);
        int e = 0;
#pragma unroll 1
        for (int j = 1; j < 32; ++j) e = (tab.toff[j] <= rt) ? j : e;
        u.pm = rt; u.pn = e * NPN + pl; u.a0 = e; u.a1 = (rt - tab.toff[e]) * 256; return true;
    }
    __device__ __forceinline__ unsigned a_off(const pg8::Unit& u, int R) const {
        if constexpr (GATHER) { const int cnt = tab.ecnt[u.a0]; int slot = u.a1 + R; slot = slot < cnt ? slot : cnt - 1; return (unsigned)TOK[(size_t)u.a0 * NT + slot] * (unsigned)(K * 2); }
        else return (unsigned)(u.pm * 256 + R) * (unsigned)(K * 2);
    }
};
__device__ __forceinline__ void route_tokens(Frame& F) {
    LAS int* lc = (LAS int*)(F.lds);
    LAS int* lb = lc + 32;
    for (int chunk = blockIdx.x; chunk < NT / NTHREADS; chunk += F.G) {
        const int tok = chunk * NTHREADS + F.tid;
        if (F.tid < 32) lc[F.tid] = 0;
        __syncthreads();
        const float* lg = F_LOG + (size_t)tok * 64;
        float gl[4];
        { const f32x4 v = *(const f32x4*)(lg + 32); gl[0] = v[0]; gl[1] = v[1]; gl[2] = v[2]; gl[3] = v[3]; }
        int gs = 0; float gm = gl[0];
#pragma unroll
        for (int j = 1; j < 4; ++j) if (gl[j] > gm) { gm = gl[j]; gs = j; }
        float den = 0.f;
#pragma unroll
        for (int j = 0; j < 4; ++j) den += __expf(gl[j] - gm);
        const float pg = 1.f / den;
        float el[8];
        { const f32x4 a = *(const f32x4*)(lg + gs * 8), b = *(const f32x4*)(lg + gs * 8 + 4); el[0] = a[0]; el[1] = a[1]; el[2] = a[2]; el[3] = a[3]; el[4] = b[0]; el[5] = b[1]; el[6] = b[2]; el[7] = b[3]; }
        int i0 = 0; float v0 = el[0];
#pragma unroll
        for (int j = 1; j < 8; ++j) if (el[j] > v0) { v0 = el[j]; i0 = j; }
        int i1 = -1; float v1 = -INFINITY;
#pragma unroll
        for (int j = 0; j < 8; ++j) if (j != i0 && (i1 < 0 || el[j] > v1)) { v1 = el[j]; i1 = j; }
        const float ex = __expf(v1 - v0); const float w0 = pg / (1.f + ex), w1 = w0 * ex;
        const int e0 = gs * 8 + i0, e1 = gs * 8 + i1;
        const int r0 = __hip_atomic_fetch_add(lc + e0, 1, __ATOMIC_RELAXED, __HIP_MEMORY_SCOPE_WORKGROUP), r1 = __hip_atomic_fetch_add(lc + e1, 1, __ATOMIC_RELAXED, __HIP_MEMORY_SCOPE_WORKGROUP);
        __syncthreads();
        if (F.tid < 32) lb[F.tid] = (int)__hip_atomic_fetch_add(F.ctl + CW_ECNT + 64 * F.tid, (unsigned)lc[F.tid], __ATOMIC_RELAXED, __HIP_MEMORY_SCOPE_AGENT);
        __syncthreads();
        const int s0 = lb[e0] + r0, s1 = lb[e1] + r1;
        F_TOK[(size_t)e0 * NT + s0] = tok; F_TOK[(size_t)e1 * NT + s1] = tok;
        F_GL[(size_t)e0 * NT + s0] = w0; F_GL[(size_t)e1 * NT + s1] = w1;
        *(int2*)(F_REID + (size_t)tok * 2) = make_int2(e0, e1);
        *(int2*)(F_RSLOT + (size_t)tok * 2) = make_int2(s0, s1);
        __syncthreads();
    }
}
__device__ __forceinline__ void combine_rows(Frame& F, const MoeTab& tab) {
    const int gw = F.vcu * NWAVES + F.wave, NGW = F.G * NWAVES;
    for (int m = gw; m < NT; m += NGW) {
        const int b = m / SEQ;
        const int2 ee = *(const int2*)(F_REID + (size_t)m * 2), ss = *(const int2*)(F_RSLOT + (size_t)m * 2);
        const size_t p0 = (size_t)tab.toff[ee.x] * 256 + ss.x, p1 = (size_t)tab.toff[ee.y] * 256 + ss.y;
        const f32x4* xr = (const f32x4*)(F_out + (size_t)m * DM) + F.lane;
        const u32x2* y0 = (const u32x2*)(F_YS + p0 * DM) + F.lane; const u32x2* y1 = (const u32x2*)(F_YS + p1 * DM) + F.lane;
        f32x4 v[4]; float s = 0.f;
#pragma unroll
        for (int j = 0; j < 4; ++j) { const f32x4 xv = xr[64 * j]; const u32x2 a = y0[64 * j], c = y1[64 * j];
            const f32x4 gm = *((const f32x4*)(F_mod + b * 6144 + 5120) + F.lane + 64 * j);
            const f32x4 ys = {bflo(a.x) + bflo(c.x), bfhi(a.x) + bfhi(c.x), bflo(a.y) + bflo(c.y), bfhi(a.y) + bfhi(c.y)};
            v[j] = xv + gm * ys; s += (v[j].x * v[j].x + v[j].y * v[j].y) + (v[j].z * v[j].z + v[j].w * v[j].w); }
        const float rstd = 1.f / sqrtf(wave_sum(s) * (1.f / DM) + RMS_EPS);
        f32x4* orow = (f32x4*)(F_out + (size_t)m * DM) + F.lane;
#pragma unroll
        for (int j = 0; j < 4; ++j) { const f32x4 gg = *((const f32x4*)F_g_final + F.lane + 64 * j); orow[64 * j] = (v[j] * rstd) * gg; }
    }
}

constexpr float DIFF_SKIP_LOG2 = 150.f;
__device__ __forceinline__ int diff_tstart(int h, int qb) {
    const float slope2 = exp2f(-2.0f * (float)(h + 1)) * LOG2E;
    const float tmax = ((float)(128 * qb - 63) - DIFF_SKIP_LOG2 / slope2) * (1.f / 64.f);
    int t = (int)floorf(tmax) + 1; return t < 0 ? 0 : t;
}
__device__ __forceinline__ void knorm_rows(Frame& F) {
    const int gw = F.vcu * NWAVES + F.wave, NGW = F.G * NWAVES;
    float* KN2 = (float*)(F.ws + WS_KN2);
    for (int it = gw; it < NB * 128; it += NGW) {
        const int b = it >> 7, tile = it & 127;
        const u32x4* rp = (const u32x4*)(F_FK + ((size_t)(b * SEQ + tile * 64)) * 512) + F.lane;
        float mx = 0.f;
#pragma unroll 4
        for (int r = 0; r < 64; ++r) { const u32x4 v = rp[(size_t)r * 64];
            float s = bflo(v.x) * bflo(v.x) + bfhi(v.x) * bfhi(v.x); s += bflo(v.y) * bflo(v.y) + bfhi(v.y) * bfhi(v.y); s += bflo(v.z) * bflo(v.z) + bfhi(v.z) * bfhi(v.z); s += bflo(v.w) * bflo(v.w) + bfhi(v.w) * bfhi(v.w);
            s += __shfl_xor(s, 1); s += __shfl_xor(s, 2); s += __shfl_xor(s, 4);
            mx = fmaxf(mx, s); }
        if ((F.lane & 7) == 0) { const int hs = F.lane >> 3; KN2[((size_t)(b * 8 + hs)) * 128 + tile] = mx; }
    }
}
__device__ __forceinline__ void diff_unit(Frame& F, int b, int h, int qb, float lam, float lam_init) {
    int tid = F.tid; asm volatile("" : "+v"(tid));
    const int lane = tid & 63, wave = F.wave;
    const int r32 = lane & 31, hi = lane >> 5;
    const int st = wave >> 2, wq = wave & 3;
    const int q0 = qb * 128, nt = 2 * qb + 2;
    const int t0 = diff_tstart(h, qb);
    const float slope2 = exp2f(-2.0f * (float)(h + 1)) * LOG2E;
    LAS unsigned char* L = F.lds;
    const int qpos = q0 + 32 * wq + r32;
    bf16x8 qf[4];
    { const bf16_t* qp = F_FQ + ((size_t)(b * SEQ + qpos) * 512 + h * 128 + st * 64 + hi * 8);
#pragma unroll
      for (int s = 0; s < 4; ++s) qf[s] = *(const bf16x8*)(qp + 16 * s); }
    float mref;
    { float qs = 0.f;
#pragma unroll
      for (int s = 0; s < 4; ++s)
#pragma unroll
          for (int j = 0; j < 8; ++j) { const float v = bf2f((unsigned short)qf[s][j]); qs += v * v; }
      qs += __shfl_xor(qs, 32);
      const float* kn = (const float*)(F.ws + WS_KN2) + ((size_t)(b * 8 + h * 2 + st)) * 128;
      float km = 0.f;
      for (int t = t0 + lane; t < nt; t += 64) km = fmaxf(km, kn[t]);
#pragma unroll
      for (int o = 1; o < 64; o <<= 1) km = fmaxf(km, __shfl_xor(km, o));
      mref = sqrtf(qs) * sqrtf(km); }
    const int srow = 4 * wave + (lane >> 4), sslot = lane & 15;
    const unsigned schunk = (unsigned)sslot ^ ((((unsigned)srow & 3u) << 2) | (((unsigned)srow >> 2) & 3u));
    const size_t gk = ((size_t)(b * SEQ) * 512 + h * 128) + (size_t)srow * 512 + schunk * 8;
    const unsigned ldsb = (unsigned)(uintptr_t)(L + wave * 1024);
#define DIFF_GLDS(gp, ldsoff) do { unsigned keep_; asm volatile("s_mov_b32 %0, m0\n\ts_mov_b32 m0, %2\n\ts_nop 0\n\tglobal_load_lds_dwordx4 %1, off\n\ts_mov_b32 m0, %0" : "=&s"(keep_) : "v"(gp), "s"((unsigned)__builtin_amdgcn_readfirstlane(ldsb + (ldsoff))) : "memory"); } while (0)
#define DIFF_STAGE(t, bo) do { const size_t go = gk + (size_t)(t) * 64 * 512; \
        DIFF_GLDS(F_FK + go, (bo)); DIFF_GLDS(F_FK + go + 32 * 512, (bo) + 8192); DIFF_GLDS(F_FV + go, 49152 + (bo)); DIFF_GLDS(F_FV + go + 32 * 512, 49152 + (bo) + 8192); } while (0)
    const unsigned kswz = ((unsigned)(r32 & 3) << 2) | ((unsigned)(r32 >> 2) & 3u);
    unsigned koff[4];
#pragma unroll
    for (int s = 0; s < 4; ++s) koff[s] = 256u * r32 + 16u * (((unsigned)(8 * st + 2 * s + hi)) ^ kswz);
    const int qq = (lane & 15) >> 2, pp = lane & 3, blk = (lane >> 4) & 1;
    unsigned vo[2][4];
#pragma unroll
    for (int tt = 0; tt < 2; ++tt)
#pragma unroll
        for (int cb = 0; cb < 4; ++cb) vo[tt][cb] = 256u * (unsigned)(8 * tt + 4 * hi + qq) + 16u * (((unsigned)(4 * cb + 2 * blk + (pp >> 1))) ^ (((unsigned)qq << 2) | ((unsigned)(2 * tt + hi) & 3u))) + 8u * (unsigned)(pp & 1);
    int b0 = 0, b1 = 16384, b2 = 32768;
    DIFF_STAGE(t0, b0); DIFF_STAGE(t0 + 1, b1);
    asm volatile("s_waitcnt vmcnt(0)" ::: "memory");
    __syncthreads();
    float lrow = 0.f;
    f32x16 o[4];
#pragma unroll
    for (int cb = 0; cb < 4; ++cb)
#pragma unroll
        for (int r = 0; r < 16; ++r) o[cb][r] = 0.f;
    f32x16 p[2];
#define DIFF_KFR(dst, Kb_, kh_) do { _Pragma("unroll") for (int s = 0; s < 4; ++s) dst[s] = *(const LAS bf16x8*)((Kb_) + (kh_) * 8192 + koff[s]); } while (0)
#define DIFF_QKH(dst, kf_, t_, kh_) do { const float cbias = slope2 * (float)(64 * (t_) + 32 * (kh_) + 4 * hi - qpos) - mref; f32x16 c; \
        _Pragma("unroll") for (int r = 0; r < 16; ++r) c[r] = fmaf(slope2, (float)((r & 3) + 8 * (r >> 2)), cbias); \
        _Pragma("unroll") for (int s = 0; s < 4; ++s) c = MFMA32(kf_[s], qf[s], c); dst = c; } while (0)
#define DIFF_VFR(dst, cb_) do { _Pragma("unroll") for (int ks = 0; ks < 4; ++ks) { const s16x4 v0_ = tr_read((const LAS char*)(Vb + vo[0][cb_] + 4096 * ks)); const s16x4 v1_ = tr_read((const LAS char*)(Vb + vo[1][cb_] + 4096 * ks)); dst[ks] = cat8(v0_, v1_); } } while (0)
    { bf16x8 ka[4], kb_[4]; DIFF_KFR(ka, L + b0, 0); DIFF_KFR(kb_, L + b0, 1); DIFF_QKH(p[0], ka, t0, 0); DIFF_QKH(p[1], kb_, t0, 1); }
#pragma unroll 1
    for (int t = t0; t < nt; ++t) {
        const bool more = (t + 1 < nt);
        if (t + 2 < nt) DIFF_STAGE(t + 2, b2);
        const LAS unsigned char* Kn = L + b1;
        const LAS unsigned char* Vb = L + 49152 + b0;
        bf16x8 kfa[4], kfb[4], vfa[4], vfb[4];
        DIFF_VFR(vfa, 0);
        if (more) { DIFF_KFR(kfa, Kn, 0); DIFF_KFR(kfb, Kn, 1); }
        __builtin_amdgcn_sched_barrier(0);
        if (t >= nt - 2) {
#pragma unroll
            for (int kh = 0; kh < 2; ++kh)
#pragma unroll
                for (int r = 0; r < 16; ++r) { const int kpos = 64 * t + 32 * kh + crow(r, hi); if (kpos > qpos) p[kh][r] = -INFINITY; }
        }
        float ps = 0.f;
#pragma unroll
        for (int kh = 0; kh < 2; ++kh)
#pragma unroll
            for (int r = 0; r < 16; ++r) { const float e = __builtin_amdgcn_exp2f(p[kh][r]); p[kh][r] = e; ps += e; }
        lrow += ps;
        bf16x8 pa[4];
#pragma unroll
        for (int ks = 0; ks < 4; ++ks) { const int kh = ks >> 1, r0 = (ks & 1) * 8;
            u32x4 w; w.x = pk2(p[kh][r0], p[kh][r0 + 1]); w.y = pk2(p[kh][r0 + 2], p[kh][r0 + 3]); w.z = pk2(p[kh][r0 + 4], p[kh][r0 + 5]); w.w = pk2(p[kh][r0 + 6], p[kh][r0 + 7]);
            pa[ks] = __builtin_bit_cast(bf16x8, w); }
        __builtin_amdgcn_sched_barrier(0);
        DIFF_VFR(vfb, 1);
        __builtin_amdgcn_sched_barrier(0);
#pragma unroll
        for (int ks = 0; ks < 4; ++ks) o[0] = MFMA32(vfa[ks], pa[ks], o[0]);
        __builtin_amdgcn_sched_barrier(0);
        DIFF_VFR(vfa, 2);
        __builtin_amdgcn_sched_barrier(0);
#pragma unroll
        for (int ks = 0; ks < 4; ++ks) o[1] = MFMA32(vfb[ks], pa[ks], o[1]);
        __builtin_amdgcn_sched_barrier(0);
        DIFF_VFR(vfb, 3);
        __builtin_amdgcn_sched_barrier(0);
#pragma unroll
        for (int ks = 0; ks < 4; ++ks) o[2] = MFMA32(vfa[ks], pa[ks], o[2]);
        if (more) { DIFF_QKH(p[0], kfa, t + 1, 0); }
#pragma unroll
        for (int ks = 0; ks < 4; ++ks) o[3] = MFMA32(vfb[ks], pa[ks], o[3]);
        if (more) { DIFF_QKH(p[1], kfb, t + 1, 1); }
        asm volatile("s_waitcnt vmcnt(0)" ::: "memory");
        __syncthreads();
        { const int tb_ = b0; b0 = b1; b1 = b2; b2 = tb_; }
    }
#undef DIFF_VFR
#undef DIFF_KFR
#undef DIFF_QKH
#undef DIFF_STAGE
#undef DIFF_GLDS
    lrow += __shfl_xor(lrow, 32);
    const float rl = 1.f / lrow;
    LAS float* X = (LAS float*)L;
    if (st == 1) {
#pragma unroll
        for (int cb = 0; cb < 4; ++cb)
#pragma unroll
            for (int r = 0; r < 16; ++r) X[(wq * 64 + cb * 16 + r) * 64 + lane] = o[cb][r] * rl;
    }
    __syncthreads();
    if (st == 0) {
        float ss = 0.f;
#pragma unroll
        for (int cb = 0; cb < 4; ++cb)
#pragma unroll
            for (int r = 0; r < 16; ++r) { const float d = o[cb][r] * rl - lam * X[(wq * 64 + cb * 16 + r) * 64 + lane]; o[cb][r] = d; ss += d * d; }
        ss += __shfl_xor(ss, 32);
        const float rstd = (1.f - lam_init) / sqrtf(ss * (1.f / 128.f) + RMS_EPS);
        bf16_t* orow = F_O + (size_t)(b * SEQ + qpos) * DM + 512 + h * 128;
#pragma unroll
        for (int cb = 0; cb < 4; ++cb)
#pragma unroll
            for (int r4 = 0; r4 < 4; ++r4) { const int c0 = 32 * cb + 8 * r4 + 4 * hi;
                const f32x4 gg = *(const f32x4*)(F_g_sub + c0);
                u32x2 w; w.x = pk2(o[cb][4 * r4] * rstd * gg[0], o[cb][4 * r4 + 1] * rstd * gg[1]); w.y = pk2(o[cb][4 * r4 + 2] * rstd * gg[2], o[cb][4 * r4 + 3] * rstd * gg[3]);
                *(u32x2*)(orow + c0) = w; }
    }
    __syncthreads();
}
__device__ __forceinline__ int wq_next(Frame& F, int qid) {
    LAS int* slot = (LAS int*)(F.lds + MISC_OFF + 96);
    __syncthreads();
    if (F.tid == 0) *slot = (int)__hip_atomic_fetch_add(F.ctl + CW_WQ + 64 * qid, 1u, __ATOMIC_RELAXED, __HIP_MEMORY_SCOPE_AGENT);
    __syncthreads();
    return *slot;
}
__device__ __forceinline__ void diff_phase(Frame& F) {
    if (F.G != 256) return;
    const float lam_init = 0.8f - 0.6f * 1.0f;
    float a = F_lq1[F.lane] * F_lk1[F.lane], c = F_lq2[F.lane] * F_lk2[F.lane];
    a = wave_sum(a); c = wave_sum(c);
    const float lam = __expf(a) - __expf(c) + lam_init;
    const int b = F.vcu >> 5;
    LAS int* cost = (LAS int*)(F.lds + 147456);
    LAS int* order = cost + 256;
    __syncthreads();
    if (F.tid < 256) { const int h = F.tid >> 6, qb = F.tid & 63; cost[F.tid] = (2 * qb + 2 - diff_tstart(h, qb)) + 4; }
    __syncthreads();
    if (F.tid < 256) { const int cm = cost[F.tid]; int rank = 0;
        for (int j = 0; j < 256; ++j) { const int cj = cost[j]; rank += (cj > cm || (cj == cm && j < F.tid)) ? 1 : 0; }
        order[rank] = F.tid; }
    __syncthreads();
#pragma unroll 1
    for (;;) { const int u = wq_next(F, 2 * b); if (u >= 256) break;
        const int id = order[u];
        diff_unit(F, b, id >> 6, id & 63, lam, lam_init); }
}

constexpr int DSA_NBIN = 1024;
constexpr int DSA_POOLCAP = 16384;
constexpr int DSA_SEL_OFF = 131072, DSA_SM_OFF = 147456, DSA_GI_OFF = 65536;
constexpr float DSA_SCALE2 = 0.125f * LOG2E;

__device__ __forceinline__ unsigned off_c(unsigned row, unsigned ch) { return 256u * row + 16u * (ch ^ (((row & 7u) << 1) | ((row >> 2) & 1u))); }
__device__ __forceinline__ unsigned f32_sortable(float f) { const unsigned u = __builtin_bit_cast(unsigned, f); return u ^ ((u >> 31) ? 0xffffffffu : 0x80000000u); }

__device__ __forceinline__ float relu_raw(float v) { int i = __builtin_bit_cast(int, v); i = i > 0 ? i : 0; return __builtin_bit_cast(float, i); }
typedef short s16x2_t __attribute__((ext_vector_type(2)));
template <int PASS>
__device__ __forceinline__ void dsa_pass(Frame& F, int b, int q0, const bf16x8 (&qf)[4][2], const float (&w)[4], int lane, int grp) {
    const int r32 = lane & 31, hi = lane >> 5;
    LAS unsigned* hist = (LAS unsigned*)F.lds;
    LAS unsigned long long* pool = (LAS unsigned long long*)F.lds;
    LAS unsigned short* sel = (LAS unsigned short*)(F.lds + DSA_SEL_OFF);
    LAS int* sm = (LAS int*)(F.lds + DSA_SM_OFF);
    const int qpos = q0 + r32;
    const int nkb = (q0 >> 5) + 1;
    int tb = 0, po = 0;
    if (PASS == 2) { tb = (sm[200 + r32] == grp) ? sm[r32] : 0x7fffffff; po = sm[96 + r32]; }
    LAS unsigned* hq = hist + r32 * DSA_NBIN;
    const bf16_t* kbase = F_IK + ((size_t)(b * SEQ + r32) * 32 + hi * 8);
    bf16x8 n0 = {0, 0, 0, 0, 0, 0, 0, 0}, n1 = n0;
    if (F.wave < nkb) { const bf16_t* kp = kbase + (size_t)F.wave * 1024; n0 = *(const bf16x8*)kp; n1 = *(const bf16x8*)(kp + 16); }
#pragma unroll 1
    for (int kb = F.wave; kb < nkb; kb += NWAVES) {
        const bf16x8 a0 = n0, a1 = n1;
        if (kb + NWAVES < nkb) { const bf16_t* kp = kbase + (size_t)(kb + NWAVES) * 1024; n0 = *(const bf16x8*)kp; n1 = *(const bf16x8*)(kp + 16); }
        f32x16 sc;
#pragma unroll
        for (int r = 0; r < 16; ++r) sc[r] = 0.f;
#pragma unroll
        for (int h = 0; h < 4; ++h) {
            f32x16 acc;
#pragma unroll
            for (int r = 0; r < 16; ++r) acc[r] = 0.f;
            acc = MFMA32(a0, qf[h][0], acc); acc = MFMA32(a1, qf[h][1], acc);
#pragma unroll
            for (int r = 0; r < 16; ++r) sc[r] = fmaf(relu_raw(acc[r]), w[h], sc[r]);
            if (h == 1) __builtin_amdgcn_sched_barrier(0);
        }
        const bool diag = (kb == nkb - 1);
        const int lim = diag ? qpos - 32 * kb : 64;
        int bin[16];
#pragma unroll
        for (int r = 0; r < 16; r += 2) { const int pk = __builtin_bit_cast(int, __builtin_amdgcn_cvt_pknorm_i16(sc[r], sc[r + 1])); bin[r] = (((int)((unsigned)pk << 16)) >> 22) + 512; bin[r + 1] = (pk >> 22) + 512; }
        if (PASS == 1) {
            if (!diag) {
#pragma unroll
                for (int r = 0; r < 16; ++r) (void)__hip_atomic_fetch_add(hq + bin[r], 1u, __ATOMIC_RELAXED, __HIP_MEMORY_SCOPE_WORKGROUP);
            } else {
#pragma unroll
                for (int r = 0; r < 16; ++r) (void)__hip_atomic_fetch_add(hq + bin[r], (crow(r, hi) <= lim) ? 1u : 0u, __ATOMIC_RELAXED, __HIP_MEMORY_SCOPE_WORKGROUP);
            }
        } else {
            unsigned abm = 0u, eqm = 0u;
#pragma unroll
            for (int r = 0; r < 16; ++r) { const bool ok = crow(r, hi) <= lim; abm |= (ok && bin[r] > tb) ? (1u << r) : 0u; eqm |= (ok && bin[r] == tb) ? (1u << r) : 0u; }
            const unsigned basew = __hip_atomic_fetch_add((LAS unsigned*)(sm + 128) + r32, (unsigned)__builtin_popcount(abm) | ((unsigned)__builtin_popcount(eqm) << 16), __ATOMIC_RELAXED, __HIP_MEMORY_SCOPE_WORKGROUP);
            int sa = r32 * 256 + (int)(basew & 0xffffu), sc2 = po + (int)(basew >> 16);
            const int kb0 = 32 * kb + 4 * hi;
            while (abm) { const int r = __builtin_ctz(abm); abm &= abm - 1u; sel[sa] = (unsigned short)(kb0 + (r & 3) + 8 * (r >> 2)); ++sa; }
            while (eqm) { const int r = __builtin_ctz(eqm); eqm &= eqm - 1u;
                float v = sc[0];
#pragma unroll
                for (int j = 1; j < 16; ++j) v = (r == j) ? sc[j] : v;
                if (sc2 < DSA_POOLCAP) pool[sc2] = ((unsigned long long)f32_sortable(v + 0.f) << 16) | (unsigned long long)(0xffffu - (unsigned)(kb0 + (r & 3) + 8 * (r >> 2))); ++sc2; }
        }
    }
}

template <int NR>
__device__ __forceinline__ void dsa_resolve(const LAS unsigned long long* pq, int c, int r, LAS unsigned short* selq, int lane) {
    unsigned long long kk[NR];
#pragma unroll
    for (int i = 0; i < NR; ++i) { const int idx = 64 * i + lane; const bool in = idx < c; kk[i] = in ? pq[in ? idx : 0] : 0ull; }
    unsigned long long P = 0ull;
    if (c > r) {
        constexpr unsigned long long ZMIN = 0x80000000ull << 16, ZMAX = ZMIN | 0xffffull;
        int ngt = 0, nge = 0;
#pragma unroll
        for (int i = 0; i < NR; ++i) { ngt += __builtin_popcountll(__ballot(kk[i] > ZMAX)); nge += __builtin_popcountll(__ballot(kk[i] >= ZMIN)); }
        int bit = 47;
        if (ngt < r && r <= nge) { P = ZMIN | 0xe000ull; bit = 12; }
#pragma unroll 1
        for (; bit >= 0; --bit) {
            const unsigned long long trial = P | (1ull << bit);
            int cnt = 0;
#pragma unroll
            for (int i = 0; i < NR; ++i) cnt += __builtin_popcountll(__ballot(kk[i] >= trial));
            if (cnt >= r) { P = trial; if (cnt == r) break; }
        }
    }
    int outp = 0;
#pragma unroll
    for (int i = 0; i < NR; ++i) { const bool take = (64 * i + lane < c) && kk[i] >= P; const unsigned long long bal = __ballot(take);
        const int pos = outp + __builtin_popcountll(bal & ((1ull << lane) - 1ull));
        if (take && pos < r) selq[pos] = (unsigned short)(0xffffu - (unsigned)(kk[i] & 0xffffull));
        outp += __builtin_popcountll(bal); }
}

__device__ __forceinline__ void dsa_topk(Frame& F, int b, int qt) {
    int lane = F.lane; asm volatile("" : "+v"(lane));
    const int r32 = lane & 31, hi = lane >> 5, wave = F.wave;
    const int q0 = qt * 32;
    LAS unsigned* hist = (LAS unsigned*)F.lds;
    LAS unsigned long long* pool = (LAS unsigned long long*)F.lds;
    LAS unsigned short* sel = (LAS unsigned short*)(F.lds + DSA_SEL_OFF);
    LAS int* sm = (LAS int*)(F.lds + DSA_SM_OFF);
    if (q0 + 32 <= 256) {
        for (int i = F.tid; i < 32 * 256; i += NTHREADS) { const int q = i >> 8, j = i & 255; sel[i] = (j <= q0 + q) ? (unsigned short)j : (unsigned short)0xffffu; }
        __syncthreads();
        return;
    }

    bf16x8 qf[4][2]; float w[4];
    { const bf16_t* qp = F_IQ + ((size_t)(b * SEQ + q0 + r32) * 128 + hi * 8);
#pragma unroll
      for (int h = 0; h < 4; ++h) { qf[h][0] = *(const bf16x8*)(qp + h * 32); qf[h][1] = *(const bf16x8*)(qp + h * 32 + 16);
      }
      const f32x4 wv = *(const f32x4*)(F_IW + (size_t)(b * SEQ + q0 + r32) * 4);
      const float wm = fmaxf(fmaxf(fabsf(wv[0]), fabsf(wv[1])), fmaxf(fabsf(wv[2]), fabsf(wv[3]))); int ex = 0; (void)frexpf(wm, &ex);
      const float wsc = (wm > 0.f) ? ldexpf(1.f, -ex - 6) : 1.f;
      w[0] = wv[0] * wsc; w[1] = wv[1] * wsc; w[2] = wv[2] * wsc; w[3] = wv[3] * wsc; }
    for (int i = F.tid; i < 32 * DSA_NBIN / 4; i += NTHREADS) ((LAS u32x4*)hist)[i] = (u32x4){0u, 0u, 0u, 0u};
    for (int i = F.tid; i < 32 * 256 / 8; i += NTHREADS) ((LAS u32x4*)sel)[i] = (u32x4){0xffffffffu, 0xffffffffu, 0xffffffffu, 0xffffffffu};
    if (F.tid < 65) sm[128 + F.tid] = 0;
    __syncthreads();


    dsa_pass<1>(F, b, q0, qf, w, lane, 0);
    __syncthreads();


#pragma unroll 1
    for (int qi = 0; qi < 4; ++qi) {
        const int q = 4 * wave + qi;
        unsigned hv[16];
#pragma unroll
        for (int j4 = 0; j4 < 4; ++j4) { const u32x4 v = *(const LAS u32x4*)(hist + q * DSA_NBIN + 16 * lane + 4 * j4); hv[4 * j4] = v.x; hv[4 * j4 + 1] = v.y; hv[4 * j4 + 2] = v.z; hv[4 * j4 + 3] = v.w; }
        unsigned lsum = 0;
#pragma unroll
        for (int j = 0; j < 16; ++j) lsum += hv[j];
        unsigned incl = lsum;
#pragma unroll
        for (int o = 1; o < 64; o <<= 1) { const unsigned v = __shfl_down(incl, o); incl += (lane + o < 64) ? v : 0u; }
        const unsigned excl = incl - lsum;
        if (excl < 256u && incl >= 256u) {
            unsigned run = excl; int tbin = 0; unsigned nab = 0, cc = 0; bool found = false;
#pragma unroll
            for (int j = 15; j >= 0; --j) { if (!found) { if (run + hv[j] >= 256u) { found = true; tbin = 16 * lane + j; nab = run; cc = hv[j]; } else run += hv[j]; } }
            sm[q] = tbin; sm[32 + q] = (int)nab; sm[64 + q] = (int)cc;
        }
    }
    __syncthreads();
    if (F.tid == 0) {
        int off = 0, g = 0;
        for (int q = 0; q < 32; ++q) { const int c = sm[64 + q]; if (off + c > DSA_POOLCAP) { ++g; off = 0; } sm[96 + q] = off; sm[200 + q] = g; off += c; }
        sm[232] = g + 1;
    }
    __syncthreads();
    const int ngrp = __builtin_amdgcn_readfirstlane(sm[232]);

#pragma unroll 1
    for (int grp = 0; grp < ngrp; ++grp) {
    dsa_pass<2>(F, b, q0, qf, w, lane, grp);
    __syncthreads();

#pragma unroll 1
    for (int qi = 0; qi < 4; ++qi) {
        const int q = 4 * wave + qi;
        if (__builtin_amdgcn_readfirstlane(sm[200 + q]) != grp) continue;
        const int base = __builtin_amdgcn_readfirstlane(sm[96 + q]); int c = __builtin_amdgcn_readfirstlane(sm[64 + q]);
        const int nab = __builtin_amdgcn_readfirstlane(sm[32 + q]); const int r = 256 - nab;
        if (base + c > DSA_POOLCAP) c = (DSA_POOLCAP - base) > 0 ? (DSA_POOLCAP - base) : 0;
        LAS unsigned short* selq = sel + q * 256 + nab;
        const LAS unsigned long long* pq = pool + base;
        if (c <= 64) dsa_resolve<1>(pq, c, r, selq, lane);
        else if (c <= 128) dsa_resolve<2>(pq, c, r, selq, lane);
        else if (c <= 256) dsa_resolve<4>(pq, c, r, selq, lane);
        else if (c <= 512) dsa_resolve<8>(pq, c, r, selq, lane);
        else if (c <= 1024) dsa_resolve<16>(pq, c, r, selq, lane);
        else {
#define DSA_COUNT_GE(out_, thr_) do { int cnt_ = 0; _Pragma("unroll 4") for (int i0 = 0; i0 < c; i0 += 64) { const int i = i0 + lane; const unsigned long long v_ = pq[i < c ? i : 0]; cnt_ += __builtin_popcountll(__ballot((i < c) && v_ >= (thr_))); } out_ = cnt_; } while (0)
            constexpr unsigned long long ZMIN = 0x80000000ull << 16, ZMAX = ZMIN | 0xffffull;
            unsigned long long P = 0ull;
            if (c > r) {
                int ngt, nge; DSA_COUNT_GE(ngt, ZMAX + 1ull); DSA_COUNT_GE(nge, ZMIN);
                int bit = 47;
                if (ngt < r && r <= nge) { P = ZMIN | 0xe000ull; bit = 12; }
#pragma unroll 1
                for (; bit >= 0; --bit) {
                    const unsigned long long trial = P | (1ull << bit);
                    int cnt; DSA_COUNT_GE(cnt, trial);
                    if (cnt >= r) { P = trial; if (cnt == r) break; }
                }
            }
#undef DSA_COUNT_GE
            int outp = 0;
#pragma unroll 2
            for (int i0 = 0; i0 < c; i0 += 64) { const int i = i0 + lane; const unsigned long long v = pq[i < c ? i : 0]; const bool take = (i < c) && v >= P;
                const unsigned long long bal = __ballot(take); const int pos = outp + __builtin_popcountll(bal & ((1ull << lane) - 1ull));
                if (take && pos < r) selq[pos] = (unsigned short)(0xffffu - (unsigned)(v & 0xffffull));
                outp += __builtin_popcountll(bal); }
        }
    }
    __syncthreads();
    }

}

__device__ __forceinline__ void dsa_chunk(const bf16x8 (&af)[2][4], const bf16x8 (&bq)[4], f32x4 (&o)[8], float& lrow, LAS unsigned char* GI, LAS unsigned short* sel,
                                          int q, int qpos, int ch, int g, float slope2, float cq, unsigned wrA0, unsigned trA0) {
    asm volatile("" : "+v"(wrA0), "+v"(trA0));
    unsigned short kk[2][4];
#pragma unroll
    for (int rb = 0; rb < 2; ++rb) { const u32x2 v = *(const LAS u32x2*)(sel + q * 256 + 32 * ch + 16 * rb + 4 * g); kk[rb][0] = (unsigned short)(v.x & 0xffffu); kk[rb][1] = (unsigned short)(v.x >> 16); kk[rb][2] = (unsigned short)(v.y & 0xffffu); kk[rb][3] = (unsigned short)(v.y >> 16); }
#pragma unroll
    for (int rb = 0; rb < 2; ++rb)
#pragma unroll
        for (int s = 0; s < 4; ++s) *(LAS bf16x8*)(GI + (wrA0 ^ (unsigned)(s << 6)) + 4096 * rb) = af[rb][s];
    f32x4 sacc[2];
#pragma unroll
    for (int rb = 0; rb < 2; ++rb) { sacc[rb] = (f32x4){0.f, 0.f, 0.f, 0.f};
#pragma unroll
        for (int s = 0; s < 4; ++s) sacc[rb] = MFMA16(af[rb][s], bq[s], sacc[rb]); }
    float ps = 0.f; float pv[8];
#pragma unroll
    for (int rb = 0; rb < 2; ++rb)
#pragma unroll
        for (int i = 0; i < 4; ++i) { const unsigned key = kk[rb][i]; const bool ok = (key != 0xffffu) && ((int)key <= qpos);
            const float v = fmaf(sacc[rb][i], DSA_SCALE2, fmaf(-slope2, (float)(qpos - (int)key), cq));
            const float e = ok ? __builtin_amdgcn_exp2f(v) : 0.f; pv[4 * rb + i] = e; ps += e; }
    lrow += ps;
    u32x4 pw; pw.x = pk2(pv[0], pv[1]); pw.y = pk2(pv[2], pv[3]); pw.z = pk2(pv[4], pv[5]); pw.w = pk2(pv[6], pv[7]);
    const bf16x8 bp = __builtin_bit_cast(bf16x8, pw);
#pragma unroll
    for (int c4 = 0; c4 < 2; ++c4) {
        bf16x8 vf[4];
#pragma unroll
        for (int i = 0; i < 4; ++i) { const unsigned ta = trA0 ^ (unsigned)((4 * c4 + i) << 5);
            const s16x4 v0 = tr_read((const LAS char*)(GI + ta)); const s16x4 v1 = tr_read((const LAS char*)(GI + ta + 4096)); vf[i] = cat8(v0, v1); }
        __builtin_amdgcn_sched_barrier(0);
#pragma unroll
        for (int i = 0; i < 4; ++i) o[4 * c4 + i] = MFMA16(vf[i], bp, o[4 * c4 + i]);
        __builtin_amdgcn_sched_barrier(0);
    }
}

__device__ __forceinline__ void dsa_attend(Frame& F, int b, int qt, float kvmax) {
    int lane = F.lane; asm volatile("" : "+v"(lane));
    const int r32 = lane & 31, hi = lane >> 5, wave = F.wave;
    const int q0 = qt * 32; const size_t t0 = (size_t)b * SEQ + q0;
    LAS unsigned char* QA = F.lds;
    LAS unsigned char* GI = F.lds + DSA_GI_OFF + wave * 8192;
    LAS unsigned short* sel = (LAS unsigned short*)(F.lds + DSA_SEL_OFF);

    LAS float* QN2 = (LAS float*)(F.lds + DSA_SM_OFF + 1024);
    { const int h = wave; float qs = 0.f;
      bf16x8 bq[4];
      { const bf16_t* qp = F_DQ + ((t0 + r32) * 512 + h * 64 + hi * 8);
#pragma unroll
        for (int s = 0; s < 4; ++s) bq[s] = *(const bf16x8*)(qp + 16 * s); }
      bf16x8 wf[4][4];
#pragma unroll
      for (int cb = 0; cb < 4; ++cb) { const bf16_t* wp = F_Wuk + ((size_t)(h * 128 + cb * 32 + r32) * 64 + hi * 8);
#pragma unroll
          for (int s = 0; s < 4; ++s) wf[cb][s] = *(const bf16x8*)(wp + 16 * s); }
      __builtin_amdgcn_sched_barrier(0);
#pragma unroll
      for (int cb = 0; cb < 4; ++cb) {
          f32x16 acc;
#pragma unroll
          for (int r = 0; r < 16; ++r) acc[r] = 0.f;
#pragma unroll
          for (int s = 0; s < 4; ++s) acc = MFMA32(wf[cb][s], bq[s], acc);
#pragma unroll
          for (int r4 = 0; r4 < 4; ++r4) { u32x2 wv; wv.x = pk2(acc[4 * r4], acc[4 * r4 + 1]); wv.y = pk2(acc[4 * r4 + 2], acc[4 * r4 + 3]);
              qs += bflo(wv.x) * bflo(wv.x) + bfhi(wv.x) * bfhi(wv.x) + bflo(wv.y) * bflo(wv.y) + bfhi(wv.y) * bfhi(wv.y);
              *(LAS u32x2*)(QA + ((r32 * 8 + h) * 128 + 32 * cb + 8 * r4 + 4 * hi) * 2) = wv; }
      }
      qs += __shfl_xor(qs, 32);
      if (hi == 0) QN2[r32 * 8 + h] = qs; }
    __syncthreads();

    const int n = lane & 15, g = lane >> 4;
    const float slope2 = exp2f(-(float)((n & 7) + 1)) * LOG2E;
    const int qq = n >> 2, pp = n & 3;
    const unsigned wrA0 = off_c(n, g), trA0 = off_c(4u * g + qq, (unsigned)(pp >> 1)) + 8u * (pp & 1);
    const bf16_t* ckvb = F_CKV + (size_t)b * SEQ * 128 + 8 * g;
#define DSA_GATHER(dst, q_, ch_) do { _Pragma("unroll") for (int rb = 0; rb < 2; ++rb) { unsigned key = sel[(q_) * 256 + 32 * (ch_) + 16 * rb + n]; key = key == 0xffffu ? 0u : key; \
        const bf16_t* kp = ckvb + (size_t)key * 128; _Pragma("unroll") for (int s = 0; s < 4; ++s) dst[rb][s] = *(const bf16x8*)(kp + 32 * s); } } while (0)
    bf16x8 afA[2][4], afB[2][4];
    DSA_GATHER(afA, 4 * wave, 0);
#pragma unroll 1
    for (int qi = 0; qi < 4; ++qi) {
        const int q = 4 * wave + qi; const int qpos = q0 + q;
        bf16x8 bq[4];
#pragma unroll
        for (int s = 0; s < 4; ++s) { bf16x8 v = *(const LAS bf16x8*)(QA + ((q * 8 + (n & 7)) * 128 + 32 * s + 8 * g) * 2); if (n >= 8) v = (bf16x8){0, 0, 0, 0, 0, 0, 0, 0}; bq[s] = v; }
        float lrow = 0.f;
        f32x4 o[8];
#pragma unroll
        for (int cb = 0; cb < 8; ++cb) o[cb] = (f32x4){0.f, 0.f, 0.f, 0.f};
        float cq;
        { const u32x2 kv4 = *(const LAS u32x2*)(sel + q * 256 + 4 * lane); int km = -1;
          { const int k0 = (int)(kv4.x & 0xffffu), k1 = (int)(kv4.x >> 16), k2 = (int)(kv4.y & 0xffffu), k3 = (int)(kv4.y >> 16);
            km = (k0 != 0xffff && k0 > km) ? k0 : km; km = (k1 != 0xffff && k1 > km) ? k1 : km; km = (k2 != 0xffff && k2 > km) ? k2 : km; km = (k3 != 0xffff && k3 > km) ? k3 : km; }
#pragma unroll
          for (int o_ = 1; o_ < 64; o_ <<= 1) { const int t = __shfl_xor(km, o_); km = t > km ? t : km; }
          const float bound = sqrtf(QN2[q * 8 + (n & 7)]) * kvmax * DSA_SCALE2;
          cq = slope2 * (float)(qpos - km) - bound; }
#pragma unroll 1
        for (int ch2 = 0; ch2 < 4; ++ch2) {
            DSA_GATHER(afB, q, 2 * ch2 + 1);
            dsa_chunk(afA, bq, o, lrow, GI, sel, q, qpos, 2 * ch2, g, slope2, cq, wrA0, trA0);
            if (ch2 < 3) DSA_GATHER(afA, q, 2 * ch2 + 2); else if (qi < 3) DSA_GATHER(afA, q + 1, 0);
            dsa_chunk(afB, bq, o, lrow, GI, sel, q, qpos, 2 * ch2 + 1, g, slope2, cq, wrA0, trA0);
        }
        lrow += __shfl_xor(lrow, 16); lrow += __shfl_xor(lrow, 32);
        const float rl = 1.f / lrow;
        if (n < 8) {
#pragma unroll
            for (int cb = 0; cb < 8; ++cb) { u32x2 wv; wv.x = pk2(o[cb][0] * rl, o[cb][1] * rl); wv.y = pk2(o[cb][2] * rl, o[cb][3] * rl);
                *(LAS u32x2*)(QA + ((q * 8 + n) * 128 + 16 * cb + 4 * g) * 2) = wv; }
        }
    }
#undef DSA_GATHER
    __syncthreads();

    { const int h = wave;
      bf16x8 bo[8];
#pragma unroll
      for (int s = 0; s < 8; ++s) bo[s] = *(const LAS bf16x8*)(QA + ((r32 * 8 + h) * 128 + 16 * s + 8 * hi) * 2);
      bf16x8 wo[2][8];
#pragma unroll
      for (int db = 0; db < 2; ++db) { const bf16_t* wp = F_WuvT + ((size_t)(h * 64 + db * 32 + r32) * 128 + hi * 8);
#pragma unroll
          for (int s = 0; s < 8; ++s) wo[db][s] = *(const bf16x8*)(wp + 16 * s); }
      __builtin_amdgcn_sched_barrier(0);
#pragma unroll
      for (int db = 0; db < 2; ++db) {
          f32x16 acc;
#pragma unroll
          for (int r = 0; r < 16; ++r) acc[r] = 0.f;
#pragma unroll
          for (int s = 0; s < 8; ++s) acc = MFMA32(wo[db][s], bo[s], acc);
          bf16_t* op = F_O + (t0 + r32) * DM + h * 64 + 32 * db + 4 * hi;
#pragma unroll
          for (int r4 = 0; r4 < 4; ++r4) { u32x2 wv; wv.x = pk2(acc[4 * r4], acc[4 * r4 + 1]); wv.y = pk2(acc[4 * r4 + 2], acc[4 * r4 + 3]);
              *(u32x2*)(op + 8 * r4) = wv; }
      } }
    __syncthreads();

}
__device__ __forceinline__ void dsa_unit(Frame& F, int b, int qt, float kvmax) {
    dsa_topk(F, b, qt);
    dsa_attend(F, b, qt, kvmax);
}
__device__ __forceinline__ void dsa_phase(Frame& F) {
    if (F.G != 256) return;
    const int b = F.vcu >> 5;
    float gm = fmaxf(fabsf(F_g_kv[F.lane]), fabsf(F_g_kv[F.lane + 64]));
#pragma unroll
    for (int o = 1; o < 64; o <<= 1) gm = fmaxf(gm, __shfl_xor(gm, o));
    const float kvmax = 11.313708499f * gm * 1.01f;
#pragma unroll 1
    for (;;) { const int u = wq_next(F, 2 * b + 1); if (u >= 256) break; dsa_unit(F, b, 255 - u, kvmax); }
}

constexpr int N_PHASES = 12;
__global__ void __launch_bounds__(NTHREADS, 2) fwd_kernel(Args args) {
    extern __shared__ __attribute__((aligned(16))) unsigned char lds[];
    Frame F;
    F.lds = (LAS unsigned char*)lds;
    F.MISC = (volatile LAS unsigned*)(F.lds + MISC_OFF);
    F.tid = threadIdx.x; F.lane = F.tid & 63; F.wave = __builtin_amdgcn_readfirstlane(F.tid >> 6);
    F.G = gridDim.x; { const int bx = blockIdx.x; F.vcu = (F.G % 8 == 0) ? (bx % 8) * (F.G / 8) + bx / 8 : bx; }
    F.a = &args; F.ws = args.ws; F.ctl = (unsigned*)(args.ws + WS_CTL);
    for (int u = F.tid; u < (LDS_BYTES - MISC_OFF) / 4; u += NTHREADS) ((LAS unsigned*)(F.lds + MISC_OFF))[u] = 0u;
    __syncthreads();
    XcdBarrier bar; bar.bar = (unsigned*)(F.ctl + CW_BAR); bar.x = 0; bar.st = nullptr;
    if (!MK_SPLIT) bar = xcd_barrier_post((unsigned*)(F.ctl + CW_BAR), F.MISC + 8);
    const int lo = args.ph_lo, hi = args.ph_hi;
#define IN(k) (lo <= (k) && (k) < hi)
#define RUN(k, ...) do { if (IN(k)) { __VA_ARGS__; } } while (0)
#define SEAM(k) do { if (IN(k) && IN((k) + 1)) xcd_barrier(bar); } while (0)


    RUN(0, p0_mod(F); __syncthreads(); p0_weights(F));
    SEAM(0);
    RUN(1, modnorm_rows(F, F_x, F_g_attn, 0, 1024, F_XN));
    SEAM(1);
    RUN(2, pg8::StaticOrder S; S.init(NT, NPROJ, DM, F.G, (int)blockIdx.x); EpiProj E{F_DQ, F_FQ, F_FK, F_FV, F_DLAT, F_IQ, F_IK, F_IW}; pg8::gemm_phase<EpiProj, pg8::StaticOrder, true>(F.lds, F_XN, F_Win, DM, S, E));
    SEAM(2);
    RUN(3, ckv_rows(F); knorm_rows(F));
    SEAM(3);
    RUN(4, diff_phase(F); dsa_phase(F));
    SEAM(4);
    RUN(5, pg8::StaticOrder S; S.init(NT, DM, DM, F.G, (int)blockIdx.x); EpiX1 E{F_x, F_mod, F_out}; pg8::gemm_phase<EpiX1, pg8::StaticOrder, true>(F.lds, F_O, F_Wout, DM, S, E));
    SEAM(5);
    RUN(6, modnorm_rows(F, F_out, F_g_moe, 3072, 4096, F_XN));
    SEAM(6);
    RUN(7, pg8::StaticOrder S; S.init(NT, 256, DM, F.G, (int)blockIdx.x); EpiLogits E{F_LOG, F_b_router, F_b_group}; pg8::gemm_phase<EpiLogits, pg8::StaticOrder, false>(F.lds, F_XN, F_Wrt, DM, S, E));
    SEAM(7);
    RUN(8, route_tokens(F));
    SEAM(8);
    RUN(9, const MoeTab tab = moe_tables(F); MoeOrder<2, true> S{tab, F.G, (int)blockIdx.x, DM, F_TOK}; EpiUp E{F_HS}; pg8::gemm_phase<EpiUp, MoeOrder<2, true>, true>(F.lds, F_XN, F_Wup, DM, S, E));
    SEAM(9);
    RUN(10, const MoeTab tab = moe_tables(F); MoeOrder<4, false> S{tab, F.G, (int)blockIdx.x, DEXP, F_TOK}; EpiDown E{F_YS, F_GL, tab.ecnt}; pg8::gemm_phase<EpiDown, MoeOrder<4, false>, true>(F.lds, F_HS, F_Wdn, DEXP, S, E));
    SEAM(10);
    RUN(11, const MoeTab tab = moe_tables(F); combine_rows(F, tab));
#undef IN
#undef SEAM
}

extern "C" void kernel_launch(void* const* d_in, const int* in_sizes, int n_in, void* d_out, int out_size, void* d_ws, size_t ws_size, hipStream_t stream) {
    static int grid = 0;
    if (grid == 0) {
        if (n_in != 24 || in_sizes[0] != NT * DM || out_size != NT * DM || ws_size < WS_END) { fprintf(stderr, "kernel_launch: unexpected problem (n_in %d, in0 %d, out %d, ws %zu)\n", n_in, n_in > 0 ? in_sizes[0] : -1, out_size, ws_size); grid = -1; return; }
        int dev = 0, cus = 0, per_cu = 0;
        if (hipGetDevice(&dev) != hipSuccess || hipDeviceGetAttribute(&cus, hipDeviceAttributeMultiprocessorCount, dev) != hipSuccess) { grid = -1; return; }
        if (hipFuncSetAttribute((const void*)fwd_kernel, hipFuncAttributeMaxDynamicSharedMemorySize, LDS_BYTES) != hipSuccess) { fprintf(stderr, "kernel_launch: hipFuncSetAttribute failed\n"); grid = -1; return; }
        if (hipOccupancyMaxActiveBlocksPerMultiprocessor(&per_cu, (const void*)fwd_kernel, NTHREADS, LDS_BYTES) != hipSuccess || per_cu < 1) { fprintf(stderr, "kernel_launch: occupancy query reports %d\n", per_cu); }
        (void)hipGetLastError();
        grid = cus;
    }
    if (grid < 0) return;
    if (hipMemsetAsync((char*)d_ws + WS_CTL, 0, CTL_ZERO_BYTES, stream) != hipSuccess) return;
    Args a{};
    for (int i = 0; i < 24; ++i) a.in[i] = (const float*)d_in[i];
    a.out = (float*)d_out; a.ws = (unsigned char*)d_ws;
#if MK_SPLIT
    for (int p = 0; p < N_PHASES; ++p) { a.ph_lo = p; a.ph_hi = p + 1; hipLaunchKernelGGL(fwd_kernel, dim3(grid), dim3(NTHREADS), LDS_BYTES, stream, a); }
#else
    a.ph_lo = 0; a.ph_hi = N_PHASES;
    hipLaunchKernelGGL(fwd_kernel, dim3(grid), dim3(NTHREADS), LDS_BYTES, stream, a);
#endif
}
```

```cpp
#include <hip/hip_runtime.h>
#include <cstdio>
#include <cstdint>

#define LAS __attribute__((address_space(3)))
#define GAS __attribute__((address_space(1)))
typedef unsigned short bf16_t;
typedef short bf16x8 __attribute__((ext_vector_type(8)));
typedef short s16x4 __attribute__((ext_vector_type(4)));
typedef float f32x2 __attribute__((ext_vector_type(2)));
typedef float f32x4 __attribute__((ext_vector_type(4)));
typedef float f32x16 __attribute__((ext_vector_type(16)));
typedef unsigned u32x2 __attribute__((ext_vector_type(2)));
typedef unsigned u32x4 __attribute__((ext_vector_type(4)));
typedef __bf16 bf16x2_t __attribute__((ext_vector_type(2)));

#ifndef MK_SPLIT
#define MK_SPLIT 0
#endif

constexpr int NB = 8, SEQ = 8192, NT = NB * SEQ, DM = 1024;
constexpr int NPROJ = 2560;
constexpr int NEXP = 32, DEXP = 256;
constexpr int PMAX = 2 * NT + NEXP * 256;
constexpr float LOG2E = 1.4426950408889634f;
constexpr float RMS_EPS = 1e-6f;
constexpr float DIFF_C2 = 0.125f * LOG2E;
constexpr float IW_SCALE = 0.5f * 0.17677669529663687f;
constexpr int NWAVES = 8, NTHREADS = 512;

constexpr size_t MiB = 1u << 20;
constexpr size_t WS_CTL = 0, CTL_ZERO_BYTES = 128 * 1024;
constexpr size_t WS_MOD = 1 * MiB;
constexpr size_t WS_KN2 = 1 * MiB + 512 * 1024;
constexpr size_t WS_WIN = 2 * MiB;
constexpr size_t WS_WOUT = 8 * MiB;
constexpr size_t WS_WRT = 10 * MiB;
constexpr size_t WS_WUK = 11 * MiB;
constexpr size_t WS_WUVT = 11 * MiB + 512 * 1024;
constexpr size_t WS_WUP = 12 * MiB;
constexpr size_t WS_WDN = 44 * MiB;
constexpr size_t WS_XN = 64 * MiB;
constexpr size_t WS_DQ = 192 * MiB, WS_FQ = 256 * MiB, WS_FK = 320 * MiB, WS_FV = 384 * MiB;
constexpr size_t WS_YS = 192 * MiB;
constexpr size_t WS_O = 464 * MiB;
constexpr size_t WS_DLAT = 592 * MiB;
constexpr size_t WS_CKV = 608 * MiB;
constexpr size_t WS_IQ = 624 * MiB;
constexpr size_t WS_IK = 640 * MiB;
constexpr size_t WS_IW = 644 * MiB;
constexpr size_t WS_LOG = 646 * MiB;
constexpr size_t WS_REID = 662 * MiB;
constexpr size_t WS_RSLOT = 663 * MiB;
constexpr size_t WS_TOK = 664 * MiB;
constexpr size_t WS_GL = 672 * MiB;
constexpr size_t WS_HS = 680 * MiB;
constexpr size_t WS_END = 752 * MiB;
static_assert(WS_YS + (size_t)PMAX * 2048 <= WS_O && WS_HS + (size_t)PMAX * 512 <= WS_END, "d_ws map");
constexpr int CW_BAR = 4096;
constexpr int CW_ECNT = 16384;
constexpr int CW_WQ = 20480;

constexpr int LDS_BYTES = 155648;
constexpr int MISC_OFF = LDS_BYTES - 512;

__device__ __forceinline__ unsigned f2bf(float f) { unsigned u = __builtin_bit_cast(unsigned, f); return (u + 0x7fffu + ((u >> 16) & 1u)) >> 16; }
__device__ __forceinline__ unsigned pk2(float lo, float hi) { f32x2 v = {lo, hi}; bf16x2_t b = __builtin_convertvector(v, bf16x2_t); return __builtin_bit_cast(unsigned, b); }
__device__ __forceinline__ float bf2f(unsigned short h) { return __builtin_bit_cast(float, (unsigned)h << 16); }
__device__ __forceinline__ float bflo(unsigned w) { return __builtin_bit_cast(float, w << 16); }
__device__ __forceinline__ float bfhi(unsigned w) { return __builtin_bit_cast(float, w & 0xffff0000u); }
__device__ __forceinline__ int crow(int r, int hi) { return (r & 3) + 8 * (r >> 2) + 4 * hi; }
__device__ __forceinline__ unsigned off_b(unsigned row, unsigned ch) { return 256u * row + 16u * (ch ^ (((row & 3u) << 2) | ((row >> 2) & 3u))); }
__device__ __forceinline__ float wave_sum(float v) {
#pragma unroll
    for (int o = 1; o < 64; o <<= 1) v += __shfl_xor(v, o);
    return v;
}
#define LDS_WAIT() asm volatile("s_waitcnt lgkmcnt(0)" ::: "memory")
#define VM_WAIT() asm volatile("s_waitcnt vmcnt(0)" ::: "memory")
#define MFMA32(a, b, c) __builtin_amdgcn_mfma_f32_32x32x16_bf16((a), (b), (c), 0, 0, 0)
#define MFMA16(a, b, c) __builtin_amdgcn_mfma_f32_16x16x32_bf16((a), (b), (c), 0, 0, 0)
__device__ __forceinline__ s16x4 tr_read(LAS const char* p) { return __builtin_bit_cast(s16x4, __builtin_amdgcn_ds_read_tr16_b64_v4i16((LAS s16x4*)p)); }
__device__ __forceinline__ bf16x8 cat8(s16x4 a, s16x4 b) { return (bf16x8){a[0], a[1], a[2], a[3], b[0], b[1], b[2], b[3]}; }

namespace pg8 {
constexpr int BM = 256, BK = 64, HALF = 128, HTB = HALF * BK * 2, STAGE_BYTES = 8 * HTB, NXCD = 8, WGM = 8;
__device__ __forceinline__ int lds_byte(int r, int c) { const int st = (r >> 4) * 2 + (c >> 5), rr = r & 15, cc = c & 31, ob = rr * 64 + cc * 2; return st * 1024 + (ob ^ (((ob >> 9) & 1) << 5)); }
__device__ __forceinline__ void stage_rc(int b, int& R, int& C) { const int st = b / 1024, sb = b % 1024, swz = sb ^ (((sb >> 9) & 1) << 5); R = (st >> 1) * 16 + swz / 64; C = (st & 1) * 32 + (swz % 64) / 2; }
__device__ __forceinline__ int perm32(int rho) { const int n = rho >> 4, i = rho & 15; return 8 * (i >> 2) + 4 * n + (i & 3); }

struct Unit { int pm, pn, a0, a1; };

struct StaticOrder {
    int nM, nN, nwg, G, c, K;
    __device__ void init(int M, int N, int K_, int G_, int c_) { nM = M / BM; nN = N / BM; nwg = nM * nN; G = G_; c = c_; K = K_; }
    __device__ bool next(int i, Unit& u) const {
        const long L = (long)i * G + c; if (L >= nwg) return false;
        int wgid = (int)L; { const int q = nwg / NXCD, r = nwg % NXCD, xcd = wgid % NXCD, off = wgid / NXCD; wgid = (xcd < r ? xcd * (q + 1) : r * (q + 1) + (xcd - r) * q) + off; }
        const int nig = WGM * nN, gid = wgid / nig, fm = gid * WGM, gsz = (nM - fm) < WGM ? (nM - fm) : WGM;
        u.pm = fm + ((wgid % nig) % gsz); u.pn = (wgid % nig) / gsz; u.a0 = 0; u.a1 = 0; return true;
    }
    __device__ __forceinline__ unsigned a_off(const Unit& u, int R) const { return (unsigned)(u.pm * BM + R) * (unsigned)(K * 2); }
};

template <class Epi, class Sched, bool ALIGN_EPI>
__device__ __forceinline__ void gemm_phase(LAS unsigned char* lds, const bf16_t* Ap, const bf16_t* Btp, const int K, const Sched& S, const Epi& E) {
    const int tid = threadIdx.x, wid = __builtin_amdgcn_readfirstlane(tid >> 6), lane = tid & 63, wr = wid >> 2, wc = wid & 3, fr = lane & 15, fq = lane >> 4;
    const int nt = K / BK;
    int RA[2], CA[2]; unsigned voffB[2];
#pragma unroll
    for (int i = 0; i < 2; ++i) { int R, C; stage_rc(tid * 16 + i * 8192, R, C); const int Rb = Epi::PERM ? ((R & ~31) + perm32(R & 31)) : R;
        RA[i] = R; CA[i] = C * 2; voffB[i] = (unsigned)(Rb * K + C) * 2u; }
    const size_t kstep = (size_t)(BK * 2);
    const size_t hstep = (size_t)HALF * K * 2;
    const size_t tstep = 2 * hstep;
    const unsigned ldsw = (unsigned)wid * 1024u;
    const int aoff = lds_byte(wr * 64 + fr, fq * 8), boff = lds_byte(wc * 32 + fr, fq * 8);
#define PG8_SA(b, h) (((b) * 2 + (h)) * HTB)
#define PG8_SB(b, h) ((4 + (b) * 2 + (h)) * HTB)
#define PG8_STAGE_B(bufoff, gbase) do { _Pragma("unroll") for (int _i = 0; _i < 2; ++_i) \
        __builtin_amdgcn_global_load_lds((const unsigned*)((const char*)(gbase) + voffB[_i]), (LAS unsigned*)(lds + (bufoff) + ldsw + _i * 8192), 16, 0, 0); } while (0)
#define PG8_STAGE_A(bufoff, offs, h, kb) do { _Pragma("unroll") for (int _i = 0; _i < 2; ++_i) \
        __builtin_amdgcn_global_load_lds((const unsigned*)((const char*)Ap + (size_t)(offs)[h][_i] + (size_t)(kb)), (LAS unsigned*)(lds + (bufoff) + ldsw + _i * 8192), 16, 0, 0); } while (0)
#define PG8_LDA(dst, b, h) do { _Pragma("unroll") for (int m = 0; m < 4; ++m) _Pragma("unroll") for (int k = 0; k < 2; ++k) dst[m][k] = *(const LAS bf16x8*)(lds + PG8_SA(b, h) + aoff + m * 2048 + k * 1024); } while (0)
#define PG8_LDB(dst, b, h) do { _Pragma("unroll") for (int n = 0; n < 2; ++n) _Pragma("unroll") for (int k = 0; k < 2; ++k) dst[n][k] = *(const LAS bf16x8*)(lds + PG8_SB(b, h) + boff + n * 2048 + k * 1024); } while (0)
#define PG8_MMA(ai, bj, At, Bt) do { __builtin_amdgcn_s_setprio(1); _Pragma("unroll") for (int m = 0; m < 4; ++m) _Pragma("unroll") for (int n = 0; n < 2; ++n) _Pragma("unroll") for (int k = 0; k < 2; ++k) \
        acc[ai][bj][m][n] = __builtin_amdgcn_mfma_f32_16x16x32_bf16(Bt[n][k], At[m][k], acc[ai][bj][m][n], 0, 0, 0); __builtin_amdgcn_s_setprio(0); } while (0)
#define PG8_WAIT_V(n) asm volatile("s_waitcnt vmcnt(" #n ")" ::: "memory")
#define PG8_WAIT_L(n) asm volatile("s_waitcnt lgkmcnt(" #n ")" ::: "memory")
#define PG8_BAR __builtin_amdgcn_s_barrier()
#define PG8_SCHED __builtin_amdgcn_sched_barrier(0)
#define PG8_OFFS(dst, u) do { _Pragma("unroll") for (int _h = 0; _h < 2; ++_h) _Pragma("unroll") for (int _i = 0; _i < 2; ++_i) dst[_h][_i] = S.a_off(u, _h * HALF + RA[_i]) + (unsigned)CA[_i]; } while (0)
    Unit cur, nxt; int ui = 0;
    if (!S.next(0, cur)) return;
    f32x4 acc[2][2][4][2];
#pragma unroll
    for (int a = 0; a < 2; ++a)
#pragma unroll
        for (int b = 0; b < 2; ++b)
#pragma unroll
            for (int m = 0; m < 4; ++m)
#pragma unroll
                for (int n = 0; n < 2; ++n) acc[a][b][m][n] = (f32x4){0.f, 0.f, 0.f, 0.f};
    bf16x8 At[4][2], B0[2][2], B1[2][2];
    unsigned offc[2][2], offn[2][2];
    PG8_OFFS(offc, cur);
    const char* cB = (const char*)Btp + (size_t)cur.pn * tstep;
    PG8_STAGE_B(PG8_SB(0, 0), cB); PG8_STAGE_B(PG8_SB(0, 1), cB + hstep); PG8_STAGE_A(PG8_SA(0, 0), offc, 0, 0); PG8_STAGE_A(PG8_SA(0, 1), offc, 1, 0);
    if (wr == 1) PG8_BAR;
    PG8_WAIT_V(2); PG8_BAR;
    PG8_STAGE_B(PG8_SB(1, 0), cB + kstep); PG8_STAGE_A(PG8_SA(1, 0), offc, 0, kstep); PG8_STAGE_B(PG8_SB(1, 1), cB + hstep + kstep);
    PG8_WAIT_V(6); PG8_BAR;
    for (;;) {
        const bool has_next = S.next(ui + 1, nxt);
        if (has_next) { PG8_OFFS(offn, nxt); }
        else {
#pragma unroll
            for (int _h = 0; _h < 2; ++_h)
#pragma unroll
                for (int _i = 0; _i < 2; ++_i) offn[_h][_i] = offc[_h][_i];
        }
        const char* nB = has_next ? (const char*)Btp + (size_t)nxt.pn * tstep : cB;
#pragma unroll 1
        for (int t = 0; t < nt; t += 2) {
            const bool last = (t == nt - 2);
            const size_t k1 = (size_t)(t + 1) * kstep;
            const size_t k2 = last ? 0 : (size_t)(t + 2) * kstep, k3 = k2 + kstep;
            unsigned o2[2][2];
#pragma unroll
            for (int _h = 0; _h < 2; ++_h)
#pragma unroll
                for (int _i = 0; _i < 2; ++_i) o2[_h][_i] = last ? offn[_h][_i] : offc[_h][_i];
            const char* b2 = last ? nB : cB + (size_t)(t + 2) * kstep; const char* b3 = b2 + kstep;
            PG8_LDB(B0, 0, 0); PG8_LDB(B1, 0, 1); PG8_SCHED; PG8_LDA(At, 0, 0); PG8_STAGE_A(PG8_SA(1, 1), offc, 1, k1);
            PG8_WAIT_V(8); PG8_WAIT_L(0); PG8_BAR; PG8_MMA(0, 0, At, B0); PG8_MMA(0, 1, At, B1); PG8_BAR; PG8_SCHED;
            PG8_LDA(At, 0, 1); PG8_STAGE_B(PG8_SB(0, 0), b2); PG8_STAGE_B(PG8_SB(0, 1), b2 + hstep); PG8_STAGE_A(PG8_SA(0, 0), o2, 0, k2);
            PG8_WAIT_V(8); PG8_WAIT_L(0); PG8_BAR; PG8_MMA(1, 0, At, B0); PG8_MMA(1, 1, At, B1); PG8_BAR; PG8_SCHED;
            PG8_LDB(B0, 1, 0); PG8_LDB(B1, 1, 1); PG8_SCHED; PG8_LDA(At, 1, 0); PG8_STAGE_A(PG8_SA(0, 1), o2, 1, k2);
            PG8_WAIT_V(8); PG8_WAIT_L(0); PG8_BAR; PG8_MMA(0, 0, At, B0); PG8_MMA(0, 1, At, B1); PG8_BAR; PG8_SCHED;
            PG8_LDA(At, 1, 1); PG8_STAGE_B(PG8_SB(1, 0), b3); PG8_STAGE_B(PG8_SB(1, 1), b3 + hstep); PG8_STAGE_A(PG8_SA(1, 0), o2, 0, k3);
            PG8_WAIT_V(8); PG8_WAIT_L(0); PG8_BAR; PG8_MMA(1, 0, At, B0); PG8_MMA(1, 1, At, B1); PG8_BAR; PG8_SCHED;
        }
        if constexpr (ALIGN_EPI) { if (wr == 0) PG8_BAR; }
        E(acc, cur, wr, wc, fr, fq);
        if (!has_next) break;
#pragma unroll
        for (int a = 0; a < 2; ++a)
#pragma unroll
            for (int b = 0; b < 2; ++b)
#pragma unroll
                for (int m = 0; m < 4; ++m)
#pragma unroll
                    for (int n = 0; n < 2; ++n) acc[a][b][m][n] = (f32x4){0.f, 0.f, 0.f, 0.f};
        cur = nxt; cB = nB; ++ui;
#pragma unroll
        for (int _h = 0; _h < 2; ++_h)
#pragma unroll
            for (int _i = 0; _i < 2; ++_i) offc[_h][_i] = offn[_h][_i];
        if constexpr (ALIGN_EPI) { if (wr == 1) PG8_BAR; }
    }
    PG8_WAIT_V(0);
    if constexpr (!ALIGN_EPI) { if (wr == 0) PG8_BAR; }
    PG8_BAR;
#undef PG8_SA
#undef PG8_SB
#undef PG8_STAGE_A
#undef PG8_STAGE_B
#undef PG8_LDA
#undef PG8_LDB
#undef PG8_MMA
#undef PG8_WAIT_V
#undef PG8_WAIT_L
#undef PG8_BAR
#undef PG8_SCHED
#undef PG8_OFFS
}
}

#define XB_TMO      128
#define XB_XCNT(j)  (256  + 64 * (j))
#define XB_XSUB(j)  (1280 + 64 * (j))
#define XB_XGEN(j)  (2304 + 64 * (j))
#define XB_TOP      3328
#define XB_TOPGEN   3392
#define XCD_BAR_WORDS 3456
#define XB_SPIN_CAP (1u << 18)
__device__ __forceinline__ unsigned xb_ld(unsigned* p)              { return __hip_atomic_load(p, __ATOMIC_RELAXED, __HIP_MEMORY_SCOPE_AGENT); }
__device__ __forceinline__ unsigned xb_add(unsigned* p, unsigned v) { return __hip_atomic_fetch_add(p, v, __ATOMIC_RELAXED, __HIP_MEMORY_SCOPE_AGENT); }
__device__ __forceinline__ unsigned xb_xcc_id() { return (unsigned)__builtin_amdgcn_s_getreg((3 << 11) | 20) & 0xFu; }
#define XB_SPIN(cond, bar) do { unsigned _sp = 0; while (cond) { __builtin_amdgcn_s_sleep(1); \
    if ((++_sp & 255u) == 0u) { if (xb_ld(&(bar)[XB_TMO])) break; if (_sp > XB_SPIN_CAP) { atomicAdd(&(bar)[XB_TMO], 1u); break; } } } } while (0)
struct XcdBarrier { unsigned* bar; unsigned x; volatile LAS unsigned* st; };
__device__ __forceinline__ XcdBarrier xcd_barrier_post(unsigned* bar, volatile LAS unsigned* st) {
    XcdBarrier b; b.bar = bar; b.x = xb_xcc_id(); b.st = st;
    if (threadIdx.x == 0) (void)xb_add(&bar[XB_XCNT(b.x)], 1u);
    return b;
}
__device__ __forceinline__ void xcd_barrier_complete(unsigned* bar, unsigned x, unsigned& nloc, unsigned& nx) {
    const unsigned G = gridDim.x * gridDim.y * gridDim.z;
    unsigned sum, cnt, mine, sp = 0u;
    for (;;) {
        sum = 0u; cnt = 0u; mine = 0u;
#pragma unroll
        for (unsigned j = 0; j < 16; ++j) { const unsigned c = xb_ld(&bar[XB_XCNT(j)]); sum += c; cnt += (c > 0u) ? 1u : 0u; mine = (j == x) ? c : mine; }
        if (sum == G) break;
        __builtin_amdgcn_s_sleep(1);
        if ((++sp & 255u) == 0u) { if (xb_ld(&bar[XB_TMO])) break; if (sp > XB_SPIN_CAP) { atomicAdd(&bar[XB_TMO], 1u); break; } }
    }
    nloc = mine > 0u ? mine : 1u; nx = cnt > 0u ? cnt : 1u;
}
__device__ __forceinline__ void xcd_barrier(const XcdBarrier& b) {
    asm volatile("s_waitcnt vmcnt(0)" ::: "memory");
    __syncthreads();
    if (threadIdx.x == 0) {
        unsigned* bar = b.bar;
        __builtin_amdgcn_s_waitcnt(0);
        unsigned nloc = b.st[0], nx = b.st[1];
        if (nloc == 0u) { xcd_barrier_complete(bar, b.x, nloc, nx); b.st[0] = nloc; b.st[1] = nx; }
        const unsigned old = xb_add(&bar[XB_XSUB(b.x)], 1u);
        const unsigned gen = old / nloc;
        if (old + 1u == (gen + 1u) * nloc) {
            __builtin_amdgcn_fence(__ATOMIC_RELEASE, "agent");
            asm volatile("s_waitcnt vmcnt(0)" ::: "memory");
            const unsigned og = xb_add(&bar[XB_TOP], 1u);
            const unsigned tg = og / nx;
            if (og + 1u == (tg + 1u) * nx) xb_add(&bar[XB_TOPGEN], 1u);
            else XB_SPIN(xb_ld(&bar[XB_TOPGEN]) == tg, bar);
            __builtin_amdgcn_fence(__ATOMIC_ACQUIRE, "agent");
            xb_add(&bar[XB_XGEN(b.x)], 1u);
            asm volatile("s_waitcnt vmcnt(0)" ::: "memory");
        } else {
            XB_SPIN(xb_ld(&bar[XB_XGEN(b.x)]) == gen, bar);
            __builtin_amdgcn_fence(__ATOMIC_ACQUIRE, "agent");
            asm volatile("s_waitcnt vmcnt(0)" ::: "memory");
        }
    }
    __syncthreads();
}

struct Args { const float* in[24]; float* out; unsigned char* ws; int ph_lo, ph_hi; };
struct Frame {
    LAS unsigned char* lds;
    volatile LAS unsigned* MISC;
    const Args* a;
    unsigned char* ws;
    unsigned* ctl;
    int tid, lane, wave, vcu, G;
};
#define FIN(i) (F.a->in[i])
#define F_x FIN(0)
#define F_c FIN(1)
#define F_w_ada FIN(2)
#define F_b_ada FIN(3)
#define F_g_attn FIN(4)
#define F_w_in FIN(5)
#define F_g_kv FIN(6)
#define F_w_uk FIN(7)
#define F_w_uv FIN(8)
#define F_lq1 FIN(9)
#define F_lk1 FIN(10)
#define F_lq2 FIN(11)
#define F_lk2 FIN(12)
#define F_g_sub FIN(13)
#define F_w_out FIN(14)
#define F_g_moe FIN(15)
#define F_w_group FIN(16)
#define F_b_group FIN(17)
#define F_w_router FIN(18)
#define F_b_router FIN(19)
#define F_w_gate FIN(20)
#define F_w_up FIN(21)
#define F_w_down FIN(22)
#define F_g_final FIN(23)
#define F_out (F.a->out)
#define F_mod ((float*)(F.ws + WS_MOD))
#define F_Win ((bf16_t*)(F.ws + WS_WIN))
#define F_Wout ((bf16_t*)(F.ws + WS_WOUT))
#define F_Wrt ((bf16_t*)(F.ws + WS_WRT))
#define F_Wuk ((bf16_t*)(F.ws + WS_WUK))
#define F_WuvT ((bf16_t*)(F.ws + WS_WUVT))
#define F_Wup ((bf16_t*)(F.ws + WS_WUP))
#define F_Wdn ((bf16_t*)(F.ws + WS_WDN))
#define F_XN ((bf16_t*)(F.ws + WS_XN))
#define F_DQ ((bf16_t*)(F.ws + WS_DQ))
#define F_FQ ((bf16_t*)(F.ws + WS_FQ))
#define F_FK ((bf16_t*)(F.ws + WS_FK))
#define F_FV ((bf16_t*)(F.ws + WS_FV))
#define F_YS ((bf16_t*)(F.ws + WS_YS))
#define F_O ((bf16_t*)(F.ws + WS_O))
#define F_DLAT ((bf16_t*)(F.ws + WS_DLAT))
#define F_CKV ((bf16_t*)(F.ws + WS_CKV))
#define F_IQ ((bf16_t*)(F.ws + WS_IQ))
#define F_IK ((bf16_t*)(F.ws + WS_IK))
#define F_HS ((bf16_t*)(F.ws + WS_HS))
#define F_IW ((float*)(F.ws + WS_IW))
#define F_LOG ((float*)(F.ws + WS_LOG))
#define F_GL ((float*)(F.ws + WS_GL))
#define F_REID ((int*)(F.ws + WS_REID))
#define F_RSLOT ((int*)(F.ws + WS_RSLOT))
#define F_TOK ((int*)(F.ws + WS_TOK))

__device__ __forceinline__ void p0_mod(Frame& F) {
    LAS float* ca = (LAS float*)(F.lds);
    LAS float* red = (LAS float*)(F.lds + 32768);
    for (int i = F.tid; i < NB * DM; i += NTHREADS) { const float v = F_c[i]; ca[i] = v / (1.f + __expf(-v)); }
    __syncthreads();
    const int kr = F.lane >> 3, c4 = F.lane & 7;
    for (int item = blockIdx.x; item < 192; item += F.G) {
        const int n0 = item * 32;
        float acc[4][8];
#pragma unroll
        for (int j = 0; j < 4; ++j)
#pragma unroll
            for (int b = 0; b < 8; ++b) acc[j][b] = 0.f;
#pragma unroll 4
        for (int it = 0; it < 16; ++it) {
            const int k = F.wave * 128 + it * 8 + kr;
            const f32x4 w = *(const f32x4*)(F_w_ada + (size_t)k * 6144 + n0 + c4 * 4);
#pragma unroll
            for (int b = 0; b < 8; ++b) { const float cv = ca[b * DM + k];
#pragma unroll
                for (int j = 0; j < 4; ++j) acc[j][b] += w[j] * cv; }
        }
#pragma unroll
        for (int j = 0; j < 4; ++j)
#pragma unroll
            for (int b = 0; b < 8; ++b) { float v = acc[j][b]; v += __shfl_xor(v, 8); v += __shfl_xor(v, 16); v += __shfl_xor(v, 32);
                if (kr == 0) red[(F.wave * 32 + c4 * 4 + j) * 8 + b] = v; }
        __syncthreads();
        if (F.tid < 256) { const int col = F.tid >> 3, b = F.tid & 7; float s = 0.f;
#pragma unroll
            for (int w = 0; w < 8; ++w) s += red[(w * 32 + col) * 8 + b];
            F_mod[b * 6144 + n0 + col] = s + F_b_ada[n0 + col]; }
        __syncthreads();
    }
}
__device__ __forceinline__ void tr_block(const float* W, int ldw, int k0, int c0, int nv, bf16_t* WT, int ldt, int r0, LAS float* scr, int lane) {
#pragma unroll 8
    for (int i = 0; i < 32; ++i) { const int kk = 2 * i + (lane >> 5), n = lane & 31; scr[kk * 33 + n] = (n < nv) ? W[(size_t)(k0 + kk) * ldw + c0 + n] : 0.f; }
    LDS_WAIT(); asm volatile("" ::: "memory");
    const int c = lane & 7;
#pragma unroll
    for (int j = 0; j < 4; ++j) { const int n = (lane >> 3) + 8 * j; const LAS float* s = scr + (8 * c) * 33 + n;
        u32x4 o; o.x = pk2(s[0 * 33], s[1 * 33]); o.y = pk2(s[2 * 33], s[3 * 33]); o.z = pk2(s[4 * 33], s[5 * 33]); o.w = pk2(s[6 * 33], s[7 * 33]);
        *(u32x4*)(WT + (size_t)(r0 + n) * ldt + k0 + 8 * c) = o; }
    LDS_WAIT(); asm volatile("" ::: "memory");
}
__device__ __forceinline__ void p0_weights(Frame& F) {
    LAS float* scr = (LAS float*)(F.lds + F.wave * 16384);
    const int gw = F.vcu * NWAVES + F.wave, NGW = F.G * NWAVES;
    constexpr int I_IN = 16 * 80, I_OUT = 16 * 32, I_RT = 16 * 8, I_UV = 32, I_UP = 32 * 2 * 2 * 4 * 16, I_DN = 32 * 4 * 32;
    constexpr int NITEMS = I_IN + I_OUT + I_RT + I_UV + I_UP + I_DN;
    for (int it = gw; it < NITEMS; it += NGW) {
        int r = it;
        if (r < I_IN) { const int kb = r / 80, nb = r % 80, n0 = nb * 32; int c0 = 0, nv = 32;
            if (n0 < 512) c0 = n0; else if (n0 < 1024) c0 = 804 + (n0 - 512); else if (n0 < 1536) c0 = 1316 + (n0 - 1024); else if (n0 < 2048) c0 = 1828 + (n0 - 1536);
            else if (n0 < 2176) c0 = 512 + (n0 - 2048); else if (n0 < 2304) c0 = 640 + (n0 - 2176); else if (n0 == 2304) c0 = 768; else if (n0 == 2336) { c0 = 800; nv = 4; } else { c0 = 0; nv = 0; }
            tr_block(F_w_in, 2340, kb * 64, c0, nv, F_Win, DM, n0, scr, F.lane); continue; } r -= I_IN;
        if (r < I_OUT) { const int kb = r / 32, nb = r % 32; tr_block(F_w_out, DM, kb * 64, nb * 32, 32, F_Wout, DM, nb * 32, scr, F.lane); continue; } r -= I_OUT;
        if (r < I_RT) { const int kb = r / 8, nb = r % 8;
            if (nb == 0) tr_block(F_w_router, 32, kb * 64, 0, 32, F_Wrt, DM, 0, scr, F.lane);
            else if (nb == 1) tr_block(F_w_group, 4, kb * 64, 0, 4, F_Wrt, DM, 32, scr, F.lane);
            else tr_block(F_w_group, 4, kb * 64, 0, 0, F_Wrt, DM, nb * 32, scr, F.lane);
            continue; } r -= I_RT;
        if (r < I_UV) { const int h = r >> 2, kb = (r >> 1) & 1, nb = r & 1; tr_block(F_w_uv + h * 8192, 64, kb * 64, nb * 32, 32, F_WuvT + h * 8192, 128, nb * 32, scr, F.lane); continue; } r -= I_UV;
        if (r < I_UP) { const int kb = r & 15, nb4 = (r >> 4) & 3, gu = (r >> 6) & 1, jt = (r >> 7) & 1, e = r >> 8;
            tr_block((gu ? F_w_up : F_w_gate) + (size_t)e * 262144, 256, kb * 64, jt * 128 + nb4 * 32, 32, F_Wup, DM, e * 512 + jt * 256 + gu * 128 + nb4 * 32, scr, F.lane); continue; } r -= I_UP;
        { const int nb = r & 31, kb = (r >> 5) & 3, e = r >> 7;
            tr_block(F_w_down + (size_t)e * 262144, DM, kb * 64, nb * 32, 32, F_Wdn + (size_t)e * 262144, 256, nb * 32, scr, F.lane); }
    }
    for (int i = (blockIdx.x * NTHREADS + F.tid) * 4; i < 65536; i += F.G * NTHREADS * 4) { const f32x4 v = *(const f32x4*)(F_w_uk + i); u32x2 o; o.x = pk2(v[0], v[1]); o.y = pk2(v[2], v[3]); *(u32x2*)(F_Wuk + i) = o; }
}

__device__ __forceinline__ void modnorm_rows(Frame& F, const float* src, const float* g, int shift_off, int scale_off, bf16_t* dst) {
    const int gw = F.vcu * NWAVES + F.wave, NGW = F.G * NWAVES;
    constexpr int RPW = 32;
    for (int it = gw; it < NT / RPW; it += NGW) {
        const int m0 = it * RPW, b = m0 / SEQ;
        f32x4 G[4], SH[4];
#pragma unroll
        for (int j = 0; j < 4; ++j) { const f32x4 gg = *((const f32x4*)g + F.lane + 64 * j);
            const f32x4 sc = *((const f32x4*)(F_mod + b * 6144 + scale_off) + F.lane + 64 * j); SH[j] = *((const f32x4*)(F_mod + b * 6144 + shift_off) + F.lane + 64 * j);
            G[j] = gg * (sc + 1.f); }
        f32x4 v[4];
#pragma unroll
        for (int j = 0; j < 4; ++j) v[j] = *((const f32x4*)(src + (size_t)m0 * DM) + F.lane + 64 * j);
#pragma unroll 1
        for (int r = 0; r < RPW; ++r) {
            const size_t m = (size_t)m0 + r;
            f32x4 nx[4];
            const size_t mn = (r + 1 < RPW) ? m + 1 : m;
#pragma unroll
            for (int j = 0; j < 4; ++j) nx[j] = *((const f32x4*)(src + mn * DM) + F.lane + 64 * j);
            float s = 0.f;
#pragma unroll
            for (int j = 0; j < 4; ++j) s += (v[j].x * v[j].x + v[j].y * v[j].y) + (v[j].z * v[j].z + v[j].w * v[j].w);
            const float rstd = 1.f / sqrtf(wave_sum(s) * (1.f / DM) + RMS_EPS);
            u32x2* o8 = (u32x2*)(dst + m * DM) + F.lane;
#pragma unroll
            for (int j = 0; j < 4; ++j) { const f32x4 y = (v[j] * rstd) * G[j] + SH[j]; u32x2 o; o.x = pk2(y.x, y.y); o.y = pk2(y.z, y.w); o8[64 * j] = o; }
#pragma unroll
            for (int j = 0; j < 4; ++j) v[j] = nx[j];
        }
    }
}
__device__ __forceinline__ void ckv_rows(Frame& F) {
    const int gw = F.vcu * NWAVES + F.wave, NGW = F.G * NWAVES;
    const int sub = F.lane >> 5, l32 = F.lane & 31;
    const f32x4 gg = *((const f32x4*)F_g_kv + l32);
    for (int it = gw; it < NT / 2; it += NGW) {
        const size_t row = (size_t)it * 2 + sub;
        const u32x2 w = *((const u32x2*)(F_DLAT + row * 128) + l32);
        const float a = bflo(w.x), b = bfhi(w.x), c = bflo(w.y), d = bfhi(w.y);
        float s = (a * a + b * b) + (c * c + d * d);
#pragma unroll
        for (int o = 1; o < 32; o <<= 1) s += __shfl_xor(s, o);
        const float rstd = 1.f / sqrtf(s * (1.f / 128.f) + RMS_EPS);
        u32x2 o; o.x = pk2(a * rstd * gg.x, b * rstd * gg.y); o.y = pk2(c * rstd * gg.z, d * rstd * gg.w);
        *((u32x2*)(F_CKV + row * 128) + l32) = o;
    }
}

struct EpiProj {
    static constexpr bool PERM = true;
    bf16_t *DQ, *FQ, *FK, *FV, *DLAT, *IQ, *IK; float* IW;
    __device__ __forceinline__ void operator()(const f32x4 (&acc)[2][2][4][2], const pg8::Unit& u, int wr, int wc, int fr, int fq) const {
        const int row0 = u.pm * 256 + wr * 64 + fr;
#pragma unroll
        for (int bj = 0; bj < 2; ++bj) {
            const int sg = 2 * u.pn + bj;
            if (sg < 18) {
                bf16_t* base; int ld, col; float sc = 1.f;
                if (sg < 16) { const int t = sg >> 2; base = (t == 0) ? DQ : (t == 1) ? FQ : (t == 2) ? FK : FV; ld = 512; col = (sg & 3) * 128 + wc * 32 + 8 * fq; if (t == 1) sc = DIFF_C2; }
                else { base = (sg == 16) ? DLAT : IQ; ld = 128; col = wc * 32 + 8 * fq; }
#pragma unroll
                for (int ai = 0; ai < 2; ++ai)
#pragma unroll
                    for (int m = 0; m < 4; ++m) { const f32x4 v0 = acc[ai][bj][m][0] * sc, v1 = acc[ai][bj][m][1] * sc;
                        u32x4 w; w.x = pk2(v0[0], v0[1]); w.y = pk2(v0[2], v0[3]); w.z = pk2(v1[0], v1[1]); w.w = pk2(v1[2], v1[3]);
                        *(u32x4*)(base + (size_t)(row0 + ai * 128 + m * 16) * ld + col) = w; }
            } else if (sg == 18) {
                if (wc == 0) {
#pragma unroll
                    for (int ai = 0; ai < 2; ++ai)
#pragma unroll
                        for (int m = 0; m < 4; ++m) { const f32x4 v0 = acc[ai][bj][m][0], v1 = acc[ai][bj][m][1];
                            u32x4 w; w.x = pk2(v0[0], v0[1]); w.y = pk2(v0[2], v0[3]); w.z = pk2(v1[0], v1[1]); w.w = pk2(v1[2], v1[3]);
                            *(u32x4*)(IK + (size_t)(row0 + ai * 128 + m * 16) * 32 + 8 * fq) = w; }
                } else if (wc == 1 && fq == 0) {
#pragma unroll
                    for (int ai = 0; ai < 2; ++ai)
#pragma unroll
                        for (int m = 0; m < 4; ++m) *(f32x4*)(IW + (size_t)(row0 + ai * 128 + m * 16) * 4) = acc[ai][bj][m][0] * IW_SCALE;
                }
            }
        }
    }
};
struct EpiX1 {
    static constexpr bool PERM = false;
    const float* x; const float* mod; float* x1;
    __device__ __forceinline__ void operator()(const f32x4 (&acc)[2][2][4][2], const pg8::Unit& u, int wr, int wc, int fr, int fq) const {
        const int row0 = u.pm * 256 + wr * 64 + fr; const int b = (u.pm * 256) / SEQ;
#pragma unroll
        for (int bj = 0; bj < 2; ++bj)
#pragma unroll
            for (int n = 0; n < 2; ++n) { const int col = u.pn * 256 + bj * 128 + wc * 32 + n * 16 + 4 * fq;
                const f32x4 gv = *(const f32x4*)(mod + b * 6144 + 2048 + col);
#pragma unroll
                for (int ai = 0; ai < 2; ++ai)
#pragma unroll
                    for (int m = 0; m < 4; ++m) { const size_t off = (size_t)(row0 + ai * 128 + m * 16) * DM + col;
                        const f32x4 xv = *(const f32x4*)(x + off); *(f32x4*)(x1 + off) = xv + gv * acc[ai][bj][m][n]; } }
    }
};
struct EpiLogits {
    static constexpr bool PERM = false;
    float* LOG; const float* b_router; const float* b_group;
    __device__ __forceinline__ void operator()(const f32x4 (&acc)[2][2][4][2], const pg8::Unit& u, int wr, int wc, int fr, int fq) const {
        if (wc > 1) return;
        const int row0 = u.pm * 256 + wr * 64 + fr;
#pragma unroll
        for (int n = 0; n < 2; ++n) { const int col = wc * 32 + n * 16 + 4 * fq;
            if (col < 36) { const f32x4 bv = (col < 32) ? *(const f32x4*)(b_router + col) : *(const f32x4*)(b_group);
#pragma unroll
                for (int ai = 0; ai < 2; ++ai)
#pragma unroll
                    for (int m = 0; m < 4; ++m) *(f32x4*)(LOG + (size_t)(row0 + ai * 128 + m * 16) * 64 + col) = acc[ai][0][m][n] + bv; } }
    }
};
__device__ __forceinline__ float silu_f(float v) { return v * __builtin_amdgcn_rcpf(1.f + __expf(-v)); }
struct EpiUp {
    static constexpr bool PERM = true;
    bf16_t* HS;
    __device__ __forceinline__ void operator()(const f32x4 (&acc)[2][2][4][2], const pg8::Unit& u, int wr, int wc, int fr, int fq) const {
        const int row0 = u.pm * 256 + wr * 64 + fr; const int col = (u.pn & 1) * 128 + wc * 32 + 8 * fq;
#pragma unroll
        for (int ai = 0; ai < 2; ++ai)
#pragma unroll
            for (int m = 0; m < 4; ++m) { const f32x4 g0 = acc[ai][0][m][0], g1 = acc[ai][0][m][1], u0 = acc[ai][1][m][0], u1 = acc[ai][1][m][1];
                u32x4 w; w.x = pk2(silu_f(g0[0]) * u0[0], silu_f(g0[1]) * u0[1]); w.y = pk2(silu_f(g0[2]) * u0[2], silu_f(g0[3]) * u0[3]);
                w.z = pk2(silu_f(g1[0]) * u1[0], silu_f(g1[1]) * u1[1]); w.w = pk2(silu_f(g1[2]) * u1[2], silu_f(g1[3]) * u1[3]);
                *(u32x4*)(HS + (size_t)(row0 + ai * 128 + m * 16) * 256 + col) = w; }
    }
};
struct EpiDown {
    static constexpr bool PERM = true;
    bf16_t* YS; const float* GL; const LAS int* ecnt;
    __device__ __forceinline__ void operator()(const f32x4 (&acc)[2][2][4][2], const pg8::Unit& u, int wr, int wc, int fr, int fq) const {
        const int r0 = wr * 64 + fr; const int e = u.a0; const int cnt = ecnt[e];
        const int colb = (u.pn & 3) * 256 + wc * 32 + 8 * fq;
#pragma unroll
        for (int ai = 0; ai < 2; ++ai)
#pragma unroll
            for (int m = 0; m < 4; ++m) { const int r = r0 + ai * 128 + m * 16; int slot = u.a1 + r; slot = slot < cnt ? slot : cnt - 1;
                const float g = GL[(size_t)e * NT + slot];
#pragma unroll
                for (int bj = 0; bj < 2; ++bj) { const f32x4 v0 = acc[ai][bj][m][0] * g, v1 = acc[ai][bj][m][1] * g;
                    u32x4 w; w.x = pk2(v0[0], v0[1]); w.y = pk2(v0[2], v0[3]); w.z = pk2(v1[0], v1[1]); w.w = pk2(v1[2], v1[3]);
                    *(u32x4*)(YS + (size_t)(u.pm * 256 + r) * DM + colb + bj * 128) = w; } }
    }
};

struct MoeTab { LAS int* ecnt; LAS int* toff; };
__device__ __forceinline__ MoeTab moe_tables(Frame& F) {
    MoeTab t; t.ecnt = (LAS int*)(F.lds + MISC_OFF + 128); t.toff = t.ecnt + 32;
    __syncthreads();
    if (F.tid < 32) t.ecnt[F.tid] = (int)__hip_atomic_load(F.ctl + CW_ECNT + 64 * F.tid, __ATOMIC_RELAXED, __HIP_MEMORY_SCOPE_AGENT);
    __syncthreads();
    if (F.tid == 0) { int s = 0; for (int e = 0; e < 32; ++e) { t.toff[e] = s; s += (t.ecnt[e] + 255) >> 8; } t.toff[32] = s; }
    __syncthreads();
    return t;
}
template <int NPN, bool GATHER> struct MoeOrder {
    MoeTab tab; int G, c, K; const int* TOK;
    __device__ bool next(int i, pg8::Unit& u) const {
        const long L = (long)i * G + c; const int total = tab.toff[32] * NPN; if (L >= total) return false;
        const int rt = (int)(L / NPN), pl = (int)(L % NPN);
        int e = 0;
#pragma unroll 1
        for (int j = 1; j < 32; ++j) e = (tab.toff[j] <= rt) ? j : e;
        u.pm = rt; u.pn = e * NPN + pl; u.a0 = e; u.a1 = (rt - tab.toff[e]) * 256; return true;
    }
    __device__ __forceinline__ unsigned a_off(const pg8::Unit& u, int R) const {
        if constexpr (GATHER) { const int cnt = tab.ecnt[u.a0]; int slot = u.a1 + R; slot = slot < cnt ? slot : cnt - 1; return (unsigned)TOK[(size_t)u.a0 * NT + slot] * (unsigned)(K * 2); }
        else return (unsigned)(u.pm * 256 + R) * (unsigned)(K * 2);
    }
};
__device__ __forceinline__ void route_panel(Frame& F, int pm) {
    LAS int* lc = (LAS int*)(F.lds);
    LAS int* lb = lc + 32;
    {
        const bool act = F.tid < 256; const int tok = pm * 256 + (act ? F.tid : 0);
        if (F.tid < 32) lc[F.tid] = 0;
        __syncthreads();
        const float* lg = F_LOG + (size_t)tok * 64;
        float gl[4];
        { const f32x4 v = *(const f32x4*)(lg + 32); gl[0] = v[0]; gl[1] = v[1]; gl[2] = v[2]; gl[3] = v[3]; }
        int gs = 0; float gm = gl[0];
#pragma unroll
        for (int j = 1; j < 4; ++j) if (gl[j] > gm) { gm = gl[j]; gs = j; }
        float den = 0.f;
#pragma unroll
        for (int j = 0; j < 4; ++j) den += __expf(gl[j] - gm);
        const float pg = 1.f / den;
        float el[8];
        { const f32x4 a = *(const f32x4*)(lg + gs * 8), b = *(const f32x4*)(lg + gs * 8 + 4); el[0] = a[0]; el[1] = a[1]; el[2] = a[2]; el[3] = a[3]; el[4] = b[0]; el[5] = b[1]; el[6] = b[2]; el[7] = b[3]; }
        int i0 = 0; float v0 = el[0];
#pragma unroll
        for (int j = 1; j < 8; ++j) if (el[j] > v0) { v0 = el[j]; i0 = j; }
        int i1 = -1; float v1 = -INFINITY;
#pragma unroll
        for (int j = 0; j < 8; ++j) if (j != i0 && (i1 < 0 || el[j] > v1)) { v1 = el[j]; i1 = j; }
        const float ex = __expf(v1 - v0); const float w0 = pg / (1.f + ex), w1 = w0 * ex;
        const int e0 = gs * 8 + i0, e1 = gs * 8 + i1;
        int r0 = 0, r1 = 0;
        if (act) { r0 = __hip_atomic_fetch_add(lc + e0, 1, __ATOMIC_RELAXED, __HIP_MEMORY_SCOPE_WORKGROUP); r1 = __hip_atomic_fetch_add(lc + e1, 1, __ATOMIC_RELAXED, __HIP_MEMORY_SCOPE_WORKGROUP); }
        __syncthreads();
        if (F.tid < 32) lb[F.tid] = (int)__hip_atomic_fetch_add(F.ctl + CW_ECNT + 64 * F.tid, (unsigned)lc[F.tid], __ATOMIC_RELAXED, __HIP_MEMORY_SCOPE_AGENT);
        __syncthreads();
        if (act) { const int s0 = lb[e0] + r0, s1 = lb[e1] + r1;
            F_TOK[(size_t)e0 * NT + s0] = tok; F_TOK[(size_t)e1 * NT + s1] = tok;
            F_GL[(size_t)e0 * NT + s0] = w0; F_GL[(size_t)e1 * NT + s1] = w1;
            *(int2*)(F_REID + (size_t)tok * 2) = make_int2(e0, e1);
            *(int2*)(F_RSLOT + (size_t)tok * 2) = make_int2(s0, s1); }
        __syncthreads();
    }
}
__device__ __forceinline__ void combine_rows(Frame& F, const MoeTab& tab) {
    const int gw = F.vcu * NWAVES + F.wave, NGW = F.G * NWAVES;
    constexpr int RPW = 32;
    for (int it = gw; it < NT / RPW; it += NGW) {
        const int m0 = it * RPW, b = m0 / SEQ;
        f32x4 GM[4], GF[4];
#pragma unroll
        for (int j = 0; j < 4; ++j) { GM[j] = *((const f32x4*)(F_mod + b * 6144 + 5120) + F.lane + 64 * j); GF[j] = *((const f32x4*)F_g_final + F.lane + 64 * j); }
        int2 ee = *(const int2*)(F_REID + (size_t)m0 * 2), ss = *(const int2*)(F_RSLOT + (size_t)m0 * 2);
        f32x4 xv[4]; u32x2 ya[4], yc[4];
        { const size_t p0 = (size_t)tab.toff[ee.x] * 256 + ss.x, p1 = (size_t)tab.toff[ee.y] * 256 + ss.y;
#pragma unroll
          for (int j = 0; j < 4; ++j) { xv[j] = *((const f32x4*)(F_out + (size_t)m0 * DM) + F.lane + 64 * j); ya[j] = *((const u32x2*)(F_YS + p0 * DM) + F.lane + 64 * j); yc[j] = *((const u32x2*)(F_YS + p1 * DM) + F.lane + 64 * j); } }
#pragma unroll 1
        for (int r = 0; r < RPW; ++r) {
            const size_t m = (size_t)m0 + r; const size_t mn = (r + 1 < RPW) ? m + 1 : m;
            const int2 een = *(const int2*)(F_REID + mn * 2), ssn = *(const int2*)(F_RSLOT + mn * 2);
            f32x4 v[4]; float s = 0.f;
#pragma unroll
            for (int j = 0; j < 4; ++j) { const u32x2 a = ya[j], c = yc[j];
                const f32x4 ys = {bflo(a.x) + bflo(c.x), bfhi(a.x) + bfhi(c.x), bflo(a.y) + bflo(c.y), bfhi(a.y) + bfhi(c.y)};
                v[j] = xv[j] + GM[j] * ys; s += (v[j].x * v[j].x + v[j].y * v[j].y) + (v[j].z * v[j].z + v[j].w * v[j].w); }
            { const size_t p0 = (size_t)tab.toff[een.x] * 256 + ssn.x, p1 = (size_t)tab.toff[een.y] * 256 + ssn.y;
#pragma unroll
              for (int j = 0; j < 4; ++j) { xv[j] = *((const f32x4*)(F_out + mn * DM) + F.lane + 64 * j); ya[j] = *((const u32x2*)(F_YS + p0 * DM) + F.lane + 64 * j); yc[j] = *((const u32x2*)(F_YS + p1 * DM) + F.lane + 64 * j); } }
            const float rstd = 1.f / sqrtf(wave_sum(s) * (1.f / DM) + RMS_EPS);
            f32x4* orow = (f32x4*)(F_out + m * DM) + F.lane;
#pragma unroll
            for (int j = 0; j < 4; ++j) orow[64 * j] = (v[j] * rstd) * GF[j];
        }
    }
}

constexpr float DIFF_SKIP_LOG2 = 150.f;
__device__ __forceinline__ int diff_tstart(int h, int qb) {
    const float slope2 = exp2f(-2.0f * (float)(h + 1)) * LOG2E;
    const float tmax = ((float)(128 * qb - 63) - DIFF_SKIP_LOG2 / slope2) * (1.f / 64.f);
    int t = (int)floorf(tmax) + 1; return t < 0 ? 0 : t;
}
__device__ __forceinline__ void knorm_rows(Frame& F) {
    const int gw = F.vcu * NWAVES + F.wave, NGW = F.G * NWAVES;
    float* KN2 = (float*)(F.ws + WS_KN2);
    for (int it = gw; it < NB * 128; it += NGW) {
        const int b = it >> 7, tile = it & 127;
        const u32x4* rp = (const u32x4*)(F_FK + ((size_t)(b * SEQ + tile * 64)) * 512) + F.lane;
        float mx = 0.f;
#pragma unroll 4
        for (int r = 0; r < 64; ++r) { const u32x4 v = rp[(size_t)r * 64];
            float s = bflo(v.x) * bflo(v.x) + bfhi(v.x) * bfhi(v.x); s += bflo(v.y) * bflo(v.y) + bfhi(v.y) * bfhi(v.y); s += bflo(v.z) * bflo(v.z) + bfhi(v.z) * bfhi(v.z); s += bflo(v.w) * bflo(v.w) + bfhi(v.w) * bfhi(v.w);
            s += __shfl_xor(s, 1); s += __shfl_xor(s, 2); s += __shfl_xor(s, 4);
            mx = fmaxf(mx, s); }
        if ((F.lane & 7) == 0) { const int hs = F.lane >> 3; KN2[((size_t)(b * 8 + hs)) * 128 + tile] = mx; }
    }
}
__device__ __forceinline__ void diff_unit(Frame& F, int b, int h, int qb, float lam, float lam_init) {
    int tid = F.tid; asm volatile("" : "+v"(tid));
    const int lane = tid & 63, wave = F.wave;
    const int r32 = lane & 31, hi = lane >> 5;
    const int st = wave >> 2, wq = wave & 3;
    const int q0 = qb * 128, nt = 2 * qb + 2;
    const int t0 = diff_tstart(h, qb);
    const float slope2 = exp2f(-2.0f * (float)(h + 1)) * LOG2E;
    LAS unsigned char* L = F.lds;
    const int qpos = q0 + 32 * wq + r32;
    bf16x8 qf[4];
    { const bf16_t* qp = F_FQ + ((size_t)(b * SEQ + qpos) * 512 + h * 128 + st * 64 + hi * 8);
#pragma unroll
      for (int s = 0; s < 4; ++s) qf[s] = *(const bf16x8*)(qp + 16 * s); }
    float mref;
    { float qs = 0.f;
#pragma unroll
      for (int s = 0; s < 4; ++s)
#pragma unroll
          for (int j = 0; j < 8; ++j) { const float v = bf2f((unsigned short)qf[s][j]); qs += v * v; }
      qs += __shfl_xor(qs, 32);
      const float* kn = (const float*)(F.ws + WS_KN2) + ((size_t)(b * 8 + h * 2 + st)) * 128;
      float km = 0.f;
      for (int t = t0 + lane; t < nt; t += 64) km = fmaxf(km, kn[t]);
#pragma unroll
      for (int o = 1; o < 64; o <<= 1) km = fmaxf(km, __shfl_xor(km, o));
      mref = sqrtf(qs) * sqrtf(km); }
    const int srow = 4 * wave + (lane >> 4), sslot = lane & 15;
    const unsigned schunk = (unsigned)sslot ^ ((((unsigned)srow & 3u) << 2) | (((unsigned)srow >> 2) & 3u));
    const size_t gk = ((size_t)(b * SEQ) * 512 + h * 128) + (size_t)srow * 512 + schunk * 8;
    const unsigned ldsb = (unsigned)(uintptr_t)(L + wave * 1024);
#define DIFF_GLDS(gp, ldsoff) do { unsigned keep_; asm volatile("s_mov_b32 %0, m0\n\ts_mov_b32 m0, %2\n\ts_nop 0\n\tglobal_load_lds_dwordx4 %1, off\n\ts_mov_b32 m0, %0" : "=&s"(keep_) : "v"(gp), "s"((unsigned)__builtin_amdgcn_readfirstlane(ldsb + (ldsoff))) : "memory"); } while (0)
#define DIFF_STAGE(t, bo) do { const size_t go = gk + (size_t)(t) * 64 * 512; \
        DIFF_GLDS(F_FK + go, (bo)); DIFF_GLDS(F_FK + go + 32 * 512, (bo) + 8192); DIFF_GLDS(F_FV + go, 49152 + (bo)); DIFF_GLDS(F_FV + go + 32 * 512, 49152 + (bo) + 8192); } while (0)
    const unsigned kswz = ((unsigned)(r32 & 3) << 2) | ((unsigned)(r32 >> 2) & 3u);
    unsigned koff[4];
#pragma unroll
    for (int s = 0; s < 4; ++s) koff[s] = 256u * r32 + 16u * (((unsigned)(8 * st + 2 * s + hi)) ^ kswz);
    const int qq = (lane & 15) >> 2, pp = lane & 3, blk = (lane >> 4) & 1;
    unsigned vo[2][4];
#pragma unroll
    for (int tt = 0; tt < 2; ++tt)
#pragma unroll
        for (int cb = 0; cb < 4; ++cb) vo[tt][cb] = 256u * (unsigned)(8 * tt + 4 * hi + qq) + 16u * (((unsigned)(4 * cb + 2 * blk + (pp >> 1))) ^ (((unsigned)qq << 2) | ((unsigned)(2 * tt + hi) & 3u))) + 8u * (unsigned)(pp & 1);
    int b0 = 0, b1 = 16384, b2 = 32768;
    DIFF_STAGE(t0, b0); DIFF_STAGE(t0 + 1, b1);
    asm volatile("s_waitcnt vmcnt(0)" ::: "memory");
    __syncthreads();
    float lrow = 0.f;
    f32x16 o[4];
#pragma unroll
    for (int cb = 0; cb < 4; ++cb)
#pragma unroll
        for (int r = 0; r < 16; ++r) o[cb][r] = 0.f;
    f32x16 p[2];
#define DIFF_KFR(dst, Kb_, kh_) do { _Pragma("unroll") for (int s = 0; s < 4; ++s) dst[s] = *(const LAS bf16x8*)((Kb_) + (kh_) * 8192 + koff[s]); } while (0)
#define DIFF_QKH(dst, kf_, t_, kh_) do { const float cbias = slope2 * (float)(64 * (t_) + 32 * (kh_) + 4 * hi - qpos) - mref; f32x16 c; \
        _Pragma("unroll") for (int r = 0; r < 16; ++r) c[r] = fmaf(slope2, (float)((r & 3) + 8 * (r >> 2)), cbias); \
        _Pragma("unroll") for (int s = 0; s < 4; ++s) c = MFMA32(kf_[s], qf[s], c); dst = c; } while (0)
#define DIFF_VFR(dst, cb_) do { _Pragma("unroll") for (int ks = 0; ks < 4; ++ks) { const s16x4 v0_ = tr_read((const LAS char*)(Vb + vo[0][cb_] + 4096 * ks)); const s16x4 v1_ = tr_read((const LAS char*)(Vb + vo[1][cb_] + 4096 * ks)); dst[ks] = cat8(v0_, v1_); } } while (0)
    { bf16x8 ka[4], kb_[4]; DIFF_KFR(ka, L + b0, 0); DIFF_KFR(kb_, L + b0, 1); DIFF_QKH(p[0], ka, t0, 0); DIFF_QKH(p[1], kb_, t0, 1); }
#pragma unroll 1
    for (int t = t0; t < nt; ++t) {
        const bool more = (t + 1 < nt);
        if (t + 2 < nt) DIFF_STAGE(t + 2, b2);
        const LAS unsigned char* Kn = L + b1;
        const LAS unsigned char* Vb = L + 49152 + b0;
        bf16x8 kfa[4], kfb[4], vfa[4], vfb[4];
        DIFF_VFR(vfa, 0);
        if (more) { DIFF_KFR(kfa, Kn, 0); DIFF_KFR(kfb, Kn, 1); }
        __builtin_amdgcn_sched_barrier(0);
        if (t >= nt - 2) {
#pragma unroll
            for (int kh = 0; kh < 2; ++kh)
#pragma unroll
                for (int r = 0; r < 16; ++r) { const int kpos = 64 * t + 32 * kh + crow(r, hi); if (kpos > qpos) p[kh][r] = -INFINITY; }
        }
        float ps = 0.f;
#pragma unroll
        for (int kh = 0; kh < 2; ++kh)
#pragma unroll
            for (int r = 0; r < 16; ++r) { const float e = __builtin_amdgcn_exp2f(p[kh][r]); p[kh][r] = e; ps += e; }
        lrow += ps;
        bf16x8 pa[4];
#pragma unroll
        for (int ks = 0; ks < 4; ++ks) { const int kh = ks >> 1, r0 = (ks & 1) * 8;
            u32x4 w; w.x = pk2(p[kh][r0], p[kh][r0 + 1]); w.y = pk2(p[kh][r0 + 2], p[kh][r0 + 3]); w.z = pk2(p[kh][r0 + 4], p[kh][r0 + 5]); w.w = pk2(p[kh][r0 + 6], p[kh][r0 + 7]);
            pa[ks] = __builtin_bit_cast(bf16x8, w); }
        __builtin_amdgcn_sched_barrier(0);
        DIFF_VFR(vfb, 1);
        __builtin_amdgcn_sched_barrier(0);
#pragma unroll
        for (int ks = 0; ks < 4; ++ks) o[0] = MFMA32(vfa[ks], pa[ks], o[0]);
        __builtin_amdgcn_sched_barrier(0);
        DIFF_VFR(vfa, 2);
        __builtin_amdgcn_sched_barrier(0);
#pragma unroll
        for (int ks = 0; ks < 4; ++ks) o[1] = MFMA32(vfb[ks], pa[ks], o[1]);
        __builtin_amdgcn_sched_barrier(0);
        DIFF_VFR(vfb, 3);
        __builtin_amdgcn_sched_barrier(0);
#pragma unroll
        for (int ks = 0; ks < 4; ++ks) o[2] = MFMA32(vfa[ks], pa[ks], o[2]);
        if (more) { DIFF_QKH(p[0], kfa, t + 1, 0); }
#pragma unroll
        for (int ks = 0; ks < 4; ++ks) o[3] = MFMA32(vfb[ks], pa[ks], o[3]);
        if (more) { DIFF_QKH(p[1], kfb, t + 1, 1); }
        asm volatile("s_waitcnt vmcnt(0)" ::: "memory");
        __syncthreads();
        { const int tb_ = b0; b0 = b1; b1 = b2; b2 = tb_; }
    }
#undef DIFF_VFR
#undef DIFF_KFR
#undef DIFF_QKH
#undef DIFF_STAGE
#undef DIFF_GLDS
    lrow += __shfl_xor(lrow, 32);
    const float rl = 1.f / lrow;
    LAS float* X = (LAS float*)L;
    if (st == 1) {
#pragma unroll
        for (int cb = 0; cb < 4; ++cb)
#pragma unroll
            for (int r = 0; r < 16; ++r) X[(wq * 64 + cb * 16 + r) * 64 + lane] = o[cb][r] * rl;
    }
    __syncthreads();
    if (st == 0) {
        float ss = 0.f;
#pragma unroll
        for (int cb = 0; cb < 4; ++cb)
#pragma unroll
            for (int r = 0; r < 16; ++r) { const float d = o[cb][r] * rl - lam * X[(wq * 64 + cb * 16 + r) * 64 + lane]; o[cb][r] = d; ss += d * d; }
        ss += __shfl_xor(ss, 32);
        const float rstd = (1.f - lam_init) / sqrtf(ss * (1.f / 128.f) + RMS_EPS);
        bf16_t* orow = F_O + (size_t)(b * SEQ + qpos) * DM + 512 + h * 128;
#pragma unroll
        for (int cb = 0; cb < 4; ++cb)
#pragma unroll
            for (int r4 = 0; r4 < 4; ++r4) { const int c0 = 32 * cb + 8 * r4 + 4 * hi;
                const f32x4 gg = *(const f32x4*)(F_g_sub + c0);
                u32x2 w; w.x = pk2(o[cb][4 * r4] * rstd * gg[0], o[cb][4 * r4 + 1] * rstd * gg[1]); w.y = pk2(o[cb][4 * r4 + 2] * rstd * gg[2], o[cb][4 * r4 + 3] * rstd * gg[3]);
                *(u32x2*)(orow + c0) = w; }
    }
    __syncthreads();
}
__device__ __forceinline__ int wq_next(Frame& F, int qid) {
    LAS int* slot = (LAS int*)(F.lds + MISC_OFF + 96);
    __syncthreads();
    if (F.tid == 0) *slot = (int)__hip_atomic_fetch_add(F.ctl + CW_WQ + 64 * qid, 1u, __ATOMIC_RELAXED, __HIP_MEMORY_SCOPE_AGENT);
    __syncthreads();
    return *slot;
}
__device__ __forceinline__ void diff_phase(Frame& F) {
    if (F.G != 256) return;
    const float lam_init = 0.8f - 0.6f * 1.0f;
    float a = F_lq1[F.lane] * F_lk1[F.lane], c = F_lq2[F.lane] * F_lk2[F.lane];
    a = wave_sum(a); c = wave_sum(c);
    const float lam = __expf(a) - __expf(c) + lam_init;
    const int b = F.vcu >> 5;
    LAS int* cost = (LAS int*)(F.lds + 147456);
    LAS int* order = cost + 256;
    __syncthreads();
    if (F.tid < 256) { const int h = F.tid >> 6, qb = F.tid & 63; cost[F.tid] = (2 * qb + 2 - diff_tstart(h, qb)) + 4; }
    __syncthreads();
    if (F.tid < 256) { const int cm = cost[F.tid]; int rank = 0;
        for (int j = 0; j < 256; ++j) { const int cj = cost[j]; rank += (cj > cm || (cj == cm && j < F.tid)) ? 1 : 0; }
        order[rank] = F.tid; }
    __syncthreads();
#pragma unroll 1
    for (;;) { const int u = wq_next(F, 2 * b); if (u >= 256) break;
        const int id = order[u];
        diff_unit(F, b, id >> 6, id & 63, lam, lam_init); }
}

constexpr int DSA_NBIN = 1024;
constexpr int DSA_POOLCAP = 16384;
constexpr int DSA_SEL_OFF = 131072, DSA_SM_OFF = 147456, DSA_GI_OFF = 65536;
constexpr float DSA_SCALE2 = 0.125f * LOG2E;

__device__ __forceinline__ unsigned off_c(unsigned row, unsigned ch) { return 256u * row + 16u * (ch ^ (((row & 7u) << 1) | ((row >> 2) & 1u))); }
__device__ __forceinline__ unsigned f32_sortable(float f) { const unsigned u = __builtin_bit_cast(unsigned, f); return u ^ ((u >> 31) ? 0xffffffffu : 0x80000000u); }

__device__ __forceinline__ float relu_raw(float v) { int i = __builtin_bit_cast(int, v); i = i > 0 ? i : 0; return __builtin_bit_cast(float, i); }
typedef short s16x2_t __attribute__((ext_vector_type(2)));
template <int PASS>
__device__ __forceinline__ void dsa_pass(Frame& F, int b, int q0, const bf16x8 (&qf)[4][2], const float (&w)[4], int lane, int grp) {
    const int r32 = lane & 31, hi = lane >> 5;
    LAS unsigned* hist = (LAS unsigned*)F.lds;
    LAS unsigned long long* pool = (LAS unsigned long long*)F.lds;
    LAS unsigned short* sel = (LAS unsigned short*)(F.lds + DSA_SEL_OFF);
    LAS int* sm = (LAS int*)(F.lds + DSA_SM_OFF);
    const int qpos = q0 + r32;
    const int nkb = (q0 >> 5) + 1;
    int tb = 0, po = 0;
    if (PASS == 2) { tb = (sm[200 + r32] == grp) ? sm[r32] : 0x7fffffff; po = sm[96 + r32]; }
    LAS unsigned* hq = hist + r32 * DSA_NBIN;
    const bf16_t* kbase = F_IK + ((size_t)(b * SEQ + r32) * 32 + hi * 8);
    bf16x8 n0 = {0, 0, 0, 0, 0, 0, 0, 0}, n1 = n0;
    if (F.wave < nkb) { const bf16_t* kp = kbase + (size_t)F.wave * 1024; n0 = *(const bf16x8*)kp; n1 = *(const bf16x8*)(kp + 16); }
#pragma unroll 1
    for (int kb = F.wave; kb < nkb; kb += NWAVES) {
        const bf16x8 a0 = n0, a1 = n1;
        if (kb + NWAVES < nkb) { const bf16_t* kp = kbase + (size_t)(kb + NWAVES) * 1024; n0 = *(const bf16x8*)kp; n1 = *(const bf16x8*)(kp + 16); }
        f32x16 sc;
#pragma unroll
        for (int r = 0; r < 16; ++r) sc[r] = 0.f;
#pragma unroll
        for (int h = 0; h < 4; ++h) {
            f32x16 acc;
#pragma unroll
            for (int r = 0; r < 16; ++r) acc[r] = 0.f;
            acc = MFMA32(a0, qf[h][0], acc); acc = MFMA32(a1, qf[h][1], acc);
#pragma unroll
            for (int r = 0; r < 16; ++r) sc[r] = fmaf(relu_raw(acc[r]), w[h], sc[r]);
            if (h == 1) __builtin_amdgcn_sched_barrier(0);
        }
        const bool diag = (kb == nkb - 1);
        const int lim = diag ? qpos - 32 * kb : 64;
        int bin[16];
#pragma unroll
        for (int r = 0; r < 16; r += 2) { const int pk = __builtin_bit_cast(int, __builtin_amdgcn_cvt_pknorm_i16(sc[r], sc[r + 1])); bin[r] = (((int)((unsigned)pk << 16)) >> 22) + 512; bin[r + 1] = (pk >> 22) + 512; }
        if (PASS == 1) {
            if (!diag) {
#pragma unroll
                for (int r = 0; r < 16; ++r) (void)__hip_atomic_fetch_add(hq + bin[r], 1u, __ATOMIC_RELAXED, __HIP_MEMORY_SCOPE_WORKGROUP);
            } else {
#pragma unroll
                for (int r = 0; r < 16; ++r) (void)__hip_atomic_fetch_add(hq + bin[r], (crow(r, hi) <= lim) ? 1u : 0u, __ATOMIC_RELAXED, __HIP_MEMORY_SCOPE_WORKGROUP);
            }
        } else {
            unsigned abm = 0u, eqm = 0u;
#pragma unroll
            for (int r = 0; r < 16; ++r) { const bool ok = crow(r, hi) <= lim; abm |= (ok && bin[r] > tb) ? (1u << r) : 0u; eqm |= (ok && bin[r] == tb) ? (1u << r) : 0u; }
            const unsigned basew = __hip_atomic_fetch_add((LAS unsigned*)(sm + 128) + r32, (unsigned)__builtin_popcount(abm) | ((unsigned)__builtin_popcount(eqm) << 16), __ATOMIC_RELAXED, __HIP_MEMORY_SCOPE_WORKGROUP);
            int sa = r32 * 256 + (int)(basew & 0xffffu), sc2 = po + (int)(basew >> 16);
            const int kb0 = 32 * kb + 4 * hi;
            while (abm) { const int r = __builtin_ctz(abm); abm &= abm - 1u; sel[sa] = (unsigned short)(kb0 + (r & 3) + 8 * (r >> 2)); ++sa; }
            while (eqm) { const int r = __builtin_ctz(eqm); eqm &= eqm - 1u;
                float v = sc[0];
#pragma unroll
                for (int j = 1; j < 16; ++j) v = (r == j) ? sc[j] : v;
                if (sc2 < DSA_POOLCAP) pool[sc2] = ((unsigned long long)f32_sortable(v + 0.f) << 16) | (unsigned long long)(0xffffu - (unsigned)(kb0 + (r & 3) + 8 * (r >> 2))); ++sc2; }
        }
    }
}

template <int NR>
__device__ __forceinline__ void dsa_resolve(const LAS unsigned long long* pq, int c, int r, LAS unsigned short* selq, int lane) {
    unsigned long long kk[NR];
#pragma unroll
    for (int i = 0; i < NR; ++i) { const int idx = 64 * i + lane; const bool in = idx < c; kk[i] = in ? pq[in ? idx : 0] : 0ull; }
    unsigned long long P = 0ull;
    if (c > r) {
        constexpr unsigned long long ZMIN = 0x80000000ull << 16, ZMAX = ZMIN | 0xffffull;
        int ngt = 0, nge = 0;
#pragma unroll
        for (int i = 0; i < NR; ++i) { ngt += __builtin_popcountll(__ballot(kk[i] > ZMAX)); nge += __builtin_popcountll(__ballot(kk[i] >= ZMIN)); }
        int bit = 47;
        if (ngt < r && r <= nge) { P = ZMIN | 0xe000ull; bit = 12; }
#pragma unroll 1
        for (; bit >= 0; --bit) {
            const unsigned long long trial = P | (1ull << bit);
            int cnt = 0;
#pragma unroll
            for (int i = 0; i < NR; ++i) cnt += __builtin_popcountll(__ballot(kk[i] >= trial));
            if (cnt >= r) { P = trial; if (cnt == r) break; }
        }
    }
    int outp = 0;
#pragma unroll
    for (int i = 0; i < NR; ++i) { const bool take = (64 * i + lane < c) && kk[i] >= P; const unsigned long long bal = __ballot(take);
        const int pos = outp + __builtin_popcountll(bal & ((1ull << lane) - 1ull));
        if (take && pos < r) selq[pos] = (unsigned short)(0xffffu - (unsigned)(kk[i] & 0xffffull));
        outp += __builtin_popcountll(bal); }
}

__device__ __forceinline__ void dsa_topk(Frame& F, int b, int qt) {
    int lane = F.lane; asm volatile("" : "+v"(lane));
    const int r32 = lane & 31, hi = lane >> 5, wave = F.wave;
    const int q0 = qt * 32;
    LAS unsigned* hist = (LAS unsigned*)F.lds;
    LAS unsigned long long* pool = (LAS unsigned long long*)F.lds;
    LAS unsigned short* sel = (LAS unsigned short*)(F.lds + DSA_SEL_OFF);
    LAS int* sm = (LAS int*)(F.lds + DSA_SM_OFF);
    if (q0 + 32 <= 256) {
        for (int i = F.tid; i < 32 * 256; i += NTHREADS) { const int q = i >> 8, j = i & 255; sel[i] = (j <= q0 + q) ? (unsigned short)j : (unsigned short)0xffffu; }
        __syncthreads();
        return;
    }

    bf16x8 qf[4][2]; float w[4];
    { const bf16_t* qp = F_IQ + ((size_t)(b * SEQ + q0 + r32) * 128 + hi * 8);
#pragma unroll
      for (int h = 0; h < 4; ++h) { qf[h][0] = *(const bf16x8*)(qp + h * 32); qf[h][1] = *(const bf16x8*)(qp + h * 32 + 16);
      }
      const f32x4 wv = *(const f32x4*)(F_IW + (size_t)(b * SEQ + q0 + r32) * 4);
      const float wm = fmaxf(fmaxf(fabsf(wv[0]), fabsf(wv[1])), fmaxf(fabsf(wv[2]), fabsf(wv[3]))); int ex = 0; (void)frexpf(wm, &ex);
      const float wsc = (wm > 0.f) ? ldexpf(1.f, -ex - 6) : 1.f;
      w[0] = wv[0] * wsc; w[1] = wv[1] * wsc; w[2] = wv[2] * wsc; w[3] = wv[3] * wsc; }
    for (int i = F.tid; i < 32 * DSA_NBIN / 4; i += NTHREADS) ((LAS u32x4*)hist)[i] = (u32x4){0u, 0u, 0u, 0u};
    for (int i = F.tid; i < 32 * 256 / 8; i += NTHREADS) ((LAS u32x4*)sel)[i] = (u32x4){0xffffffffu, 0xffffffffu, 0xffffffffu, 0xffffffffu};
    if (F.tid < 65) sm[128 + F.tid] = 0;
    __syncthreads();


    dsa_pass<1>(F, b, q0, qf, w, lane, 0);
    __syncthreads();


#pragma unroll 1
    for (int qi = 0; qi < 4; ++qi) {
        const int q = 4 * wave + qi;
        unsigned hv[16];
#pragma unroll
        for (int j4 = 0; j4 < 4; ++j4) { const u32x4 v = *(const LAS u32x4*)(hist + q * DSA_NBIN + 16 * lane + 4 * j4); hv[4 * j4] = v.x; hv[4 * j4 + 1] = v.y; hv[4 * j4 + 2] = v.z; hv[4 * j4 + 3] = v.w; }
        unsigned lsum = 0;
#pragma unroll
        for (int j = 0; j < 16; ++j) lsum += hv[j];
        unsigned incl = lsum;
#pragma unroll
        for (int o = 1; o < 64; o <<= 1) { const unsigned v = __shfl_down(incl, o); incl += (lane + o < 64) ? v : 0u; }
        const unsigned excl = incl - lsum;
        if (excl < 256u && incl >= 256u) {
            unsigned run = excl; int tbin = 0; unsigned nab = 0, cc = 0; bool found = false;
#pragma unroll
            for (int j = 15; j >= 0; --j) { if (!found) { if (run + hv[j] >= 256u) { found = true; tbin = 16 * lane + j; nab = run; cc = hv[j]; } else run += hv[j]; } }
            sm[q] = tbin; sm[32 + q] = (int)nab; sm[64 + q] = (int)cc;
        }
    }
    __syncthreads();
    if (F.tid == 0) {
        int off = 0, g = 0;
        for (int q = 0; q < 32; ++q) { const int c = sm[64 + q]; if (off + c > DSA_POOLCAP) { ++g; off = 0; } sm[96 + q] = off; sm[200 + q] = g; off += c; }
        sm[232] = g + 1;
    }
    __syncthreads();
    const int ngrp = __builtin_amdgcn_readfirstlane(sm[232]);

#pragma unroll 1
    for (int grp = 0; grp < ngrp; ++grp) {
    dsa_pass<2>(F, b, q0, qf, w, lane, grp);
    __syncthreads();

#pragma unroll 1
    for (int qi = 0; qi < 4; ++qi) {
        const int q = 4 * wave + qi;
        if (__builtin_amdgcn_readfirstlane(sm[200 + q]) != grp) continue;
        const int base = __builtin_amdgcn_readfirstlane(sm[96 + q]); int c = __builtin_amdgcn_readfirstlane(sm[64 + q]);
        const int nab = __builtin_amdgcn_readfirstlane(sm[32 + q]); const int r = 256 - nab;
        if (base + c > DSA_POOLCAP) c = (DSA_POOLCAP - base) > 0 ? (DSA_POOLCAP - base) : 0;
        LAS unsigned short* selq = sel + q * 256 + nab;
        const LAS unsigned long long* pq = pool + base;
        if (c <= 64) dsa_resolve<1>(pq, c, r, selq, lane);
        else if (c <= 128) dsa_resolve<2>(pq, c, r, selq, lane);
        else if (c <= 256) dsa_resolve<4>(pq, c, r, selq, lane);
        else if (c <= 512) dsa_resolve<8>(pq, c, r, selq, lane);
        else if (c <= 1024) dsa_resolve<16>(pq, c, r, selq, lane);
        else {
#define DSA_COUNT_GE(out_, thr_) do { int cnt_ = 0; _Pragma("unroll 4") for (int i0 = 0; i0 < c; i0 += 64) { const int i = i0 + lane; const unsigned long long v_ = pq[i < c ? i : 0]; cnt_ += __builtin_popcountll(__ballot((i < c) && v_ >= (thr_))); } out_ = cnt_; } while (0)
            constexpr unsigned long long ZMIN = 0x80000000ull << 16, ZMAX = ZMIN | 0xffffull;
            unsigned long long P = 0ull;
            if (c > r) {
                int ngt, nge; DSA_COUNT_GE(ngt, ZMAX + 1ull); DSA_COUNT_GE(nge, ZMIN);
                int bit = 47;
                if (ngt < r && r <= nge) { P = ZMIN | 0xe000ull; bit = 12; }
#pragma unroll 1
                for (; bit >= 0; --bit) {
                    const unsigned long long trial = P | (1ull << bit);
                    int cnt; DSA_COUNT_GE(cnt, trial);
                    if (cnt >= r) { P = trial; if (cnt == r) break; }
                }
            }
#undef DSA_COUNT_GE
            int outp = 0;
#pragma unroll 2
            for (int i0 = 0; i0 < c; i0 += 64) { const int i = i0 + lane; const unsigned long long v = pq[i < c ? i : 0]; const bool take = (i < c) && v >= P;
                const unsigned long long bal = __ballot(take); const int pos = outp + __builtin_popcountll(bal & ((1ull << lane) - 1ull));
                if (take && pos < r) selq[pos] = (unsigned short)(0xffffu - (unsigned)(v & 0xffffull));
                outp += __builtin_popcountll(bal); }
        }
    }
    __syncthreads();
    }

}

__device__ __forceinline__ void dsa_chunk(const bf16x8 (&af)[2][4], const bf16x8 (&bq)[4], f32x4 (&o)[8], float& lrow, LAS unsigned char* GI, LAS unsigned short* sel,
                                          int q, int qpos, int ch, int g, float slope2, float cq, unsigned wrA0, unsigned trA0) {
    asm volatile("" : "+v"(wrA0), "+v"(trA0));
    unsigned short kk[2][4];
#pragma unroll
    for (int rb = 0; rb < 2; ++rb) { const u32x2 v = *(const LAS u32x2*)(sel + q * 256 + 32 * ch + 16 * rb + 4 * g); kk[rb][0] = (unsigned short)(v.x & 0xffffu); kk[rb][1] = (unsigned short)(v.x >> 16); kk[rb][2] = (unsigned short)(v.y & 0xffffu); kk[rb][3] = (unsigned short)(v.y >> 16); }
#pragma unroll
    for (int rb = 0; rb < 2; ++rb)
#pragma unroll
        for (int s = 0; s < 4; ++s) *(LAS bf16x8*)(GI + (wrA0 ^ (unsigned)(s << 6)) + 4096 * rb) = af[rb][s];
    f32x4 sacc[2];
#pragma unroll
    for (int rb = 0; rb < 2; ++rb) { sacc[rb] = (f32x4){0.f, 0.f, 0.f, 0.f};
#pragma unroll
        for (int s = 0; s < 4; ++s) sacc[rb] = MFMA16(af[rb][s], bq[s], sacc[rb]); }
    float ps = 0.f; float pv[8];
#pragma unroll
    for (int rb = 0; rb < 2; ++rb)
#pragma unroll
        for (int i = 0; i < 4; ++i) { const unsigned key = kk[rb][i]; const bool ok = (key != 0xffffu) && ((int)key <= qpos);
            const float v = fmaf(sacc[rb][i], DSA_SCALE2, fmaf(-slope2, (float)(qpos - (int)key), cq));
            const float e = ok ? __builtin_amdgcn_exp2f(v) : 0.f; pv[4 * rb + i] = e; ps += e; }
    lrow += ps;
    u32x4 pw; pw.x = pk2(pv[0], pv[1]); pw.y = pk2(pv[2], pv[3]); pw.z = pk2(pv[4], pv[5]); pw.w = pk2(pv[6], pv[7]);
    const bf16x8 bp = __builtin_bit_cast(bf16x8, pw);
#pragma unroll
    for (int c4 = 0; c4 < 2; ++c4) {
        bf16x8 vf[4];
#pragma unroll
        for (int i = 0; i < 4; ++i) { const unsigned ta = trA0 ^ (unsigned)((4 * c4 + i) << 5);
            const s16x4 v0 = tr_read((const LAS char*)(GI + ta)); const s16x4 v1 = tr_read((const LAS char*)(GI + ta + 4096)); vf[i] = cat8(v0, v1); }
        __builtin_amdgcn_sched_barrier(0);
#pragma unroll
        for (int i = 0; i < 4; ++i) o[4 * c4 + i] = MFMA16(vf[i], bp, o[4 * c4 + i]);
        __builtin_amdgcn_sched_barrier(0);
    }
}

__device__ __forceinline__ void dsa_attend(Frame& F, int b, int qt, float kvmax) {
    int lane = F.lane; asm volatile("" : "+v"(lane));
    const int r32 = lane & 31, hi = lane >> 5, wave = F.wave;
    const int q0 = qt * 32; const size_t t0 = (size_t)b * SEQ + q0;
    LAS unsigned char* QA = F.lds;
    LAS unsigned char* GI = F.lds + DSA_GI_OFF + wave * 8192;
    LAS unsigned short* sel = (LAS unsigned short*)(F.lds + DSA_SEL_OFF);

    LAS float* QN2 = (LAS float*)(F.lds + DSA_SM_OFF + 1024);
    { const int h = wave; float qs = 0.f;
      bf16x8 bq[4];
      { const bf16_t* qp = F_DQ + ((t0 + r32) * 512 + h * 64 + hi * 8);
#pragma unroll
        for (int s = 0; s < 4; ++s) bq[s] = *(const bf16x8*)(qp + 16 * s); }
      bf16x8 wf[4][4];
#pragma unroll
      for (int cb = 0; cb < 4; ++cb) { const bf16_t* wp = F_Wuk + ((size_t)(h * 128 + cb * 32 + r32) * 64 + hi * 8);
#pragma unroll
          for (int s = 0; s < 4; ++s) wf[cb][s] = *(const bf16x8*)(wp + 16 * s); }
      __builtin_amdgcn_sched_barrier(0);
#pragma unroll
      for (int cb = 0; cb < 4; ++cb) {
          f32x16 acc;
#pragma unroll
          for (int r = 0; r < 16; ++r) acc[r] = 0.f;
#pragma unroll
          for (int s = 0; s < 4; ++s) acc = MFMA32(wf[cb][s], bq[s], acc);
#pragma unroll
          for (int r4 = 0; r4 < 4; ++r4) { u32x2 wv; wv.x = pk2(acc[4 * r4], acc[4 * r4 + 1]); wv.y = pk2(acc[4 * r4 + 2], acc[4 * r4 + 3]);
              qs += bflo(wv.x) * bflo(wv.x) + bfhi(wv.x) * bfhi(wv.x) + bflo(wv.y) * bflo(wv.y) + bfhi(wv.y) * bfhi(wv.y);
              *(LAS u32x2*)(QA + ((r32 * 8 + h) * 128 + 32 * cb + 8 * r4 + 4 * hi) * 2) = wv; }
      }
      qs += __shfl_xor(qs, 32);
      if (hi == 0) QN2[r32 * 8 + h] = qs; }
    __syncthreads();

    const int n = lane & 15, g = lane >> 4;
    const float slope2 = exp2f(-(float)((n & 7) + 1)) * LOG2E;
    const int qq = n >> 2, pp = n & 3;
    const unsigned wrA0 = off_c(n, g), trA0 = off_c(4u * g + qq, (unsigned)(pp >> 1)) + 8u * (pp & 1);
    const bf16_t* ckvb = F_CKV + (size_t)b * SEQ * 128 + 8 * g;
#define DSA_GATHER(dst, q_, ch_) do { _Pragma("unroll") for (int rb = 0; rb < 2; ++rb) { unsigned key = sel[(q_) * 256 + 32 * (ch_) + 16 * rb + n]; key = key == 0xffffu ? 0u : key; \
        const bf16_t* kp = ckvb + (size_t)key * 128; _Pragma("unroll") for (int s = 0; s < 4; ++s) dst[rb][s] = *(const bf16x8*)(kp + 32 * s); } } while (0)
    bf16x8 afA[2][4], afB[2][4];
    DSA_GATHER(afA, 4 * wave, 0);
#pragma unroll 1
    for (int qi = 0; qi < 4; ++qi) {
        const int q = 4 * wave + qi; const int qpos = q0 + q;
        bf16x8 bq[4];
#pragma unroll
        for (int s = 0; s < 4; ++s) { bf16x8 v = *(const LAS bf16x8*)(QA + ((q * 8 + (n & 7)) * 128 + 32 * s + 8 * g) * 2); if (n >= 8) v = (bf16x8){0, 0, 0, 0, 0, 0, 0, 0}; bq[s] = v; }
        float lrow = 0.f;
        f32x4 o[8];
#pragma unroll
        for (int cb = 0; cb < 8; ++cb) o[cb] = (f32x4){0.f, 0.f, 0.f, 0.f};
        float cq;
        { const u32x2 kv4 = *(const LAS u32x2*)(sel + q * 256 + 4 * lane); int km = -1;
          { const int k0 = (int)(kv4.x & 0xffffu), k1 = (int)(kv4.x >> 16), k2 = (int)(kv4.y & 0xffffu), k3 = (int)(kv4.y >> 16);
            km = (k0 != 0xffff && k0 > km) ? k0 : km; km = (k1 != 0xffff && k1 > km) ? k1 : km; km = (k2 != 0xffff && k2 > km) ? k2 : km; km = (k3 != 0xffff && k3 > km) ? k3 : km; }
#pragma unroll
          for (int o_ = 1; o_ < 64; o_ <<= 1) { const int t = __shfl_xor(km, o_); km = t > km ? t : km; }
          const float bound = sqrtf(QN2[q * 8 + (n & 7)]) * kvmax * DSA_SCALE2;
          cq = slope2 * (float)(qpos - km) - bound; }
#pragma unroll 1
        for (int ch2 = 0; ch2 < 4; ++ch2) {
            DSA_GATHER(afB, q, 2 * ch2 + 1);
            dsa_chunk(afA, bq, o, lrow, GI, sel, q, qpos, 2 * ch2, g, slope2, cq, wrA0, trA0);
            if (ch2 < 3) DSA_GATHER(afA, q, 2 * ch2 + 2); else if (qi < 3) DSA_GATHER(afA, q + 1, 0);
            dsa_chunk(afB, bq, o, lrow, GI, sel, q, qpos, 2 * ch2 + 1, g, slope2, cq, wrA0, trA0);
        }
        lrow += __shfl_xor(lrow, 16); lrow += __shfl_xor(lrow, 32);
        const float rl = 1.f / lrow;
        if (n < 8) {
#pragma unroll
            for (int cb = 0; cb < 8; ++cb) { u32x2 wv; wv.x = pk2(o[cb][0] * rl, o[cb][1] * rl); wv.y = pk2(o[cb][2] * rl, o[cb][3] * rl);
                *(LAS u32x2*)(QA + ((q * 8 + n) * 128 + 16 * cb + 4 * g) * 2) = wv; }
        }
    }
#undef DSA_GATHER
    __syncthreads();

    { const int h = wave;
      bf16x8 bo[8];
#pragma unroll
      for (int s = 0; s < 8; ++s) bo[s] = *(const LAS bf16x8*)(QA + ((r32 * 8 + h) * 128 + 16 * s + 8 * hi) * 2);
      bf16x8 wo[2][8];
#pragma unroll
      for (int db = 0; db < 2; ++db) { const bf16_t* wp = F_WuvT + ((size_t)(h * 64 + db * 32 + r32) * 128 + hi * 8);
#pragma unroll
          for (int s = 0; s < 8; ++s) wo[db][s] = *(const bf16x8*)(wp + 16 * s); }
      __builtin_amdgcn_sched_barrier(0);
#pragma unroll
      for (int db = 0; db < 2; ++db) {
          f32x16 acc;
#pragma unroll
          for (int r = 0; r < 16; ++r) acc[r] = 0.f;
#pragma unroll
          for (int s = 0; s < 8; ++s) acc = MFMA32(wo[db][s], bo[s], acc);
          bf16_t* op = F_O + (t0 + r32) * DM + h * 64 + 32 * db + 4 * hi;
#pragma unroll
          for (int r4 = 0; r4 < 4; ++r4) { u32x2 wv; wv.x = pk2(acc[4 * r4], acc[4 * r4 + 1]); wv.y = pk2(acc[4 * r4 + 2], acc[4 * r4 + 3]);
              *(u32x2*)(op + 8 * r4) = wv; }
      } }
    __syncthreads();

}
__device__ __forceinline__ void dsa_unit(Frame& F, int b, int qt, float kvmax) {
    dsa_topk(F, b, qt);
    dsa_attend(F, b, qt, kvmax);
}
__device__ __forceinline__ void dsa_phase(Frame& F) {
    if (F.G != 256) return;
    const int b = F.vcu >> 5;
    float gm = fmaxf(fabsf(F_g_kv[F.lane]), fabsf(F_g_kv[F.lane + 64]));
#pragma unroll
    for (int o = 1; o < 64; o <<= 1) gm = fmaxf(gm, __shfl_xor(gm, o));
    const float kvmax = 11.313708499f * gm * 1.01f;
#pragma unroll 1
    for (;;) { const int u = wq_next(F, 2 * b + 1); if (u >= 256) break; dsa_unit(F, b, 255 - u, kvmax); }
}

constexpr int N_PHASES = 12;
__global__ void __launch_bounds__(NTHREADS, 2) fwd_kernel(Args args) {
    extern __shared__ __attribute__((aligned(16))) unsigned char lds[];
    Frame F;
    F.lds = (LAS unsigned char*)lds;
    F.MISC = (volatile LAS unsigned*)(F.lds + MISC_OFF);
    F.tid = threadIdx.x; F.lane = F.tid & 63; F.wave = __builtin_amdgcn_readfirstlane(F.tid >> 6);
    F.G = gridDim.x; { const int bx = blockIdx.x; F.vcu = (F.G % 8 == 0) ? (bx % 8) * (F.G / 8) + bx / 8 : bx; }
    F.a = &args; F.ws = args.ws; F.ctl = (unsigned*)(args.ws + WS_CTL);
    for (int u = F.tid; u < (LDS_BYTES - MISC_OFF) / 4; u += NTHREADS) ((LAS unsigned*)(F.lds + MISC_OFF))[u] = 0u;
    __syncthreads();
    XcdBarrier bar; bar.bar = (unsigned*)(F.ctl + CW_BAR); bar.x = 0; bar.st = nullptr;
    if (!MK_SPLIT) bar = xcd_barrier_post((unsigned*)(F.ctl + CW_BAR), F.MISC + 8);
    const int lo = args.ph_lo, hi = args.ph_hi;
#define IN(k) (lo <= (k) && (k) < hi)
#define RUN(k, ...) do { if (IN(k)) { __VA_ARGS__; } } while (0)
#define SEAM(k) do { if (IN(k) && (IN((k) + 1) || ((k) == 7 && IN(9)))) xcd_barrier(bar); } while (0)


    RUN(0, p0_mod(F); __syncthreads(); p0_weights(F));
    SEAM(0);
    RUN(1, modnorm_rows(F, F_x, F_g_attn, 0, 1024, F_XN));
    SEAM(1);
    RUN(2, pg8::StaticOrder S; S.init(NT, NPROJ, DM, F.G, (int)blockIdx.x); EpiProj E{F_DQ, F_FQ, F_FK, F_FV, F_DLAT, F_IQ, F_IK, F_IW}; pg8::gemm_phase<EpiProj, pg8::StaticOrder, true>(F.lds, F_XN, F_Win, DM, S, E));
    SEAM(2);
    RUN(3, ckv_rows(F); knorm_rows(F));
    SEAM(3);
    RUN(4, diff_phase(F); dsa_phase(F));
    SEAM(4);
    RUN(5, pg8::StaticOrder S; S.init(NT, DM, DM, F.G, (int)blockIdx.x); EpiX1 E{F_x, F_mod, F_out}; pg8::gemm_phase<EpiX1, pg8::StaticOrder, true>(F.lds, F_O, F_Wout, DM, S, E));
    SEAM(5);
    RUN(6, modnorm_rows(F, F_out, F_g_moe, 3072, 4096, F_XN));
    SEAM(6);
    RUN(7, pg8::StaticOrder S; S.init(NT, 256, DM, F.G, (int)blockIdx.x); EpiLogits E{F_LOG, F_b_router, F_b_group}; pg8::gemm_phase<EpiLogits, pg8::StaticOrder, false>(F.lds, F_XN, F_Wrt, DM, S, E);
        VM_WAIT(); __syncthreads(); { pg8::Unit u; for (int i = 0; S.next(i, u); ++i) route_panel(F, u.pm); });
    SEAM(7);
    RUN(9, const MoeTab tab = moe_tables(F); MoeOrder<2, true> S{tab, F.G, (int)blockIdx.x, DM, F_TOK}; EpiUp E{F_HS}; pg8::gemm_phase<EpiUp, MoeOrder<2, true>, true>(F.lds, F_XN, F_Wup, DM, S, E));
    SEAM(9);
    RUN(10, const MoeTab tab = moe_tables(F); MoeOrder<4, false> S{tab, F.G, (int)blockIdx.x, DEXP, F_TOK}; EpiDown E{F_YS, F_GL, tab.ecnt}; pg8::gemm_phase<EpiDown, MoeOrder<4, false>, true>(F.lds, F_HS, F_Wdn, DEXP, S, E));
    SEAM(10);
    RUN(11, const MoeTab tab = moe_tables(F); combine_rows(F, tab));
#undef IN
#undef SEAM
}

extern "C" void kernel_launch(void* const* d_in, const int* in_sizes, int n_in, void* d_out, int out_size, void* d_ws, size_t ws_size, hipStream_t stream) {
    static int grid = 0;
    if (grid == 0) {
        if (n_in != 24 || in_sizes[0] != NT * DM || out_size != NT * DM || ws_size < WS_END) { fprintf(stderr, "kernel_launch: unexpected problem (n_in %d, in0 %d, out %d, ws %zu)\n", n_in, n_in > 0 ? in_sizes[0] : -1, out_size, ws_size); grid = -1; return; }
        int dev = 0, cus = 0, per_cu = 0;
        if (hipGetDevice(&dev) != hipSuccess || hipDeviceGetAttribute(&cus, hipDeviceAttributeMultiprocessorCount, dev) != hipSuccess) { grid = -1; return; }
        if (hipFuncSetAttribute((const void*)fwd_kernel, hipFuncAttributeMaxDynamicSharedMemorySize, LDS_BYTES) != hipSuccess) { fprintf(stderr, "kernel_launch: hipFuncSetAttribute failed\n"); grid = -1; return; }
        if (hipOccupancyMaxActiveBlocksPerMultiprocessor(&per_cu, (const void*)fwd_kernel, NTHREADS, LDS_BYTES) != hipSuccess || per_cu < 1) { fprintf(stderr, "kernel_launch: occupancy query reports %d\n", per_cu); }
        (void)hipGetLastError();
        grid = cus;
    }
    if (grid < 0) return;
    if (hipMemsetAsync((char*)d_ws + WS_CTL, 0, CTL_ZERO_BYTES, stream) != hipSuccess) return;
    Args a{};
    for (int i = 0; i < 24; ++i) a.in[i] = (const float*)d_in[i];
    a.out = (float*)d_out; a.ws = (unsigned char*)d_ws;
#if MK_SPLIT
    for (int p = 0; p < N_PHASES; ++p) { a.ph_lo = p; a.ph_hi = p + 1; hipLaunchKernelGGL(fwd_kernel, dim3(grid), dim3(NTHREADS), LDS_BYTES, stream, a); }
#else
    a.ph_lo = 0; a.ph_hi = N_PHASES;
    hipLaunchKernelGGL(fwd_kernel, dim3(grid), dim3(NTHREADS), LDS_BYTES, stream, a);
#endif
}
```

```cpp
#include <hip/hip_runtime.h>
#include <cstdio>
#include <cstdint>

#define LAS __attribute__((address_space(3)))
#define GAS __attribute__((address_space(1)))
typedef unsigned short bf16_t;
typedef short bf16x8 __attribute__((ext_vector_type(8)));
typedef short s16x4 __attribute__((ext_vector_type(4)));
typedef float f32x2 __attribute__((ext_vector_type(2)));
typedef float f32x4 __attribute__((ext_vector_type(4)));
typedef float f32x16 __attribute__((ext_vector_type(16)));
typedef unsigned u32x2 __attribute__((ext_vector_type(2)));
typedef unsigned u32x4 __attribute__((ext_vector_type(4)));
typedef __bf16 bf16x2_t __attribute__((ext_vector_type(2)));

#ifndef MK_SPLIT
#define MK_SPLIT 0
#endif

constexpr int NB = 8, SEQ = 8192, NT = NB * SEQ, DM = 1024;
constexpr int NPROJ = 2560;
constexpr int NEXP = 32, DEXP = 256;
constexpr int PMAX = 2 * NT + NEXP * 256;
constexpr float LOG2E = 1.4426950408889634f;
constexpr float RMS_EPS = 1e-6f;
constexpr float DIFF_C2 = 0.125f * LOG2E;
constexpr float IW_SCALE = 0.5f * 0.17677669529663687f;
constexpr int NWAVES = 8, NTHREADS = 512;

constexpr size_t MiB = 1u << 20;
constexpr size_t WS_CTL = 0, CTL_ZERO_BYTES = 128 * 1024;
constexpr size_t WS_MOD = 1 * MiB;
constexpr size_t WS_KN2 = 1 * MiB + 512 * 1024;
constexpr size_t WS_WIN = 2 * MiB;
constexpr size_t WS_WOUT = 8 * MiB;
constexpr size_t WS_WRT = 10 * MiB;
constexpr size_t WS_WUK = 11 * MiB;
constexpr size_t WS_WUVT = 11 * MiB + 512 * 1024;
constexpr size_t WS_WUP = 12 * MiB;
constexpr size_t WS_WDN = 44 * MiB;
constexpr size_t WS_XN = 64 * MiB;
constexpr size_t WS_DQ = 192 * MiB, WS_FQ = 256 * MiB, WS_FK = 320 * MiB, WS_FV = 384 * MiB;
constexpr size_t WS_YS = 192 * MiB;
constexpr size_t WS_O = 464 * MiB;
constexpr size_t WS_DLAT = 592 * MiB;
constexpr size_t WS_CKV = 608 * MiB;
constexpr size_t WS_IQ = 624 * MiB;
constexpr size_t WS_IK = 640 * MiB;
constexpr size_t WS_IW = 644 * MiB;
constexpr size_t WS_LOG = 646 * MiB;
constexpr size_t WS_REID = 662 * MiB;
constexpr size_t WS_RSLOT = 663 * MiB;
constexpr size_t WS_TOK = 664 * MiB;
constexpr size_t WS_GL = 672 * MiB;
constexpr size_t WS_HS = 680 * MiB;
constexpr size_t WS_END = 752 * MiB;
static_assert(WS_YS + (size_t)PMAX * 2048 <= WS_O && WS_HS + (size_t)PMAX * 512 <= WS_END, "d_ws map");
constexpr int CW_BAR = 4096;
constexpr int CW_ECNT = 16384;
constexpr int CW_WQ = 20480;

constexpr int LDS_BYTES = 155648;
constexpr int MISC_OFF = LDS_BYTES - 512;

__device__ __forceinline__ unsigned f2bf(float f) { unsigned u = __builtin_bit_cast(unsigned, f); return (u + 0x7fffu + ((u >> 16) & 1u)) >> 16; }
__device__ __forceinline__ unsigned pk2(float lo, float hi) { f32x2 v = {lo, hi}; bf16x2_t b = __builtin_convertvector(v, bf16x2_t); return __builtin_bit_cast(unsigned, b); }
__device__ __forceinline__ float bf2f(unsigned short h) { return __builtin_bit_cast(float, (unsigned)h << 16); }
__device__ __forceinline__ float bflo(unsigned w) { return __builtin_bit_cast(float, w << 16); }
__device__ __forceinline__ float bfhi(unsigned w) { return __builtin_bit_cast(float, w & 0xffff0000u); }
__device__ __forceinline__ int crow(int r, int hi) { return (r & 3) + 8 * (r >> 2) + 4 * hi; }
__device__ __forceinline__ unsigned off_b(unsigned row, unsigned ch) { return 256u * row + 16u * (ch ^ (((row & 3u) << 2) | ((row >> 2) & 3u))); }
__device__ __forceinline__ float wave_sum(float v) {
#pragma unroll
    for (int o = 1; o < 64; o <<= 1) v += __shfl_xor(v, o);
    return v;
}
#define LDS_WAIT() asm volatile("s_waitcnt lgkmcnt(0)" ::: "memory")
#define VM_WAIT() asm volatile("s_waitcnt vmcnt(0)" ::: "memory")
#define MFMA32(a, b, c) __builtin_amdgcn_mfma_f32_32x32x16_bf16((a), (b), (c), 0, 0, 0)
#define MFMA16(a, b, c) __builtin_amdgcn_mfma_f32_16x16x32_bf16((a), (b), (c), 0, 0, 0)
__device__ __forceinline__ s16x4 tr_read(LAS const char* p) { return __builtin_bit_cast(s16x4, __builtin_amdgcn_ds_read_tr16_b64_v4i16((LAS s16x4*)p)); }
__device__ __forceinline__ bf16x8 cat8(s16x4 a, s16x4 b) { return (bf16x8){a[0], a[1], a[2], a[3], b[0], b[1], b[2], b[3]}; }

namespace pg8 {
constexpr int BM = 256, BK = 64, HALF = 128, HTB = HALF * BK * 2, STAGE_BYTES = 8 * HTB, NXCD = 8, WGM = 8;
__device__ __forceinline__ int lds_byte(int r, int c) { const int st = (r >> 4) * 2 + (c >> 5), rr = r & 15, cc = c & 31, ob = rr * 64 + cc * 2; return st * 1024 + (ob ^ (((ob >> 9) & 1) << 5)); }
__device__ __forceinline__ void stage_rc(int b, int& R, int& C) { const int st = b / 1024, sb = b % 1024, swz = sb ^ (((sb >> 9) & 1) << 5); R = (st >> 1) * 16 + swz / 64; C = (st & 1) * 32 + (swz % 64) / 2; }
__device__ __forceinline__ int perm32(int rho) { const int n = rho >> 4, i = rho & 15; return 8 * (i >> 2) + 4 * n + (i & 3); }

struct Unit { int pm, pn, a0, a1; };

struct StaticOrder {
    int nM, nN, nwg, G, c, K;
    __device__ void init(int M, int N, int K_, int G_, int c_) { nM = M / BM; nN = N / BM; nwg = nM * nN; G = G_; c = c_; K = K_; }
    __device__ bool next(int i, Unit& u) const {
        const long L = (long)i * G + c; if (L >= nwg) return false;
        int wgid = (int)L; { const int q = nwg / NXCD, r = nwg % NXCD, xcd = wgid % NXCD, off = wgid / NXCD; wgid = (xcd < r ? xcd * (q + 1) : r * (q + 1) + (xcd - r) * q) + off; }
        const int nig = WGM * nN, gid = wgid / nig, fm = gid * WGM, gsz = (nM - fm) < WGM ? (nM - fm) : WGM;
        u.pm = fm + ((wgid % nig) % gsz); u.pn = (wgid % nig) / gsz; u.a0 = 0; u.a1 = 0; return true;
    }
    __device__ __forceinline__ unsigned a_off(const Unit& u, int R) const { return (unsigned)(u.pm * BM + R) * (unsigned)(K * 2); }
};

template <class Epi, class Sched, bool ALIGN_EPI>
__device__ __forceinline__ void gemm_phase(LAS unsigned char* lds, const bf16_t* Ap, const bf16_t* Btp, const int K, const Sched& S, const Epi& E) {
    const int tid = threadIdx.x, wid = __builtin_amdgcn_readfirstlane(tid >> 6), lane = tid & 63, wr = wid >> 2, wc = wid & 3, fr = lane & 15, fq = lane >> 4;
    const int nt = K / BK;
    int RA[2], CA[2]; unsigned voffB[2];
#pragma unroll
    for (int i = 0; i < 2; ++i) { int R, C; stage_rc(tid * 16 + i * 8192, R, C); const int Rb = Epi::PERM ? ((R & ~31) + perm32(R & 31)) : R;
        RA[i] = R; CA[i] = C * 2; voffB[i] = (unsigned)(Rb * K + C) * 2u; }
    const size_t kstep = (size_t)(BK * 2);
    const size_t hstep = (size_t)HALF * K * 2;
    const size_t tstep = 2 * hstep;
    const unsigned ldsw = (unsigned)wid * 1024u;
    const int aoff = lds_byte(wr * 64 + fr, fq * 8), boff = lds_byte(wc * 32 + fr, fq * 8);
#define PG8_SA(b, h) (((b) * 2 + (h)) * HTB)
#define PG8_SB(b, h) ((4 + (b) * 2 + (h)) * HTB)
#define PG8_STAGE_B(bufoff, gbase) do { _Pragma("unroll") for (int _i = 0; _i < 2; ++_i) \
        __builtin_amdgcn_global_load_lds((const unsigned*)((const char*)(gbase) + voffB[_i]), (LAS unsigned*)(lds + (bufoff) + ldsw + _i * 8192), 16, 0, 0); } while (0)
#define PG8_STAGE_A(bufoff, offs, h, kb) do { _Pragma("unroll") for (int _i = 0; _i < 2; ++_i) \
        __builtin_amdgcn_global_load_lds((const unsigned*)((const char*)Ap + (size_t)(offs)[h][_i] + (size_t)(kb)), (LAS unsigned*)(lds + (bufoff) + ldsw + _i * 8192), 16, 0, 0); } while (0)
#define PG8_LDA(dst, b, h) do { _Pragma("unroll") for (int m = 0; m < 4; ++m) _Pragma("unroll") for (int k = 0; k < 2; ++k) dst[m][k] = *(const LAS bf16x8*)(lds + PG8_SA(b, h) + aoff + m * 2048 + k * 1024); } while (0)
#define PG8_LDB(dst, b, h) do { _Pragma("unroll") for (int n = 0; n < 2; ++n) _Pragma("unroll") for (int k = 0; k < 2; ++k) dst[n][k] = *(const LAS bf16x8*)(lds + PG8_SB(b, h) + boff + n * 2048 + k * 1024); } while (0)
#define PG8_MMA(ai, bj, At, Bt) do { __builtin_amdgcn_s_setprio(1); _Pragma("unroll") for (int m = 0; m < 4; ++m) _Pragma("unroll") for (int n = 0; n < 2; ++n) _Pragma("unroll") for (int k = 0; k < 2; ++k) \
        acc[ai][bj][m][n] = __builtin_amdgcn_mfma_f32_16x16x32_bf16(Bt[n][k], At[m][k], acc[ai][bj][m][n], 0, 0, 0); __builtin_amdgcn_s_setprio(0); } while (0)
#define PG8_WAIT_V(n) asm volatile("s_waitcnt vmcnt(" #n ")" ::: "memory")
#define PG8_WAIT_L(n) asm volatile("s_waitcnt lgkmcnt(" #n ")" ::: "memory")
#define PG8_BAR __builtin_amdgcn_s_barrier()
#define PG8_SCHED __builtin_amdgcn_sched_barrier(0)
#define PG8_OFFS(dst, u) do { _Pragma("unroll") for (int _h = 0; _h < 2; ++_h) _Pragma("unroll") for (int _i = 0; _i < 2; ++_i) dst[_h][_i] = S.a_off(u, _h * HALF + RA[_i]) + (unsigned)CA[_i]; } while (0)
    Unit cur, nxt; int ui = 0;
    if (!S.next(0, cur)) return;
    f32x4 acc[2][2][4][2];
#pragma unroll
    for (int a = 0; a < 2; ++a)
#pragma unroll
        for (int b = 0; b < 2; ++b)
#pragma unroll
            for (int m = 0; m < 4; ++m)
#pragma unroll
                for (int n = 0; n < 2; ++n) acc[a][b][m][n] = (f32x4){0.f, 0.f, 0.f, 0.f};
    bf16x8 At[4][2], B0[2][2], B1[2][2];
    unsigned offc[2][2], offn[2][2];
    PG8_OFFS(offc, cur);
    const char* cB = (const char*)Btp + (size_t)cur.pn * tstep;
    PG8_STAGE_B(PG8_SB(0, 0), cB); PG8_STAGE_B(PG8_SB(0, 1), cB + hstep); PG8_STAGE_A(PG8_SA(0, 0), offc, 0, 0); PG8_STAGE_A(PG8_SA(0, 1), offc, 1, 0);
    if (wr == 1) PG8_BAR;
    PG8_WAIT_V(2); PG8_BAR;
    PG8_STAGE_B(PG8_SB(1, 0), cB + kstep); PG8_STAGE_A(PG8_SA(1, 0), offc, 0, kstep); PG8_STAGE_B(PG8_SB(1, 1), cB + hstep + kstep);
    PG8_WAIT_V(6); PG8_BAR;
    for (;;) {
        const bool has_next = S.next(ui + 1, nxt);
        if (has_next) { PG8_OFFS(offn, nxt); }
        else {
#pragma unroll
            for (int _h = 0; _h < 2; ++_h)
#pragma unroll
                for (int _i = 0; _i < 2; ++_i) offn[_h][_i] = offc[_h][_i];
        }
        const char* nB = has_next ? (const char*)Btp + (size_t)nxt.pn * tstep : cB;
#pragma unroll 1
        for (int t = 0; t < nt; t += 2) {
            const bool last = (t == nt - 2);
            const size_t k1 = (size_t)(t + 1) * kstep;
            const size_t k2 = last ? 0 : (size_t)(t + 2) * kstep, k3 = k2 + kstep;
            unsigned o2[2][2];
#pragma unroll
            for (int _h = 0; _h < 2; ++_h)
#pragma unroll
                for (int _i = 0; _i < 2; ++_i) o2[_h][_i] = last ? offn[_h][_i] : offc[_h][_i];
            const char* b2 = last ? nB : cB + (size_t)(t + 2) * kstep; const char* b3 = b2 + kstep;
            PG8_LDB(B0, 0, 0); PG8_LDB(B1, 0, 1); PG8_SCHED; PG8_LDA(At, 0, 0); PG8_STAGE_A(PG8_SA(1, 1), offc, 1, k1);
            PG8_WAIT_V(8); PG8_WAIT_L(0); PG8_BAR; PG8_MMA(0, 0, At, B0); PG8_MMA(0, 1, At, B1); PG8_BAR; PG8_SCHED;
            PG8_LDA(At, 0, 1); PG8_STAGE_B(PG8_SB(0, 0), b2); PG8_STAGE_B(PG8_SB(0, 1), b2 + hstep); PG8_STAGE_A(PG8_SA(0, 0), o2, 0, k2);
            PG8_WAIT_V(8); PG8_WAIT_L(0); PG8_BAR; PG8_MMA(1, 0, At, B0); PG8_MMA(1, 1, At, B1); PG8_BAR; PG8_SCHED;
            PG8_LDB(B0, 1, 0); PG8_LDB(B1, 1, 1); PG8_SCHED; PG8_LDA(At, 1, 0); PG8_STAGE_A(PG8_SA(0, 1), o2, 1, k2);
            PG8_WAIT_V(8); PG8_WAIT_L(0); PG8_BAR; PG8_MMA(0, 0, At, B0); PG8_MMA(0, 1, At, B1); PG8_BAR; PG8_SCHED;
            PG8_LDA(At, 1, 1); PG8_STAGE_B(PG8_SB(1, 0), b3); PG8_STAGE_B(PG8_SB(1, 1), b3 + hstep); PG8_STAGE_A(PG8_SA(1, 0), o2, 0, k3);
            PG8_WAIT_V(8); PG8_WAIT_L(0); PG8_BAR; PG8_MMA(1, 0, At, B0); PG8_MMA(1, 1, At, B1); PG8_BAR; PG8_SCHED;
        }
        if constexpr (ALIGN_EPI) { if (wr == 0) PG8_BAR; }
        E(acc, cur, wr, wc, fr, fq);
        if (!has_next) break;
#pragma unroll
        for (int a = 0; a < 2; ++a)
#pragma unroll
            for (int b = 0; b < 2; ++b)
#pragma unroll
                for (int m = 0; m < 4; ++m)
#pragma unroll
                    for (int n = 0; n < 2; ++n) acc[a][b][m][n] = (f32x4){0.f, 0.f, 0.f, 0.f};
        cur = nxt; cB = nB; ++ui;
#pragma unroll
        for (int _h = 0; _h < 2; ++_h)
#pragma unroll
            for (int _i = 0; _i < 2; ++_i) offc[_h][_i] = offn[_h][_i];
        if constexpr (ALIGN_EPI) { if (wr == 1) PG8_BAR; }
    }
    PG8_WAIT_V(0);
    if constexpr (!ALIGN_EPI) { if (wr == 0) PG8_BAR; }
    PG8_BAR;
#undef PG8_SA
#undef PG8_SB
#undef PG8_STAGE_A
#undef PG8_STAGE_B
#undef PG8_LDA
#undef PG8_LDB
#undef PG8_MMA
#undef PG8_WAIT_V
#undef PG8_WAIT_L
#undef PG8_BAR
#undef PG8_SCHED
#undef PG8_OFFS
}
}

#define XB_TMO      128
#define XB_XCNT(j)  (256  + 64 * (j))
#define XB_XSUB(j)  (1280 + 64 * (j))
#define XB_XGEN(j)  (2304 + 64 * (j))
#define XB_TOP      3328
#define XB_TOPGEN   3392
#define XCD_BAR_WORDS 3456
#define XB_SPIN_CAP (1u << 18)
__device__ __forceinline__ unsigned xb_ld(unsigned* p)              { return __hip_atomic_load(p, __ATOMIC_RELAXED, __HIP_MEMORY_SCOPE_AGENT); }
__device__ __forceinline__ unsigned xb_add(unsigned* p, unsigned v) { return __hip_atomic_fetch_add(p, v, __ATOMIC_RELAXED, __HIP_MEMORY_SCOPE_AGENT); }
__device__ __forceinline__ unsigned xb_xcc_id() { return (unsigned)__builtin_amdgcn_s_getreg((3 << 11) | 20) & 0xFu; }
#define XB_SPIN(cond, bar) do { unsigned _sp = 0; while (cond) { __builtin_amdgcn_s_sleep(1); \
    if ((++_sp & 255u) == 0u) { if (xb_ld(&(bar)[XB_TMO])) break; if (_sp > XB_SPIN_CAP) { atomicAdd(&(bar)[XB_TMO], 1u); break; } } } } while (0)
struct XcdBarrier { unsigned* bar; unsigned x; volatile LAS unsigned* st; };
__device__ __forceinline__ XcdBarrier xcd_barrier_post(unsigned* bar, volatile LAS unsigned* st) {
    XcdBarrier b; b.bar = bar; b.x = xb_xcc_id(); b.st = st;
    if (threadIdx.x == 0) (void)xb_add(&bar[XB_XCNT(b.x)], 1u);
    return b;
}
__device__ __forceinline__ void xcd_barrier_complete(unsigned* bar, unsigned x, unsigned& nloc, unsigned& nx) {
    const unsigned G = gridDim.x * gridDim.y * gridDim.z;
    unsigned sum, cnt, mine, sp = 0u;
    for (;;) {
        sum = 0u; cnt = 0u; mine = 0u;
#pragma unroll
        for (unsigned j = 0; j < 16; ++j) { const unsigned c = xb_ld(&bar[XB_XCNT(j)]); sum += c; cnt += (c > 0u) ? 1u : 0u; mine = (j == x) ? c : mine; }
        if (sum == G) break;
        __builtin_amdgcn_s_sleep(1);
        if ((++sp & 255u) == 0u) { if (xb_ld(&bar[XB_TMO])) break; if (sp > XB_SPIN_CAP) { atomicAdd(&bar[XB_TMO], 1u); break; } }
    }
    nloc = mine > 0u ? mine : 1u; nx = cnt > 0u ? cnt : 1u;
}
__device__ __forceinline__ void xcd_barrier(const XcdBarrier& b) {
    asm volatile("s_waitcnt vmcnt(0)" ::: "memory");
    __syncthreads();
    if (threadIdx.x == 0) {
        unsigned* bar = b.bar;
        __builtin_amdgcn_s_waitcnt(0);
        unsigned nloc = b.st[0], nx = b.st[1];
        if (nloc == 0u) { xcd_barrier_complete(bar, b.x, nloc, nx); b.st[0] = nloc; b.st[1] = nx; }
        const unsigned old = xb_add(&bar[XB_XSUB(b.x)], 1u);
        const unsigned gen = old / nloc;
        if (old + 1u == (gen + 1u) * nloc) {
            __builtin_amdgcn_fence(__ATOMIC_RELEASE, "agent");
            asm volatile("s_waitcnt vmcnt(0)" ::: "memory");
            const unsigned og = xb_add(&bar[XB_TOP], 1u);
            const unsigned tg = og / nx;
            if (og + 1u == (tg + 1u) * nx) xb_add(&bar[XB_TOPGEN], 1u);
            else XB_SPIN(xb_ld(&bar[XB_TOPGEN]) == tg, bar);
            __builtin_amdgcn_fence(__ATOMIC_ACQUIRE, "agent");
            xb_add(&bar[XB_XGEN(b.x)], 1u);
            asm volatile("s_waitcnt vmcnt(0)" ::: "memory");
        } else {
            XB_SPIN(xb_ld(&bar[XB_XGEN(b.x)]) == gen, bar);
            __builtin_amdgcn_fence(__ATOMIC_ACQUIRE, "agent");
            asm volatile("s_waitcnt vmcnt(0)" ::: "memory");
        }
    }
    __syncthreads();
}

struct Args { const float* in[24]; float* out; unsigned char* ws; int ph_lo, ph_hi; };
struct Frame {
    LAS unsigned char* lds;
    volatile LAS unsigned* MISC;
    const Args* a;
    unsigned char* ws;
    unsigned* ctl;
    int tid, lane, wave, vcu, G;
};
#define FIN(i) (F.a->in[i])
#define F_x FIN(0)
#define F_c FIN(1)
#define F_w_ada FIN(2)
#define F_b_ada FIN(3)
#define F_g_attn FIN(4)
#define F_w_in FIN(5)
#define F_g_kv FIN(6)
#define F_w_uk FIN(7)
#define F_w_uv FIN(8)
#define F_lq1 FIN(9)
#define F_lk1 FIN(10)
#define F_lq2 FIN(11)
#define F_lk2 FIN(12)
#define F_g_sub FIN(13)
#define F_w_out FIN(14)
#define F_g_moe FIN(15)
#define F_w_group FIN(16)
#define F_b_group FIN(17)
#define F_w_router FIN(18)
#define F_b_router FIN(19)
#define F_w_gate FIN(20)
#define F_w_up FIN(21)
#define F_w_down FIN(22)
#define F_g_final FIN(23)
#define F_out (F.a->out)
#define F_mod ((float*)(F.ws + WS_MOD))
#define F_Win ((bf16_t*)(F.ws + WS_WIN))
#define F_Wout ((bf16_t*)(F.ws + WS_WOUT))
#define F_Wrt ((bf16_t*)(F.ws + WS_WRT))
#define F_Wuk ((bf16_t*)(F.ws + WS_WUK))
#define F_WuvT ((bf16_t*)(F.ws + WS_WUVT))
#define F_Wup ((bf16_t*)(F.ws + WS_WUP))
#define F_Wdn ((bf16_t*)(F.ws + WS_WDN))
#define F_XN ((bf16_t*)(F.ws + WS_XN))
#define F_DQ ((bf16_t*)(F.ws + WS_DQ))
#define F_FQ ((bf16_t*)(F.ws + WS_FQ))
#define F_FK ((bf16_t*)(F.ws + WS_FK))
#define F_FV ((bf16_t*)(F.ws + WS_FV))
#define F_YS ((bf16_t*)(F.ws + WS_YS))
#define F_O ((bf16_t*)(F.ws + WS_O))
#define F_DLAT ((bf16_t*)(F.ws + WS_DLAT))
#define F_CKV ((bf16_t*)(F.ws + WS_CKV))
#define F_IQ ((bf16_t*)(F.ws + WS_IQ))
#define F_IK ((bf16_t*)(F.ws + WS_IK))
#define F_HS ((bf16_t*)(F.ws + WS_HS))
#define F_IW ((float*)(F.ws + WS_IW))
#define F_LOG ((float*)(F.ws + WS_LOG))
#define F_GL ((float*)(F.ws + WS_GL))
#define F_REID ((int*)(F.ws + WS_REID))
#define F_RSLOT ((int*)(F.ws + WS_RSLOT))
#define F_TOK ((int*)(F.ws + WS_TOK))

__device__ __forceinline__ void p0_mod(Frame& F) {
    LAS float* ca = (LAS float*)(F.lds);
    LAS float* red = (LAS float*)(F.lds + 32768);
    for (int i = F.tid; i < NB * DM; i += NTHREADS) { const float v = F_c[i]; ca[i] = v / (1.f + __expf(-v)); }
    __syncthreads();
    const int kr = F.lane >> 3, c4 = F.lane & 7;
    for (int item = blockIdx.x; item < 192; item += F.G) {
        const int n0 = item * 32;
        float acc[4][8];
#pragma unroll
        for (int j = 0; j < 4; ++j)
#pragma unroll
            for (int b = 0; b < 8; ++b) acc[j][b] = 0.f;
#pragma unroll 4
        for (int it = 0; it < 16; ++it) {
            const int k = F.wave * 128 + it * 8 + kr;
            const f32x4 w = *(const f32x4*)(F_w_ada + (size_t)k * 6144 + n0 + c4 * 4);
#pragma unroll
            for (int b = 0; b < 8; ++b) { const float cv = ca[b * DM + k];
#pragma unroll
                for (int j = 0; j < 4; ++j) acc[j][b] += w[j] * cv; }
        }
#pragma unroll
        for (int j = 0; j < 4; ++j)
#pragma unroll
            for (int b = 0; b < 8; ++b) { float v = acc[j][b]; v += __shfl_xor(v, 8); v += __shfl_xor(v, 16); v += __shfl_xor(v, 32);
                if (kr == 0) red[(F.wave * 32 + c4 * 4 + j) * 8 + b] = v; }
        __syncthreads();
        if (F.tid < 256) { const int col = F.tid >> 3, b = F.tid & 7; float s = 0.f;
#pragma unroll
            for (int w = 0; w < 8; ++w) s += red[(w * 32 + col) * 8 + b];
            F_mod[b * 6144 + n0 + col] = s + F_b_ada[n0 + col]; }
        __syncthreads();
    }
}
__device__ __forceinline__ void tr_block(const float* W, int ldw, int k0, int c0, int nv, bf16_t* WT, int ldt, int r0, LAS float* scr, int lane) {
#pragma unroll
    for (int i = 0; i < 8; ++i) { const int kk = 8 * i + (lane >> 3), n4 = (lane & 7) * 4;
        const f32x4 v = (n4 < nv) ? *(const f32x4*)(W + (size_t)(k0 + kk) * ldw + c0 + n4) : (f32x4){0.f, 0.f, 0.f, 0.f};
        LAS float* d = scr + kk * 33 + n4; d[0] = v.x; d[1] = v.y; d[2] = v.z; d[3] = v.w; }
    LDS_WAIT(); asm volatile("" ::: "memory");
    const int c = lane & 7;
#pragma unroll
    for (int j = 0; j < 4; ++j) { const int n = (lane >> 3) + 8 * j; const LAS float* s = scr + (8 * c) * 33 + n;
        u32x4 o; o.x = pk2(s[0 * 33], s[1 * 33]); o.y = pk2(s[2 * 33], s[3 * 33]); o.z = pk2(s[4 * 33], s[5 * 33]); o.w = pk2(s[6 * 33], s[7 * 33]);
        *(u32x4*)(WT + (size_t)(r0 + n) * ldt + k0 + 8 * c) = o; }
    LDS_WAIT(); asm volatile("" ::: "memory");
}
__device__ __forceinline__ void p0_weights(Frame& F) {
    LAS float* scr = (LAS float*)(F.lds + F.wave * 16384);
    const int gw = F.vcu * NWAVES + F.wave, NGW = F.G * NWAVES;
    constexpr int I_IN = 16 * 80, I_OUT = 16 * 32, I_RT = 16 * 8, I_UV = 32, I_UP = 32 * 2 * 2 * 4 * 16, I_DN = 32 * 4 * 32;
    constexpr int NITEMS = I_IN + I_OUT + I_RT + I_UV + I_UP + I_DN;
    for (int it = gw; it < NITEMS; it += NGW) {
        int r = it;
        if (r < I_IN) { const int kb = r / 80, nb = r % 80, n0 = nb * 32; int c0 = 0, nv = 32;
            if (n0 < 512) c0 = n0; else if (n0 < 1024) c0 = 804 + (n0 - 512); else if (n0 < 1536) c0 = 1316 + (n0 - 1024); else if (n0 < 2048) c0 = 1828 + (n0 - 1536);
            else if (n0 < 2176) c0 = 512 + (n0 - 2048); else if (n0 < 2304) c0 = 640 + (n0 - 2176); else if (n0 == 2304) c0 = 768; else if (n0 == 2336) { c0 = 800; nv = 4; } else { c0 = 0; nv = 0; }
            tr_block(F_w_in, 2340, kb * 64, c0, nv, F_Win, DM, n0, scr, F.lane); continue; } r -= I_IN;
        if (r < I_OUT) { const int kb = r / 32, nb = r % 32; tr_block(F_w_out, DM, kb * 64, nb * 32, 32, F_Wout, DM, nb * 32, scr, F.lane); continue; } r -= I_OUT;
        if (r < I_RT) { const int kb = r / 8, nb = r % 8;
            if (nb == 0) tr_block(F_w_router, 32, kb * 64, 0, 32, F_Wrt, DM, 0, scr, F.lane);
            else if (nb == 1) tr_block(F_w_group, 4, kb * 64, 0, 4, F_Wrt, DM, 32, scr, F.lane);
            else tr_block(F_w_group, 4, kb * 64, 0, 0, F_Wrt, DM, nb * 32, scr, F.lane);
            continue; } r -= I_RT;
        if (r < I_UV) { const int h = r >> 2, kb = (r >> 1) & 1, nb = r & 1; tr_block(F_w_uv + h * 8192, 64, kb * 64, nb * 32, 32, F_WuvT + h * 8192, 128, nb * 32, scr, F.lane); continue; } r -= I_UV;
        if (r < I_UP) { const int kb = r & 15, nb4 = (r >> 4) & 3, gu = (r >> 6) & 1, jt = (r >> 7) & 1, e = r >> 8;
            tr_block((gu ? F_w_up : F_w_gate) + (size_t)e * 262144, 256, kb * 64, jt * 128 + nb4 * 32, 32, F_Wup, DM, e * 512 + jt * 256 + gu * 128 + nb4 * 32, scr, F.lane); continue; } r -= I_UP;
        { const int nb = r & 31, kb = (r >> 5) & 3, e = r >> 7;
            tr_block(F_w_down + (size_t)e * 262144, DM, kb * 64, nb * 32, 32, F_Wdn + (size_t)e * 262144, 256, nb * 32, scr, F.lane); }
    }
    for (int i = (blockIdx.x * NTHREADS + F.tid) * 4; i < 65536; i += F.G * NTHREADS * 4) { const f32x4 v = *(const f32x4*)(F_w_uk + i); u32x2 o; o.x = pk2(v[0], v[1]); o.y = pk2(v[2], v[3]); *(u32x2*)(F_Wuk + i) = o; }
}

__device__ __forceinline__ void modnorm_rows(Frame& F, const float* src, const float* g, int shift_off, int scale_off, bf16_t* dst) {
    const int gw = F.vcu * NWAVES + F.wave, NGW = F.G * NWAVES;
    constexpr int RPW = 32;
    for (int it = gw; it < NT / RPW; it += NGW) {
        const int m0 = it * RPW, b = m0 / SEQ;
        f32x4 G[4], SH[4];
#pragma unroll
        for (int j = 0; j < 4; ++j) { const f32x4 gg = *((const f32x4*)g + F.lane + 64 * j);
            const f32x4 sc = *((const f32x4*)(F_mod + b * 6144 + scale_off) + F.lane + 64 * j); SH[j] = *((const f32x4*)(F_mod + b * 6144 + shift_off) + F.lane + 64 * j);
            G[j] = gg * (sc + 1.f); }
        f32x4 v[4];
#pragma unroll
        for (int j = 0; j < 4; ++j) v[j] = *((const f32x4*)(src + (size_t)m0 * DM) + F.lane + 64 * j);
#pragma unroll 1
        for (int r = 0; r < RPW; ++r) {
            const size_t m = (size_t)m0 + r;
            f32x4 nx[4];
            const size_t mn = (r + 1 < RPW) ? m + 1 : m;
#pragma unroll
            for (int j = 0; j < 4; ++j) nx[j] = *((const f32x4*)(src + mn * DM) + F.lane + 64 * j);
            float s = 0.f;
#pragma unroll
            for (int j = 0; j < 4; ++j) s += (v[j].x * v[j].x + v[j].y * v[j].y) + (v[j].z * v[j].z + v[j].w * v[j].w);
            const float rstd = 1.f / sqrtf(wave_sum(s) * (1.f / DM) + RMS_EPS);
            u32x2* o8 = (u32x2*)(dst + m * DM) + F.lane;
#pragma unroll
            for (int j = 0; j < 4; ++j) { const f32x4 y = (v[j] * rstd) * G[j] + SH[j]; u32x2 o; o.x = pk2(y.x, y.y); o.y = pk2(y.z, y.w); o8[64 * j] = o; }
#pragma unroll
            for (int j = 0; j < 4; ++j) v[j] = nx[j];
        }
    }
}
__device__ __forceinline__ void ckv_rows(Frame& F) {
    const int gw = F.vcu * NWAVES + F.wave, NGW = F.G * NWAVES;
    const int sub = F.lane >> 5, l32 = F.lane & 31;
    const f32x4 gg = *((const f32x4*)F_g_kv + l32);
    for (int it = gw; it < NT / 2; it += NGW) {
        const size_t row = (size_t)it * 2 + sub;
        const u32x2 w = *((const u32x2*)(F_DLAT + row * 128) + l32);
        const float a = bflo(w.x), b = bfhi(w.x), c = bflo(w.y), d = bfhi(w.y);
        float s = (a * a + b * b) + (c * c + d * d);
#pragma unroll
        for (int o = 1; o < 32; o <<= 1) s += __shfl_xor(s, o);
        const float rstd = 1.f / sqrtf(s * (1.f / 128.f) + RMS_EPS);
        u32x2 o; o.x = pk2(a * rstd * gg.x, b * rstd * gg.y); o.y = pk2(c * rstd * gg.z, d * rstd * gg.w);
        *((u32x2*)(F_CKV + row * 128) + l32) = o;
    }
}

struct EpiProj {
    static constexpr bool PERM = true;
    bf16_t *DQ, *FQ, *FK, *FV, *DLAT, *IQ, *IK; float* IW;
    __device__ __forceinline__ void operator()(const f32x4 (&acc)[2][2][4][2], const pg8::Unit& u, int wr, int wc, int fr, int fq) const {
        const int row0 = u.pm * 256 + wr * 64 + fr;
#pragma unroll
        for (int bj = 0; bj < 2; ++bj) {
            const int sg = 2 * u.pn + bj;
            if (sg < 18) {
                bf16_t* base; int ld, col; float sc = 1.f;
                if (sg < 16) { const int t = sg >> 2; base = (t == 0) ? DQ : (t == 1) ? FQ : (t == 2) ? FK : FV; ld = 512; col = (sg & 3) * 128 + wc * 32 + 8 * fq; if (t == 1) sc = DIFF_C2; }
                else { base = (sg == 16) ? DLAT : IQ; ld = 128; col = wc * 32 + 8 * fq; }
#pragma unroll
                for (int ai = 0; ai < 2; ++ai)
#pragma unroll
                    for (int m = 0; m < 4; ++m) { const f32x4 v0 = acc[ai][bj][m][0] * sc, v1 = acc[ai][bj][m][1] * sc;
                        u32x4 w; w.x = pk2(v0[0], v0[1]); w.y = pk2(v0[2], v0[3]); w.z = pk2(v1[0], v1[1]); w.w = pk2(v1[2], v1[3]);
                        *(u32x4*)(base + (size_t)(row0 + ai * 128 + m * 16) * ld + col) = w; }
            } else if (sg == 18) {
                if (wc == 0) {
#pragma unroll
                    for (int ai = 0; ai < 2; ++ai)
#pragma unroll
                        for (int m = 0; m < 4; ++m) { const f32x4 v0 = acc[ai][bj][m][0], v1 = acc[ai][bj][m][1];
                            u32x4 w; w.x = pk2(v0[0], v0[1]); w.y = pk2(v0[2], v0[3]); w.z = pk2(v1[0], v1[1]); w.w = pk2(v1[2], v1[3]);
                            *(u32x4*)(IK + (size_t)(row0 + ai * 128 + m * 16) * 32 + 8 * fq) = w; }
                } else if (wc == 1 && fq == 0) {
#pragma unroll
                    for (int ai = 0; ai < 2; ++ai)
#pragma unroll
                        for (int m = 0; m < 4; ++m) *(f32x4*)(IW + (size_t)(row0 + ai * 128 + m * 16) * 4) = acc[ai][bj][m][0] * IW_SCALE;
                }
            }
        }
    }
};
struct EpiX1 {
    static constexpr bool PERM = false;
    const float* x; const float* mod; float* x1;
    __device__ __forceinline__ void operator()(const f32x4 (&acc)[2][2][4][2], const pg8::Unit& u, int wr, int wc, int fr, int fq) const {
        const int row0 = u.pm * 256 + wr * 64 + fr; const int b = (u.pm * 256) / SEQ;
#pragma unroll
        for (int bj = 0; bj < 2; ++bj)
#pragma unroll
            for (int n = 0; n < 2; ++n) { const int col = u.pn * 256 + bj * 128 + wc * 32 + n * 16 + 4 * fq;
                const f32x4 gv = *(const f32x4*)(mod + b * 6144 + 2048 + col);
#pragma unroll
                for (int ai = 0; ai < 2; ++ai)
#pragma unroll
                    for (int m = 0; m < 4; ++m) { const size_t off = (size_t)(row0 + ai * 128 + m * 16) * DM + col;
                        const f32x4 xv = *(const f32x4*)(x + off); *(f32x4*)(x1 + off) = xv + gv * acc[ai][bj][m][n]; } }
    }
};
struct EpiLogits {
    static constexpr bool PERM = false;
    float* LOG; const float* b_router; const float* b_group;
    __device__ __forceinline__ void operator()(const f32x4 (&acc)[2][2][4][2], const pg8::Unit& u, int wr, int wc, int fr, int fq) const {
        if (wc > 1) return;
        const int row0 = u.pm * 256 + wr * 64 + fr;
#pragma unroll
        for (int n = 0; n < 2; ++n) { const int col = wc * 32 + n * 16 + 4 * fq;
            if (col < 36) { const f32x4 bv = (col < 32) ? *(const f32x4*)(b_router + col) : *(const f32x4*)(b_group);
#pragma unroll
                for (int ai = 0; ai < 2; ++ai)
#pragma unroll
                    for (int m = 0; m < 4; ++m) *(f32x4*)(LOG + (size_t)(row0 + ai * 128 + m * 16) * 64 + col) = acc[ai][0][m][n] + bv; } }
    }
};
__device__ __forceinline__ float silu_f(float v) { return v * __builtin_amdgcn_rcpf(1.f + __expf(-v)); }
struct EpiUp {
    static constexpr bool PERM = true;
    bf16_t* HS;
    __device__ __forceinline__ void operator()(const f32x4 (&acc)[2][2][4][2], const pg8::Unit& u, int wr, int wc, int fr, int fq) const {
        const int row0 = u.pm * 256 + wr * 64 + fr; const int col = (u.pn & 1) * 128 + wc * 32 + 8 * fq;
#pragma unroll
        for (int ai = 0; ai < 2; ++ai)
#pragma unroll
            for (int m = 0; m < 4; ++m) { const f32x4 g0 = acc[ai][0][m][0], g1 = acc[ai][0][m][1], u0 = acc[ai][1][m][0], u1 = acc[ai][1][m][1];
                u32x4 w; w.x = pk2(silu_f(g0[0]) * u0[0], silu_f(g0[1]) * u0[1]); w.y = pk2(silu_f(g0[2]) * u0[2], silu_f(g0[3]) * u0[3]);
                w.z = pk2(silu_f(g1[0]) * u1[0], silu_f(g1[1]) * u1[1]); w.w = pk2(silu_f(g1[2]) * u1[2], silu_f(g1[3]) * u1[3]);
                *(u32x4*)(HS + (size_t)(row0 + ai * 128 + m * 16) * 256 + col) = w; }
    }
};
struct EpiDown {
    static constexpr bool PERM = true;
    bf16_t* YS; const float* GL; const LAS int* ecnt;
    __device__ __forceinline__ void operator()(const f32x4 (&acc)[2][2][4][2], const pg8::Unit& u, int wr, int wc, int fr, int fq) const {
        const int r0 = wr * 64 + fr; const int e = u.a0; const int cnt = ecnt[e];
        const int colb = (u.pn & 3) * 256 + wc * 32 + 8 * fq;
#pragma unroll
        for (int ai = 0; ai < 2; ++ai)
#pragma unroll
            for (int m = 0; m < 4; ++m) { const int r = r0 + ai * 128 + m * 16; int slot = u.a1 + r; slot = slot < cnt ? slot : cnt - 1;
                const float g = GL[(size_t)e * NT + slot];
#pragma unroll
                for (int bj = 0; bj < 2; ++bj) { const f32x4 v0 = acc[ai][bj][m][0] * g, v1 = acc[ai][bj][m][1] * g;
                    u32x4 w; w.x = pk2(v0[0], v0[1]); w.y = pk2(v0[2], v0[3]); w.z = pk2(v1[0], v1[1]); w.w = pk2(v1[2], v1[3]);
                    *(u32x4*)(YS + (size_t)(u.pm * 256 + r) * DM + colb + bj * 128) = w; } }
    }
};

struct MoeTab { LAS int* ecnt; LAS int* toff; };
__device__ __forceinline__ MoeTab moe_tables(Frame& F) {
    MoeTab t; t.ecnt = (LAS int*)(F.lds + MISC_OFF + 128); t.toff = t.ecnt + 32;
    __syncthreads();
    if (F.tid < 32) t.ecnt[F.tid] = (int)__hip_atomic_load(F.ctl + CW_ECNT + 64 * F.tid, __ATOMIC_RELAXED, __HIP_MEMORY_SCOPE_AGENT);
    __syncthreads();
    if (F.tid == 0) { int s = 0; for (int e = 0; e < 32; ++e) { t.toff[e] = s; s += (t.ecnt[e] + 255) >> 8; } t.toff[32] = s; }
    __syncthreads();
    return t;
}
template <int NPN, bool GATHER> struct MoeOrder {
    MoeTab tab; int G, c, K; const int* TOK;
    __device__ bool next(int i, pg8::Unit& u) const {
        const long L = (long)i * G + c; const int total = tab.toff[32] * NPN; if (L >= total) return false;
        const int rt = (int)(L / NPN), pl = (int)(L % NPN);
        int e = 0;
#pragma unroll 1
        for (int j = 1; j < 32; ++j) e = (tab.toff[j] <= rt) ? j : e;
        u.pm = rt; u.pn = e * NPN + pl; u.a0 = e; u.a1 = (rt - tab.toff[e]) * 256; return true;
    }
    __device__ __forceinline__ unsigned a_off(const pg8::Unit& u, int R) const {
        if constexpr (GATHER) { const int cnt = tab.ecnt[u.a0]; int slot = u.a1 + R; slot = slot < cnt ? slot : cnt - 1; return (unsigned)TOK[(size_t)u.a0 * NT + slot] * (unsigned)(K * 2); }
        else return (unsigned)(u.pm * 256 + R) * (unsigned)(K * 2);
    }
};
__device__ __forceinline__ void route_panel(Frame& F, int pm) {
    LAS int* lc = (LAS int*)(F.lds);
    LAS int* lb = lc + 32;
    {
        const bool act = F.tid < 256; const int tok = pm * 256 + (act ? F.tid : 0);
        if (F.tid < 32) lc[F.tid] = 0;
        __syncthreads();
        const float* lg = F_LOG + (size_t)tok * 64;
        float gl[4];
        { const f32x4 v = *(const f32x4*)(lg + 32); gl[0] = v[0]; gl[1] = v[1]; gl[2] = v[2]; gl[3] = v[3]; }
        int gs = 0; float gm = gl[0];
#pragma unroll
        for (int j = 1; j < 4; ++j) if (gl[j] > gm) { gm = gl[j]; gs = j; }
        float den = 0.f;
#pragma unroll
        for (int j = 0; j < 4; ++j) den += __expf(gl[j] - gm);
        const float pg = 1.f / den;
        float el[8];
        { const f32x4 a = *(const f32x4*)(lg + gs * 8), b = *(const f32x4*)(lg + gs * 8 + 4); el[0] = a[0]; el[1] = a[1]; el[2] = a[2]; el[3] = a[3]; el[4] = b[0]; el[5] = b[1]; el[6] = b[2]; el[7] = b[3]; }
        int i0 = 0; float v0 = el[0];
#pragma unroll
        for (int j = 1; j < 8; ++j) if (el[j] > v0) { v0 = el[j]; i0 = j; }
        int i1 = -1; float v1 = -INFINITY;
#pragma unroll
        for (int j = 0; j < 8; ++j) if (j != i0 && (i1 < 0 || el[j] > v1)) { v1 = el[j]; i1 = j; }
        const float ex = __expf(v1 - v0); const float w0 = pg / (1.f + ex), w1 = w0 * ex;
        const int e0 = gs * 8 + i0, e1 = gs * 8 + i1;
        int r0 = 0, r1 = 0;
        if (act) { r0 = __hip_atomic_fetch_add(lc + e0, 1, __ATOMIC_RELAXED, __HIP_MEMORY_SCOPE_WORKGROUP); r1 = __hip_atomic_fetch_add(lc + e1, 1, __ATOMIC_RELAXED, __HIP_MEMORY_SCOPE_WORKGROUP); }
        __syncthreads();
        if (F.tid < 32) lb[F.tid] = (int)__hip_atomic_fetch_add(F.ctl + CW_ECNT + 64 * F.tid, (unsigned)lc[F.tid], __ATOMIC_RELAXED, __HIP_MEMORY_SCOPE_AGENT);
        __syncthreads();
        if (act) { const int s0 = lb[e0] + r0, s1 = lb[e1] + r1;
            F_TOK[(size_t)e0 * NT + s0] = tok; F_TOK[(size_t)e1 * NT + s1] = tok;
            F_GL[(size_t)e0 * NT + s0] = w0; F_GL[(size_t)e1 * NT + s1] = w1;
            *(int2*)(F_REID + (size_t)tok * 2) = make_int2(e0, e1);
            *(int2*)(F_RSLOT + (size_t)tok * 2) = make_int2(s0, s1); }
        __syncthreads();
    }
}
__device__ __forceinline__ void combine_rows(Frame& F, const MoeTab& tab) {
    const int gw = F.vcu * NWAVES + F.wave, NGW = F.G * NWAVES;
    constexpr int RPW = 32;
    for (int it = gw; it < NT / RPW; it += NGW) {
        const int m0 = it * RPW, b = m0 / SEQ;
        f32x4 GM[4], GF[4];
#pragma unroll
        for (int j = 0; j < 4; ++j) { GM[j] = *((const f32x4*)(F_mod + b * 6144 + 5120) + F.lane + 64 * j); GF[j] = *((const f32x4*)F_g_final + F.lane + 64 * j); }
        int2 ee = *(const int2*)(F_REID + (size_t)m0 * 2), ss = *(const int2*)(F_RSLOT + (size_t)m0 * 2);
        f32x4 xv[4]; u32x2 ya[4], yc[4];
        { const size_t p0 = (size_t)tab.toff[ee.x] * 256 + ss.x, p1 = (size_t)tab.toff[ee.y] * 256 + ss.y;
#pragma unroll
          for (int j = 0; j < 4; ++j) { xv[j] = *((const f32x4*)(F_out + (size_t)m0 * DM) + F.lane + 64 * j); ya[j] = *((const u32x2*)(F_YS + p0 * DM) + F.lane + 64 * j); yc[j] = *((const u32x2*)(F_YS + p1 * DM) + F.lane + 64 * j); } }
#pragma unroll 1
        for (int r = 0; r < RPW; ++r) {
            const size_t m = (size_t)m0 + r; const size_t mn = (r + 1 < RPW) ? m + 1 : m;
            const int2 een = *(const int2*)(F_REID + mn * 2), ssn = *(const int2*)(F_RSLOT + mn * 2);
            f32x4 v[4]; float s = 0.f;
#pragma unroll
            for (int j = 0; j < 4; ++j) { const u32x2 a = ya[j], c = yc[j];
                const f32x4 ys = {bflo(a.x) + bflo(c.x), bfhi(a.x) + bfhi(c.x), bflo(a.y) + bflo(c.y), bfhi(a.y) + bfhi(c.y)};
                v[j] = xv[j] + GM[j] * ys; s += (v[j].x * v[j].x + v[j].y * v[j].y) + (v[j].z * v[j].z + v[j].w * v[j].w); }
            { const size_t p0 = (size_t)tab.toff[een.x] * 256 + ssn.x, p1 = (size_t)tab.toff[een.y] * 256 + ssn.y;
#pragma unroll
              for (int j = 0; j < 4; ++j) { xv[j] = *((const f32x4*)(F_out + mn * DM) + F.lane + 64 * j); ya[j] = *((const u32x2*)(F_YS + p0 * DM) + F.lane + 64 * j); yc[j] = *((const u32x2*)(F_YS + p1 * DM) + F.lane + 64 * j); } }
            const float rstd = 1.f / sqrtf(wave_sum(s) * (1.f / DM) + RMS_EPS);
            f32x4* orow = (f32x4*)(F_out + m * DM) + F.lane;
#pragma unroll
            for (int j = 0; j < 4; ++j) orow[64 * j] = (v[j] * rstd) * GF[j];
        }
    }
}

constexpr float DIFF_SKIP_LOG2 = 150.f;
__device__ __forceinline__ int diff_tstart(int h, int qb) {
    const float slope2 = exp2f(-2.0f * (float)(h + 1)) * LOG2E;
    const float tmax = ((float)(128 * qb - 63) - DIFF_SKIP_LOG2 / slope2) * (1.f / 64.f);
    int t = (int)floorf(tmax) + 1; return t < 0 ? 0 : t;
}
__device__ __forceinline__ void knorm_rows(Frame& F) {
    const int gw = F.vcu * NWAVES + F.wave, NGW = F.G * NWAVES;
    float* KN2 = (float*)(F.ws + WS_KN2);
    for (int it = gw; it < NB * 128; it += NGW) {
        const int b = it >> 7, tile = it & 127;
        const u32x4* rp = (const u32x4*)(F_FK + ((size_t)(b * SEQ + tile * 64)) * 512) + F.lane;
        float mx = 0.f;
#pragma unroll 4
        for (int r = 0; r < 64; ++r) { const u32x4 v = rp[(size_t)r * 64];
            float s = bflo(v.x) * bflo(v.x) + bfhi(v.x) * bfhi(v.x); s += bflo(v.y) * bflo(v.y) + bfhi(v.y) * bfhi(v.y); s += bflo(v.z) * bflo(v.z) + bfhi(v.z) * bfhi(v.z); s += bflo(v.w) * bflo(v.w) + bfhi(v.w) * bfhi(v.w);
            s += __shfl_xor(s, 1); s += __shfl_xor(s, 2); s += __shfl_xor(s, 4);
            mx = fmaxf(mx, s); }
        if ((F.lane & 7) == 0) { const int hs = F.lane >> 3; KN2[((size_t)(b * 8 + hs)) * 128 + tile] = mx; }
    }
}
__device__ __forceinline__ void diff_unit(Frame& F, int b, int h, int qb, float lam, float lam_init) {
    int tid = F.tid; asm volatile("" : "+v"(tid));
    const int lane = tid & 63, wave = F.wave;
    const int r32 = lane & 31, hi = lane >> 5;
    const int st = wave >> 2, wq = wave & 3;
    const int q0 = qb * 128, nt = 2 * qb + 2;
    const int t0 = diff_tstart(h, qb);
    const float slope2 = exp2f(-2.0f * (float)(h + 1)) * LOG2E;
    LAS unsigned char* L = F.lds;
    const int qpos = q0 + 32 * wq + r32;
    bf16x8 qf[4];
    { const bf16_t* qp = F_FQ + ((size_t)(b * SEQ + qpos) * 512 + h * 128 + st * 64 + hi * 8);
#pragma unroll
      for (int s = 0; s < 4; ++s) qf[s] = *(const bf16x8*)(qp + 16 * s); }
    float mref;
    { float qs = 0.f;
#pragma unroll
      for (int s = 0; s < 4; ++s)
#pragma unroll
          for (int j = 0; j < 8; ++j) { const float v = bf2f((unsigned short)qf[s][j]); qs += v * v; }
      qs += __shfl_xor(qs, 32);
      const float* kn = (const float*)(F.ws + WS_KN2) + ((size_t)(b * 8 + h * 2 + st)) * 128;
      float km = 0.f;
      for (int t = t0 + lane; t < nt; t += 64) km = fmaxf(km, kn[t]);
#pragma unroll
      for (int o = 1; o < 64; o <<= 1) km = fmaxf(km, __shfl_xor(km, o));
      mref = sqrtf(qs) * sqrtf(km); }
    const int srow = 4 * wave + (lane >> 4), sslot = lane & 15;
    const unsigned schunk = (unsigned)sslot ^ ((((unsigned)srow & 3u) << 2) | (((unsigned)srow >> 2) & 3u));
    const size_t gk = ((size_t)(b * SEQ) * 512 + h * 128) + (size_t)srow * 512 + schunk * 8;
    const unsigned ldsb = (unsigned)(uintptr_t)(L + wave * 1024);
#define DIFF_GLDS(gp, ldsoff) do { unsigned keep_; asm volatile("s_mov_b32 %0, m0\n\ts_mov_b32 m0, %2\n\ts_nop 0\n\tglobal_load_lds_dwordx4 %1, off\n\ts_mov_b32 m0, %0" : "=&s"(keep_) : "v"(gp), "s"((unsigned)__builtin_amdgcn_readfirstlane(ldsb + (ldsoff))) : "memory"); } while (0)
#define DIFF_STAGE(t, bo) do { const size_t go = gk + (size_t)(t) * 64 * 512; \
        DIFF_GLDS(F_FK + go, (bo)); DIFF_GLDS(F_FK + go + 32 * 512, (bo) + 8192); DIFF_GLDS(F_FV + go, 49152 + (bo)); DIFF_GLDS(F_FV + go + 32 * 512, 49152 + (bo) + 8192); } while (0)
    const unsigned kswz = ((unsigned)(r32 & 3) << 2) | ((unsigned)(r32 >> 2) & 3u);
    unsigned koff[4];
#pragma unroll
    for (int s = 0; s < 4; ++s) koff[s] = 256u * r32 + 16u * (((unsigned)(8 * st + 2 * s + hi)) ^ kswz);
    const int qq = (lane & 15) >> 2, pp = lane & 3, blk = (lane >> 4) & 1;
    unsigned vo[2][4];
#pragma unroll
    for (int tt = 0; tt < 2; ++tt)
#pragma unroll
        for (int cb = 0; cb < 4; ++cb) vo[tt][cb] = 256u * (unsigned)(8 * tt + 4 * hi + qq) + 16u * (((unsigned)(4 * cb + 2 * blk + (pp >> 1))) ^ (((unsigned)qq << 2) | ((unsigned)(2 * tt + hi) & 3u))) + 8u * (unsigned)(pp & 1);
    int b0 = 0, b1 = 16384, b2 = 32768;
    DIFF_STAGE(t0, b0); DIFF_STAGE(t0 + 1, b1);
    asm volatile("s_waitcnt vmcnt(0)" ::: "memory");
    __syncthreads();
    float lrow = 0.f;
    f32x16 o[4];
#pragma unroll
    for (int cb = 0; cb < 4; ++cb)
#pragma unroll
        for (int r = 0; r < 16; ++r) o[cb][r] = 0.f;
    f32x16 p[2];
#define DIFF_KFR(dst, Kb_, kh_) do { _Pragma("unroll") for (int s = 0; s < 4; ++s) dst[s] = *(const LAS bf16x8*)((Kb_) + (kh_) * 8192 + koff[s]); } while (0)
#define DIFF_QKH(dst, kf_, t_, kh_) do { const float cbias = slope2 * (float)(64 * (t_) + 32 * (kh_) + 4 * hi - qpos) - mref; f32x16 c; \
        _Pragma("unroll") for (int r = 0; r < 16; ++r) c[r] = fmaf(slope2, (float)((r & 3) + 8 * (r >> 2)), cbias); \
        _Pragma("unroll") for (int s = 0; s < 4; ++s) c = MFMA32(kf_[s], qf[s], c); dst = c; } while (0)
#define DIFF_VFR(dst, cb_) do { _Pragma("unroll") for (int ks = 0; ks < 4; ++ks) { const s16x4 v0_ = tr_read((const LAS char*)(Vb + vo[0][cb_] + 4096 * ks)); const s16x4 v1_ = tr_read((const LAS char*)(Vb + vo[1][cb_] + 4096 * ks)); dst[ks] = cat8(v0_, v1_); } } while (0)
    { bf16x8 ka[4], kb_[4]; DIFF_KFR(ka, L + b0, 0); DIFF_KFR(kb_, L + b0, 1); DIFF_QKH(p[0], ka, t0, 0); DIFF_QKH(p[1], kb_, t0, 1); }
#pragma unroll 1
    for (int t = t0; t < nt; ++t) {
        const bool more = (t + 1 < nt);
        if (t + 2 < nt) DIFF_STAGE(t + 2, b2);
        const LAS unsigned char* Kn = L + b1;
        const LAS unsigned char* Vb = L + 49152 + b0;
        bf16x8 kfa[4], kfb[4], vfa[4], vfb[4];
        DIFF_VFR(vfa, 0);
        if (more) { DIFF_KFR(kfa, Kn, 0); DIFF_KFR(kfb, Kn, 1); }
        __builtin_amdgcn_sched_barrier(0);
        if (t >= nt - 2) {
#pragma unroll
            for (int kh = 0; kh < 2; ++kh)
#pragma unroll
                for (int r = 0; r < 16; ++r) { const int kpos = 64 * t + 32 * kh + crow(r, hi); if (kpos > qpos) p[kh][r] = -INFINITY; }
        }
        float ps = 0.f;
#pragma unroll
        for (int kh = 0; kh < 2; ++kh)
#pragma unroll
            for (int r = 0; r < 16; ++r) { const float e = __builtin_amdgcn_exp2f(p[kh][r]); p[kh][r] = e; ps += e; }
        lrow += ps;
        bf16x8 pa[4];
#pragma unroll
        for (int ks = 0; ks < 4; ++ks) { const int kh = ks >> 1, r0 = (ks & 1) * 8;
            u32x4 w; w.x = pk2(p[kh][r0], p[kh][r0 + 1]); w.y = pk2(p[kh][r0 + 2], p[kh][r0 + 3]); w.z = pk2(p[kh][r0 + 4], p[kh][r0 + 5]); w.w = pk2(p[kh][r0 + 6], p[kh][r0 + 7]);
            pa[ks] = __builtin_bit_cast(bf16x8, w); }
        __builtin_amdgcn_sched_barrier(0);
        DIFF_VFR(vfb, 1);
        __builtin_amdgcn_sched_barrier(0);
#pragma unroll
        for (int ks = 0; ks < 4; ++ks) o[0] = MFMA32(vfa[ks], pa[ks], o[0]);
        __builtin_amdgcn_sched_barrier(0);
        DIFF_VFR(vfa, 2);
        __builtin_amdgcn_sched_barrier(0);
#pragma unroll
        for (int ks = 0; ks < 4; ++ks) o[1] = MFMA32(vfb[ks], pa[ks], o[1]);
        __builtin_amdgcn_sched_barrier(0);
        DIFF_VFR(vfb, 3);
        __builtin_amdgcn_sched_barrier(0);
#pragma unroll
        for (int ks = 0; ks < 4; ++ks) o[2] = MFMA32(vfa[ks], pa[ks], o[2]);
        if (more) { DIFF_QKH(p[0], kfa, t + 1, 0); }
#pragma unroll
        for (int ks = 0; ks < 4; ++ks) o[3] = MFMA32(vfb[ks], pa[ks], o[3]);
        if (more) { DIFF_QKH(p[1], kfb, t + 1, 1); }
        asm volatile("s_waitcnt vmcnt(0)" ::: "memory");
        __syncthreads();
        { const int tb_ = b0; b0 = b1; b1 = b2; b2 = tb_; }
    }
#undef DIFF_VFR
#undef DIFF_KFR
#undef DIFF_QKH
#undef DIFF_STAGE
#undef DIFF_GLDS
    lrow += __shfl_xor(lrow, 32);
    const float rl = 1.f / lrow;
    LAS float* X = (LAS float*)L;
    if (st == 1) {
#pragma unroll
        for (int cb = 0; cb < 4; ++cb)
#pragma unroll
            for (int r = 0; r < 16; ++r) X[(wq * 64 + cb * 16 + r) * 64 + lane] = o[cb][r] * rl;
    }
    __syncthreads();
    if (st == 0) {
        float ss = 0.f;
#pragma unroll
        for (int cb = 0; cb < 4; ++cb)
#pragma unroll
            for (int r = 0; r < 16; ++r) { const float d = o[cb][r] * rl - lam * X[(wq * 64 + cb * 16 + r) * 64 + lane]; o[cb][r] = d; ss += d * d; }
        ss += __shfl_xor(ss, 32);
        const float rstd = (1.f - lam_init) / sqrtf(ss * (1.f / 128.f) + RMS_EPS);
        bf16_t* orow = F_O + (size_t)(b * SEQ + qpos) * DM + 512 + h * 128;
#pragma unroll
        for (int cb = 0; cb < 4; ++cb)
#pragma unroll
            for (int r4 = 0; r4 < 4; ++r4) { const int c0 = 32 * cb + 8 * r4 + 4 * hi;
                const f32x4 gg = *(const f32x4*)(F_g_sub + c0);
                u32x2 w; w.x = pk2(o[cb][4 * r4] * rstd * gg[0], o[cb][4 * r4 + 1] * rstd * gg[1]); w.y = pk2(o[cb][4 * r4 + 2] * rstd * gg[2], o[cb][4 * r4 + 3] * rstd * gg[3]);
                *(u32x2*)(orow + c0) = w; }
    }
    __syncthreads();
}
__device__ __forceinline__ int wq_next(Frame& F, int qid) {
    LAS int* slot = (LAS int*)(F.lds + MISC_OFF + 96);
    __syncthreads();
    if (F.tid == 0) *slot = (int)__hip_atomic_fetch_add(F.ctl + CW_WQ + 64 * qid, 1u, __ATOMIC_RELAXED, __HIP_MEMORY_SCOPE_AGENT);
    __syncthreads();
    return *slot;
}
__device__ __forceinline__ void diff_phase(Frame& F) {
    if (F.G != 256) return;
    const float lam_init = 0.8f - 0.6f * 1.0f;
    float a = F_lq1[F.lane] * F_lk1[F.lane], c = F_lq2[F.lane] * F_lk2[F.lane];
    a = wave_sum(a); c = wave_sum(c);
    const float lam = __expf(a) - __expf(c) + lam_init;
    const int b = F.vcu >> 5;
    LAS int* cost = (LAS int*)(F.lds + 147456);
    LAS int* order = cost + 256;
    __syncthreads();
    if (F.tid < 256) { const int h = F.tid >> 6, qb = F.tid & 63; cost[F.tid] = (2 * qb + 2 - diff_tstart(h, qb)) + 4; }
    __syncthreads();
    if (F.tid < 256) { const int cm = cost[F.tid]; int rank = 0;
        for (int j = 0; j < 256; ++j) { const int cj = cost[j]; rank += (cj > cm || (cj == cm && j < F.tid)) ? 1 : 0; }
        order[rank] = F.tid; }
    __syncthreads();
#pragma unroll 1
    for (;;) { const int u = wq_next(F, 2 * b); if (u >= 256) break;
        const int id = order[u];
        diff_unit(F, b, id >> 6, id & 63, lam, lam_init); }
}

constexpr int DSA_NBIN = 1024;
constexpr int DSA_POOLCAP = 16384;
constexpr int DSA_SEL_OFF = 131072, DSA_SM_OFF = 147456, DSA_GI_OFF = 65536;
constexpr float DSA_SCALE2 = 0.125f * LOG2E;

__device__ __forceinline__ unsigned off_c(unsigned row, unsigned ch) { return 256u * row + 16u * (ch ^ (((row & 7u) << 1) | ((row >> 2) & 1u))); }
__device__ __forceinline__ unsigned f32_sortable(float f) { const unsigned u = __builtin_bit_cast(unsigned, f); return u ^ ((u >> 31) ? 0xffffffffu : 0x80000000u); }

__device__ __forceinline__ float relu_raw(float v) { int i = __builtin_bit_cast(int, v); i = i > 0 ? i : 0; return __builtin_bit_cast(float, i); }
typedef short s16x2_t __attribute__((ext_vector_type(2)));
template <int PASS>
__device__ __forceinline__ void dsa_pass(Frame& F, int b, int q0, const bf16x8 (&qf)[4][2], const float (&w)[4], int lane, int grp) {
    const int r32 = lane & 31, hi = lane >> 5;
    LAS unsigned* hist = (LAS unsigned*)F.lds;
    LAS unsigned long long* pool = (LAS unsigned long long*)F.lds;
    LAS unsigned short* sel = (LAS unsigned short*)(F.lds + DSA_SEL_OFF);
    LAS int* sm = (LAS int*)(F.lds + DSA_SM_OFF);
    const int qpos = q0 + r32;
    const int nkb = (q0 >> 5) + 1;
    int tb = 0, po = 0;
    if (PASS == 2) { tb = (sm[200 + r32] == grp) ? sm[r32] : 0x7fffffff; po = sm[96 + r32]; }
    LAS unsigned* hq = hist + r32 * DSA_NBIN;
    const bf16_t* kbase = F_IK + ((size_t)(b * SEQ + r32) * 32 + hi * 8);
    bf16x8 n0 = {0, 0, 0, 0, 0, 0, 0, 0}, n1 = n0;
    if (F.wave < nkb) { const bf16_t* kp = kbase + (size_t)F.wave * 1024; n0 = *(const bf16x8*)kp; n1 = *(const bf16x8*)(kp + 16); }
#pragma unroll 1
    for (int kb = F.wave; kb < nkb; kb += NWAVES) {
        const bf16x8 a0 = n0, a1 = n1;
        if (kb + NWAVES < nkb) { const bf16_t* kp = kbase + (size_t)(kb + NWAVES) * 1024; n0 = *(const bf16x8*)kp; n1 = *(const bf16x8*)(kp + 16); }
        f32x16 sc;
#pragma unroll
        for (int r = 0; r < 16; ++r) sc[r] = 0.f;
#pragma unroll
        for (int h = 0; h < 4; ++h) {
            f32x16 acc;
#pragma unroll
            for (int r = 0; r < 16; ++r) acc[r] = 0.f;
            acc = MFMA32(a0, qf[h][0], acc); acc = MFMA32(a1, qf[h][1], acc);
#pragma unroll
            for (int r = 0; r < 16; ++r) sc[r] = fmaf(relu_raw(acc[r]), w[h], sc[r]);
            if (h == 1) __builtin_amdgcn_sched_barrier(0);
        }
        const bool diag = (kb == nkb - 1);
        const int lim = diag ? qpos - 32 * kb : 64;
        int bin[16];
#pragma unroll
        for (int r = 0; r < 16; r += 2) { const int pk = __builtin_bit_cast(int, __builtin_amdgcn_cvt_pknorm_i16(sc[r], sc[r + 1])); bin[r] = (((int)((unsigned)pk << 16)) >> 22) + 512; bin[r + 1] = (pk >> 22) + 512; }
        if (PASS == 1) {
            if (!diag) {
#pragma unroll
                for (int r = 0; r < 16; ++r) (void)__hip_atomic_fetch_add(hq + bin[r], 1u, __ATOMIC_RELAXED, __HIP_MEMORY_SCOPE_WORKGROUP);
            } else {
#pragma unroll
                for (int r = 0; r < 16; ++r) (void)__hip_atomic_fetch_add(hq + bin[r], (crow(r, hi) <= lim) ? 1u : 0u, __ATOMIC_RELAXED, __HIP_MEMORY_SCOPE_WORKGROUP);
            }
        } else {
            unsigned abm = 0u, eqm = 0u;
#pragma unroll
            for (int r = 0; r < 16; ++r) { const bool ok = crow(r, hi) <= lim; abm |= (ok && bin[r] > tb) ? (1u << r) : 0u; eqm |= (ok && bin[r] == tb) ? (1u << r) : 0u; }
            const unsigned basew = __hip_atomic_fetch_add((LAS unsigned*)(sm + 128) + r32, (unsigned)__builtin_popcount(abm) | ((unsigned)__builtin_popcount(eqm) << 16), __ATOMIC_RELAXED, __HIP_MEMORY_SCOPE_WORKGROUP);
            int sa = r32 * 256 + (int)(basew & 0xffffu), sc2 = po + (int)(basew >> 16);
            const int kb0 = 32 * kb + 4 * hi;
            while (abm) { const int r = __builtin_ctz(abm); abm &= abm - 1u; sel[sa] = (unsigned short)(kb0 + (r & 3) + 8 * (r >> 2)); ++sa; }
            while (eqm) { const int r = __builtin_ctz(eqm); eqm &= eqm - 1u;
                float v = sc[0];
#pragma unroll
                for (int j = 1; j < 16; ++j) v = (r == j) ? sc[j] : v;
                if (sc2 < DSA_POOLCAP) pool[sc2] = ((unsigned long long)f32_sortable(v + 0.f) << 16) | (unsigned long long)(0xffffu - (unsigned)(kb0 + (r & 3) + 8 * (r >> 2))); ++sc2; }
        }
    }
}

template <int NR>
__device__ __forceinline__ void dsa_resolve(const LAS unsigned long long* pq, int c, int r, LAS unsigned short* selq, int lane) {
    unsigned long long kk[NR];
#pragma unroll
    for (int i = 0; i < NR; ++i) { const int idx = 64 * i + lane; const bool in = idx < c; kk[i] = in ? pq[in ? idx : 0] : 0ull; }
    unsigned long long P = 0ull;
    if (c > r) {
        constexpr unsigned long long ZMIN = 0x80000000ull << 16, ZMAX = ZMIN | 0xffffull;
        int ngt = 0, nge = 0;
#pragma unroll
        for (int i = 0; i < NR; ++i) { ngt += __builtin_popcountll(__ballot(kk[i] > ZMAX)); nge += __builtin_popcountll(__ballot(kk[i] >= ZMIN)); }
        int bit = 47;
        if (ngt < r && r <= nge) { P = ZMIN | 0xe000ull; bit = 12; }
#pragma unroll 1
        for (; bit >= 0; --bit) {
            const unsigned long long trial = P | (1ull << bit);
            int cnt = 0;
#pragma unroll
            for (int i = 0; i < NR; ++i) cnt += __builtin_popcountll(__ballot(kk[i] >= trial));
            if (cnt >= r) { P = trial; if (cnt == r) break; }
        }
    }
    int outp = 0;
#pragma unroll
    for (int i = 0; i < NR; ++i) { const bool take = (64 * i + lane < c) && kk[i] >= P; const unsigned long long bal = __ballot(take);
        const int pos = outp + __builtin_popcountll(bal & ((1ull << lane) - 1ull));
        if (take && pos < r) selq[pos] = (unsigned short)(0xffffu - (unsigned)(kk[i] & 0xffffull));
        outp += __builtin_popcountll(bal); }
}

__device__ __forceinline__ void dsa_topk(Frame& F, int b, int qt) {
    int lane = F.lane; asm volatile("" : "+v"(lane));
    const int r32 = lane & 31, hi = lane >> 5, wave = F.wave;
    const int q0 = qt * 32;
    LAS unsigned* hist = (LAS unsigned*)F.lds;
    LAS unsigned long long* pool = (LAS unsigned long long*)F.lds;
    LAS unsigned short* sel = (LAS unsigned short*)(F.lds + DSA_SEL_OFF);
    LAS int* sm = (LAS int*)(F.lds + DSA_SM_OFF);
    if (q0 + 32 <= 256) {
        for (int i = F.tid; i < 32 * 256; i += NTHREADS) { const int q = i >> 8, j = i & 255; sel[i] = (j <= q0 + q) ? (unsigned short)j : (unsigned short)0xffffu; }
        __syncthreads();
        return;
    }

    bf16x8 qf[4][2]; float w[4];
    { const bf16_t* qp = F_IQ + ((size_t)(b * SEQ + q0 + r32) * 128 + hi * 8);
#pragma unroll
      for (int h = 0; h < 4; ++h) { qf[h][0] = *(const bf16x8*)(qp + h * 32); qf[h][1] = *(const bf16x8*)(qp + h * 32 + 16);
      }
      const f32x4 wv = *(const f32x4*)(F_IW + (size_t)(b * SEQ + q0 + r32) * 4);
      const float wm = fmaxf(fmaxf(fabsf(wv[0]), fabsf(wv[1])), fmaxf(fabsf(wv[2]), fabsf(wv[3]))); int ex = 0; (void)frexpf(wm, &ex);
      const float wsc = (wm > 0.f) ? ldexpf(1.f, -ex - 6) : 1.f;
      w[0] = wv[0] * wsc; w[1] = wv[1] * wsc; w[2] = wv[2] * wsc; w[3] = wv[3] * wsc; }
    for (int i = F.tid; i < 32 * DSA_NBIN / 4; i += NTHREADS) ((LAS u32x4*)hist)[i] = (u32x4){0u, 0u, 0u, 0u};
    for (int i = F.tid; i < 32 * 256 / 8; i += NTHREADS) ((LAS u32x4*)sel)[i] = (u32x4){0xffffffffu, 0xffffffffu, 0xffffffffu, 0xffffffffu};
    if (F.tid < 65) sm[128 + F.tid] = 0;
    __syncthreads();


    dsa_pass<1>(F, b, q0, qf, w, lane, 0);
    __syncthreads();


#pragma unroll 1
    for (int qi = 0; qi < 4; ++qi) {
        const int q = 4 * wave + qi;
        unsigned hv[16];
#pragma unroll
        for (int j4 = 0; j4 < 4; ++j4) { const u32x4 v = *(const LAS u32x4*)(hist + q * DSA_NBIN + 16 * lane + 4 * j4); hv[4 * j4] = v.x; hv[4 * j4 + 1] = v.y; hv[4 * j4 + 2] = v.z; hv[4 * j4 + 3] = v.w; }
        unsigned lsum = 0;
#pragma unroll
        for (int j = 0; j < 16; ++j) lsum += hv[j];
        unsigned incl = lsum;
#pragma unroll
        for (int o = 1; o < 64; o <<= 1) { const unsigned v = __shfl_down(incl, o); incl += (lane + o < 64) ? v : 0u; }
        const unsigned excl = incl - lsum;
        if (excl < 256u && incl >= 256u) {
            unsigned run = excl; int tbin = 0; unsigned nab = 0, cc = 0; bool found = false;
#pragma unroll
            for (int j = 15; j >= 0; --j) { if (!found) { if (run + hv[j] >= 256u) { found = true; tbin = 16 * lane + j; nab = run; cc = hv[j]; } else run += hv[j]; } }
            sm[q] = tbin; sm[32 + q] = (int)nab; sm[64 + q] = (int)cc;
        }
    }
    __syncthreads();
    if (F.tid == 0) {
        int off = 0, g = 0;
        for (int q = 0; q < 32; ++q) { const int c = sm[64 + q]; if (off + c > DSA_POOLCAP) { ++g; off = 0; } sm[96 + q] = off; sm[200 + q] = g; off += c; }
        sm[232] = g + 1;
    }
    __syncthreads();
    const int ngrp = __builtin_amdgcn_readfirstlane(sm[232]);

#pragma unroll 1
    for (int grp = 0; grp < ngrp; ++grp) {
    dsa_pass<2>(F, b, q0, qf, w, lane, grp);
    __syncthreads();

#pragma unroll 1
    for (int qi = 0; qi < 4; ++qi) {
        const int q = 4 * wave + qi;
        if (__builtin_amdgcn_readfirstlane(sm[200 + q]) != grp) continue;
        const int base = __builtin_amdgcn_readfirstlane(sm[96 + q]); int c = __builtin_amdgcn_readfirstlane(sm[64 + q]);
        const int nab = __builtin_amdgcn_readfirstlane(sm[32 + q]); const int r = 256 - nab;
        if (base + c > DSA_POOLCAP) c = (DSA_POOLCAP - base) > 0 ? (DSA_POOLCAP - base) : 0;
        LAS unsigned short* selq = sel + q * 256 + nab;
        const LAS unsigned long long* pq = pool + base;
        if (c <= 64) dsa_resolve<1>(pq, c, r, selq, lane);
        else if (c <= 128) dsa_resolve<2>(pq, c, r, selq, lane);
        else if (c <= 256) dsa_resolve<4>(pq, c, r, selq, lane);
        else if (c <= 512) dsa_resolve<8>(pq, c, r, selq, lane);
        else if (c <= 1024) dsa_resolve<16>(pq, c, r, selq, lane);
        else {
#define DSA_COUNT_GE(out_, thr_) do { int cnt_ = 0; _Pragma("unroll 4") for (int i0 = 0; i0 < c; i0 += 64) { const int i = i0 + lane; const unsigned long long v_ = pq[i < c ? i : 0]; cnt_ += __builtin_popcountll(__ballot((i < c) && v_ >= (thr_))); } out_ = cnt_; } while (0)
            constexpr unsigned long long ZMIN = 0x80000000ull << 16, ZMAX = ZMIN | 0xffffull;
            unsigned long long P = 0ull;
            if (c > r) {
                int ngt, nge; DSA_COUNT_GE(ngt, ZMAX + 1ull); DSA_COUNT_GE(nge, ZMIN);
                int bit = 47;
                if (ngt < r && r <= nge) { P = ZMIN | 0xe000ull; bit = 12; }
#pragma unroll 1
                for (; bit >= 0; --bit) {
                    const unsigned long long trial = P | (1ull << bit);
                    int cnt; DSA_COUNT_GE(cnt, trial);
                    if (cnt >= r) { P = trial; if (cnt == r) break; }
                }
            }
#undef DSA_COUNT_GE
            int outp = 0;
#pragma unroll 2
            for (int i0 = 0; i0 < c; i0 += 64) { const int i = i0 + lane; const unsigned long long v = pq[i < c ? i : 0]; const bool take = (i < c) && v >= P;
                const unsigned long long bal = __ballot(take); const int pos = outp + __builtin_popcountll(bal & ((1ull << lane) - 1ull));
                if (take && pos < r) selq[pos] = (unsigned short)(0xffffu - (unsigned)(v & 0xffffull));
                outp += __builtin_popcountll(bal); }
        }
    }
    __syncthreads();
    }

}

__device__ __forceinline__ void dsa_chunk(const bf16x8 (&af)[2][4], const bf16x8 (&bq)[4], f32x4 (&o)[8], float& lrow, LAS unsigned char* GI, LAS unsigned short* sel,
                                          int q, int qpos, int ch, int g, float slope2, float cq, unsigned wrA0, unsigned trA0, unsigned gwr) {
    asm volatile("" : "+v"(wrA0), "+v"(trA0));
    unsigned short kk[2][4];
#pragma unroll
    for (int rb = 0; rb < 2; ++rb) { const u32x2 v = *(const LAS u32x2*)(sel + q * 256 + 32 * ch + 16 * rb + 4 * g); kk[rb][0] = (unsigned short)(v.x & 0xffffu); kk[rb][1] = (unsigned short)(v.x >> 16); kk[rb][2] = (unsigned short)(v.y & 0xffffu); kk[rb][3] = (unsigned short)(v.y >> 16); }
#pragma unroll
    for (int j = 0; j < 8; ++j) *(LAS bf16x8*)(GI + (gwr ^ ((j & 1) ? 144u : 0u)) + 1024 * j) = af[j >> 2][j & 3];
    f32x4 sacc[2];
    { bf16x8 ar[2][4];
#pragma unroll
      for (int rb = 0; rb < 2; ++rb)
#pragma unroll
          for (int s = 0; s < 4; ++s) ar[rb][s] = *(const LAS bf16x8*)(GI + (wrA0 ^ (unsigned)(s << 6)) + 4096 * rb);
#pragma unroll
      for (int rb = 0; rb < 2; ++rb) { sacc[rb] = (f32x4){0.f, 0.f, 0.f, 0.f};
#pragma unroll
          for (int s = 0; s < 4; ++s) sacc[rb] = MFMA16(ar[rb][s], bq[s], sacc[rb]); } }
    float ps = 0.f; float pv[8];
#pragma unroll
    for (int rb = 0; rb < 2; ++rb)
#pragma unroll
        for (int i = 0; i < 4; ++i) { const unsigned key = kk[rb][i]; const bool ok = (key != 0xffffu) && ((int)key <= qpos);
            const float v = fmaf(sacc[rb][i], DSA_SCALE2, fmaf(-slope2, (float)(qpos - (int)key), cq));
            const float e = ok ? __builtin_amdgcn_exp2f(v) : 0.f; pv[4 * rb + i] = e; ps += e; }
    lrow += ps;
    u32x4 pw; pw.x = pk2(pv[0], pv[1]); pw.y = pk2(pv[2], pv[3]); pw.z = pk2(pv[4], pv[5]); pw.w = pk2(pv[6], pv[7]);
    const bf16x8 bp = __builtin_bit_cast(bf16x8, pw);
#pragma unroll
    for (int c4 = 0; c4 < 2; ++c4) {
        bf16x8 vf[4];
#pragma unroll
        for (int i = 0; i < 4; ++i) { const unsigned ta = trA0 ^ (unsigned)((4 * c4 + i) << 5);
            const s16x4 v0 = tr_read((const LAS char*)(GI + ta)); const s16x4 v1 = tr_read((const LAS char*)(GI + ta + 4096)); vf[i] = cat8(v0, v1); }
        __builtin_amdgcn_sched_barrier(0);
#pragma unroll
        for (int i = 0; i < 4; ++i) o[4 * c4 + i] = MFMA16(vf[i], bp, o[4 * c4 + i]);
        __builtin_amdgcn_sched_barrier(0);
    }
}

__device__ __forceinline__ void dsa_attend(Frame& F, int b, int qt, float kvmax) {
    int lane = F.lane; asm volatile("" : "+v"(lane));
    const int r32 = lane & 31, hi = lane >> 5, wave = F.wave;
    const int q0 = qt * 32; const size_t t0 = (size_t)b * SEQ + q0;
    LAS unsigned char* QA = F.lds;
    LAS unsigned char* GI = F.lds + DSA_GI_OFF + wave * 8192;
    LAS unsigned short* sel = (LAS unsigned short*)(F.lds + DSA_SEL_OFF);

    LAS float* QN2 = (LAS float*)(F.lds + DSA_SM_OFF + 1024);
    { const int h = wave; float qs = 0.f;
      bf16x8 bq[4];
      { const bf16_t* qp = F_DQ + ((t0 + r32) * 512 + h * 64 + hi * 8);
#pragma unroll
        for (int s = 0; s < 4; ++s) bq[s] = *(const bf16x8*)(qp + 16 * s); }
      bf16x8 wf[4][4];
#pragma unroll
      for (int cb = 0; cb < 4; ++cb) { const bf16_t* wp = F_Wuk + ((size_t)(h * 128 + cb * 32 + r32) * 64 + hi * 8);
#pragma unroll
          for (int s = 0; s < 4; ++s) wf[cb][s] = *(const bf16x8*)(wp + 16 * s); }
      __builtin_amdgcn_sched_barrier(0);
#pragma unroll
      for (int cb = 0; cb < 4; ++cb) {
          f32x16 acc;
#pragma unroll
          for (int r = 0; r < 16; ++r) acc[r] = 0.f;
#pragma unroll
          for (int s = 0; s < 4; ++s) acc = MFMA32(wf[cb][s], bq[s], acc);
#pragma unroll
          for (int r4 = 0; r4 < 4; ++r4) { u32x2 wv; wv.x = pk2(acc[4 * r4], acc[4 * r4 + 1]); wv.y = pk2(acc[4 * r4 + 2], acc[4 * r4 + 3]);
              qs += bflo(wv.x) * bflo(wv.x) + bfhi(wv.x) * bfhi(wv.x) + bflo(wv.y) * bflo(wv.y) + bfhi(wv.y) * bfhi(wv.y);
              *(LAS u32x2*)(QA + ((r32 * 8 + h) * 128 + 32 * cb + 8 * r4 + 4 * hi) * 2) = wv; }
      }
      qs += __shfl_xor(qs, 32);
      if (hi == 0) QN2[r32 * 8 + h] = qs; }
    __syncthreads();

    const int n = lane & 15, g = lane >> 4;
    const float slope2 = exp2f(-(float)((n & 7) + 1)) * LOG2E;
    const int qq = n >> 2, pp = n & 3;
    const unsigned gwr = off_c((unsigned)(lane >> 4), (unsigned)(lane & 15));
    const unsigned wrA0 = off_c(n, g), trA0 = off_c(4u * g + qq, (unsigned)(pp >> 1)) + 8u * (pp & 1);
    const bf16_t* ckvb = F_CKV + (size_t)b * SEQ * 128 + 8 * g;
    const int grow = lane >> 4, gch = lane & 15;
    const bf16_t* ckvg = F_CKV + (size_t)b * SEQ * 128 + 8 * gch;
#define DSA_GATHER(dst, q_, ch_) do { _Pragma("unroll") for (int j = 0; j < 8; ++j) { unsigned key = sel[(q_) * 256 + 32 * (ch_) + 4 * j + grow]; key = key == 0xffffu ? 0u : key; \
        dst[j >> 2][j & 3] = *(const bf16x8*)(ckvg + (size_t)key * 128); } } while (0)
    bf16x8 afA[2][4], afB[2][4];
    DSA_GATHER(afA, 4 * wave, 0);
#pragma unroll 1
    for (int qi = 0; qi < 4; ++qi) {
        const int q = 4 * wave + qi; const int qpos = q0 + q;
        bf16x8 bq[4];
#pragma unroll
        for (int s = 0; s < 4; ++s) { bf16x8 v = *(const LAS bf16x8*)(QA + ((q * 8 + (n & 7)) * 128 + 32 * s + 8 * g) * 2); if (n >= 8) v = (bf16x8){0, 0, 0, 0, 0, 0, 0, 0}; bq[s] = v; }
        float lrow = 0.f;
        f32x4 o[8];
#pragma unroll
        for (int cb = 0; cb < 8; ++cb) o[cb] = (f32x4){0.f, 0.f, 0.f, 0.f};
        float cq;
        { const u32x2 kv4 = *(const LAS u32x2*)(sel + q * 256 + 4 * lane); int km = -1;
          { const int k0 = (int)(kv4.x & 0xffffu), k1 = (int)(kv4.x >> 16), k2 = (int)(kv4.y & 0xffffu), k3 = (int)(kv4.y >> 16);
            km = (k0 != 0xffff && k0 > km) ? k0 : km; km = (k1 != 0xffff && k1 > km) ? k1 : km; km = (k2 != 0xffff && k2 > km) ? k2 : km; km = (k3 != 0xffff && k3 > km) ? k3 : km; }
#pragma unroll
          for (int o_ = 1; o_ < 64; o_ <<= 1) { const int t = __shfl_xor(km, o_); km = t > km ? t : km; }
          const float bound = sqrtf(QN2[q * 8 + (n & 7)]) * kvmax * DSA_SCALE2;
          cq = slope2 * (float)(qpos - km) - bound; }
#pragma unroll 1
        for (int ch2 = 0; ch2 < 4; ++ch2) {
            DSA_GATHER(afB, q, 2 * ch2 + 1);
            dsa_chunk(afA, bq, o, lrow, GI, sel, q, qpos, 2 * ch2, g, slope2, cq, wrA0, trA0, gwr);
            { const int nq_ = (ch2 < 3) ? q : ((qi < 3) ? q + 1 : q), nc_ = (ch2 < 3) ? 2 * ch2 + 2 : 0; DSA_GATHER(afA, nq_, nc_); }
            dsa_chunk(afB, bq, o, lrow, GI, sel, q, qpos, 2 * ch2 + 1, g, slope2, cq, wrA0, trA0, gwr);
        }
        lrow += __shfl_xor(lrow, 16); lrow += __shfl_xor(lrow, 32);
        const float rl = 1.f / lrow;
        if (n < 8) {
#pragma unroll
            for (int cb = 0; cb < 8; ++cb) { u32x2 wv; wv.x = pk2(o[cb][0] * rl, o[cb][1] * rl); wv.y = pk2(o[cb][2] * rl, o[cb][3] * rl);
                *(LAS u32x2*)(QA + ((q * 8 + n) * 128 + 16 * cb + 4 * g) * 2) = wv; }
        }
    }
#undef DSA_GATHER
    __syncthreads();

    { const int h = wave;
      bf16x8 bo[8];
#pragma unroll
      for (int s = 0; s < 8; ++s) bo[s] = *(const LAS bf16x8*)(QA + ((r32 * 8 + h) * 128 + 16 * s + 8 * hi) * 2);
      bf16x8 wo[2][8];
#pragma unroll
      for (int db = 0; db < 2; ++db) { const bf16_t* wp = F_WuvT + ((size_t)(h * 64 + db * 32 + r32) * 128 + hi * 8);
#pragma unroll
          for (int s = 0; s < 8; ++s) wo[db][s] = *(const bf16x8*)(wp + 16 * s); }
      __builtin_amdgcn_sched_barrier(0);
#pragma unroll
      for (int db = 0; db < 2; ++db) {
          f32x16 acc;
#pragma unroll
          for (int r = 0; r < 16; ++r) acc[r] = 0.f;
#pragma unroll
          for (int s = 0; s < 8; ++s) acc = MFMA32(wo[db][s], bo[s], acc);
          bf16_t* op = F_O + (t0 + r32) * DM + h * 64 + 32 * db + 4 * hi;
#pragma unroll
          for (int r4 = 0; r4 < 4; ++r4) { u32x2 wv; wv.x = pk2(acc[4 * r4], acc[4 * r4 + 1]); wv.y = pk2(acc[4 * r4 + 2], acc[4 * r4 + 3]);
              *(u32x2*)(op + 8 * r4) = wv; }
      } }
    __syncthreads();

}
__device__ __forceinline__ void dsa_unit(Frame& F, int b, int qt, float kvmax) {
    dsa_topk(F, b, qt);
    dsa_attend(F, b, qt, kvmax);
}
__device__ __forceinline__ void dsa_phase(Frame& F) {
    if (F.G != 256) return;
    const int b = F.vcu >> 5;
    float gm = fmaxf(fabsf(F_g_kv[F.lane]), fabsf(F_g_kv[F.lane + 64]));
#pragma unroll
    for (int o = 1; o < 64; o <<= 1) gm = fmaxf(gm, __shfl_xor(gm, o));
    const float kvmax = 11.313708499f * gm * 1.01f;
#pragma unroll 1
    for (;;) { const int u = wq_next(F, 2 * b + 1); if (u >= 256) break; dsa_unit(F, b, 255 - u, kvmax); }
}

constexpr int N_PHASES = 12;
__global__ void __launch_bounds__(NTHREADS, 2) fwd_kernel(Args args) {
    extern __shared__ __attribute__((aligned(16))) unsigned char lds[];
    Frame F;
    F.lds = (LAS unsigned char*)lds;
    F.MISC = (volatile LAS unsigned*)(F.lds + MISC_OFF);
    F.tid = threadIdx.x; F.lane = F.tid & 63; F.wave = __builtin_amdgcn_readfirstlane(F.tid >> 6);
    F.G = gridDim.x; { const int bx = blockIdx.x; F.vcu = (F.G % 8 == 0) ? (bx % 8) * (F.G / 8) + bx / 8 : bx; }
    F.a = &args; F.ws = args.ws; F.ctl = (unsigned*)(args.ws + WS_CTL);
    for (int u = F.tid; u < (LDS_BYTES - MISC_OFF) / 4; u += NTHREADS) ((LAS unsigned*)(F.lds + MISC_OFF))[u] = 0u;
    __syncthreads();
    XcdBarrier bar; bar.bar = (unsigned*)(F.ctl + CW_BAR); bar.x = 0; bar.st = nullptr;
    if (!MK_SPLIT) bar = xcd_barrier_post((unsigned*)(F.ctl + CW_BAR), F.MISC + 8);
    const int lo = args.ph_lo, hi = args.ph_hi;
#define IN(k) (lo <= (k) && (k) < hi)
#define RUN(k, ...) do { if (IN(k)) { __VA_ARGS__; } } while (0)
#define SEAM(k) do { if (IN(k) && (IN((k) + 1) || ((k) == 7 && IN(9)))) xcd_barrier(bar); } while (0)


    RUN(0, p0_mod(F); __syncthreads(); p0_weights(F));
    SEAM(0);
    RUN(1, modnorm_rows(F, F_x, F_g_attn, 0, 1024, F_XN));
    SEAM(1);
    RUN(2, pg8::StaticOrder S; S.init(NT, NPROJ, DM, F.G, (int)blockIdx.x); EpiProj E{F_DQ, F_FQ, F_FK, F_FV, F_DLAT, F_IQ, F_IK, F_IW}; pg8::gemm_phase<EpiProj, pg8::StaticOrder, true>(F.lds, F_XN, F_Win, DM, S, E));
    SEAM(2);
    RUN(3, ckv_rows(F); knorm_rows(F));
    SEAM(3);
    RUN(4, diff_phase(F); dsa_phase(F));
    SEAM(4);
    RUN(5, pg8::StaticOrder S; S.init(NT, DM, DM, F.G, (int)blockIdx.x); EpiX1 E{F_x, F_mod, F_out}; pg8::gemm_phase<EpiX1, pg8::StaticOrder, true>(F.lds, F_O, F_Wout, DM, S, E));
    SEAM(5);
    RUN(6, modnorm_rows(F, F_out, F_g_moe, 3072, 4096, F_XN));
    SEAM(6);
    RUN(7, pg8::StaticOrder S; S.init(NT, 256, DM, F.G, (int)blockIdx.x); EpiLogits E{F_LOG, F_b_router, F_b_group}; pg8::gemm_phase<EpiLogits, pg8::StaticOrder, false>(F.lds, F_XN, F_Wrt, DM, S, E);
        VM_WAIT(); __syncthreads(); { pg8::Unit u; for (int i = 0; S.next(i, u); ++i) route_panel(F, u.pm); });
    SEAM(7);
    RUN(9, const MoeTab tab = moe_tables(F); MoeOrder<2, true> S{tab, F.G, (int)blockIdx.x, DM, F_TOK}; EpiUp E{F_HS}; pg8::gemm_phase<EpiUp, MoeOrder<2, true>, true>(F.lds, F_XN, F_Wup, DM, S, E));
    SEAM(9);
    RUN(10, const MoeTab tab = moe_tables(F); MoeOrder<4, false> S{tab, F.G, (int)blockIdx.x, DEXP, F_TOK}; EpiDown E{F_YS, F_GL, tab.ecnt}; pg8::gemm_phase<EpiDown, MoeOrder<4, false>, true>(F.lds, F_HS, F_Wdn, DEXP, S, E));
    SEAM(10);
    RUN(11, const MoeTab tab = moe_tables(F); combine_rows(F, tab));
#undef IN
#undef SEAM
}

extern "C" void kernel_launch(void* const* d_in, const int* in_sizes, int n_in, void* d_out, int out_size, void* d_ws, size_t ws_size, hipStream_t stream) {
    static int grid = 0;
    if (grid == 0) {
        if (n_in != 24 || in_sizes[0] != NT * DM || out_size != NT * DM || ws_size < WS_END) { fprintf(stderr, "kernel_launch: unexpected problem (n_in %d, in0 %d, out %d, ws %zu)\n", n_in, n_in > 0 ? in_sizes[0] : -1, out_size, ws_size); grid = -1; return; }
        int dev = 0, cus = 0, per_cu = 0;
        if (hipGetDevice(&dev) != hipSuccess || hipDeviceGetAttribute(&cus, hipDeviceAttributeMultiprocessorCount, dev) != hipSuccess) { grid = -1; return; }
        if (hipFuncSetAttribute((const void*)fwd_kernel, hipFuncAttributeMaxDynamicSharedMemorySize, LDS_BYTES) != hipSuccess) { fprintf(stderr, "kernel_launch: hipFuncSetAttribute failed\n"); grid = -1; return; }
        if (hipOccupancyMaxActiveBlocksPerMultiprocessor(&per_cu, (const void*)fwd_kernel, NTHREADS, LDS_BYTES) != hipSuccess || per_cu < 1) { fprintf(stderr, "kernel_launch: occupancy query reports %d\n", per_cu); }
        (void)hipGetLastError();
        grid = cus;
    }
    if (grid < 0) return;
    if (hipMemsetAsync((char*)d_ws + WS_CTL, 0, CTL_ZERO_BYTES, stream) != hipSuccess) return;
    Args a{};
    for (int i = 0; i < 24; ++i) a.in[i] = (const float*)d_in[i];
    a.out = (float*)d_out; a.ws = (unsigned char*)d_ws;
#if MK_SPLIT
    for (int p = 0; p < N_PHASES; ++p) { a.ph_lo = p; a.ph_hi = p + 1; hipLaunchKernelGGL(fwd_kernel, dim3(grid), dim3(NTHREADS), LDS_BYTES, stream, a); }
#else
    a.ph_lo = 0; a.ph_hi = N_PHASES;
    hipLaunchKernelGGL(fwd_kernel, dim3(grid), dim3(NTHREADS), LDS_BYTES, stream, a);
#endif
}
```

```cpp
#include <hip/hip_runtime.h>
#include <cstdio>
#include <cstdint>

#define LAS __attribute__((address_space(3)))
#define GAS __attribute__((address_space(1)))
typedef unsigned short bf16_t;
typedef short bf16x8 __attribute__((ext_vector_type(8)));
typedef short s16x4 __attribute__((ext_vector_type(4)));
typedef float f32x2 __attribute__((ext_vector_type(2)));
typedef float f32x4 __attribute__((ext_vector_type(4)));
typedef float f32x16 __attribute__((ext_vector_type(16)));
typedef unsigned u32x2 __attribute__((ext_vector_type(2)));
typedef unsigned u32x4 __attribute__((ext_vector_type(4)));
typedef __bf16 bf16x2_t __attribute__((ext_vector_type(2)));

#ifndef MK_SPLIT
#define MK_SPLIT 0
#endif

constexpr int NB = 8, SEQ = 8192, NT = NB * SEQ, DM = 1024;
constexpr int NPROJ = 2560;
constexpr int NEXP = 32, DEXP = 256;
constexpr int PMAX = 2 * NT + NEXP * 256;
constexpr float LOG2E = 1.4426950408889634f;
constexpr float RMS_EPS = 1e-6f;
constexpr float DIFF_C2 = 0.125f * LOG2E;
constexpr float IW_SCALE = 0.5f * 0.17677669529663687f;
constexpr int NWAVES = 8, NTHREADS = 512;

constexpr size_t MiB = 1u << 20;
constexpr size_t WS_CTL = 0, CTL_ZERO_BYTES = 128 * 1024;
constexpr size_t WS_MOD = 1 * MiB;
constexpr size_t WS_KN2 = 1 * MiB + 512 * 1024;
constexpr size_t WS_WIN = 2 * MiB;
constexpr size_t WS_WOUT = 8 * MiB;
constexpr size_t WS_WRT = 10 * MiB;
constexpr size_t WS_WUK = 11 * MiB;
constexpr size_t WS_WUVT = 11 * MiB + 512 * 1024;
constexpr size_t WS_WUP = 12 * MiB;
constexpr size_t WS_WDN = 44 * MiB;
constexpr size_t WS_XN = 64 * MiB;
constexpr size_t WS_DQ = 192 * MiB, WS_FQ = 256 * MiB, WS_FK = 320 * MiB, WS_FV = 384 * MiB;
constexpr size_t WS_YS = 192 * MiB;
constexpr size_t WS_O = 464 * MiB;
constexpr size_t WS_DLAT = 592 * MiB;
constexpr size_t WS_CKV = 608 * MiB;
constexpr size_t WS_IQ = 624 * MiB;
constexpr size_t WS_IK = 640 * MiB;
constexpr size_t WS_IW = 644 * MiB;
constexpr size_t WS_LOG = 646 * MiB;
constexpr size_t WS_REID = 662 * MiB;
constexpr size_t WS_RSLOT = 663 * MiB;
constexpr size_t WS_TOK = 664 * MiB;
constexpr size_t WS_GL = 672 * MiB;
constexpr size_t WS_HS = 680 * MiB;
constexpr size_t WS_END = 752 * MiB;
static_assert(WS_YS + (size_t)PMAX * 2048 <= WS_O && WS_HS + (size_t)PMAX * 512 <= WS_END, "d_ws map");
constexpr int CW_BAR = 4096;
constexpr int CW_ECNT = 16384;
constexpr int CW_WQ = 20480;

constexpr int LDS_BYTES = 155648;
constexpr int MISC_OFF = LDS_BYTES - 512;

__device__ __forceinline__ unsigned f2bf(float f) { unsigned u = __builtin_bit_cast(unsigned, f); return (u + 0x7fffu + ((u >> 16) & 1u)) >> 16; }
__device__ __forceinline__ unsigned pk2(float lo, float hi) { f32x2 v = {lo, hi}; bf16x2_t b = __builtin_convertvector(v, bf16x2_t); return __builtin_bit_cast(unsigned, b); }
__device__ __forceinline__ float bf2f(unsigned short h) { return __builtin_bit_cast(float, (unsigned)h << 16); }
__device__ __forceinline__ float bflo(unsigned w) { return __builtin_bit_cast(float, w << 16); }
__device__ __forceinline__ float bfhi(unsigned w) { return __builtin_bit_cast(float, w & 0xffff0000u); }
__device__ __forceinline__ int crow(int r, int hi) { return (r & 3) + 8 * (r >> 2) + 4 * hi; }
__device__ __forceinline__ unsigned off_b(unsigned row, unsigned ch) { return 256u * row + 16u * (ch ^ (((row & 3u) << 2) | ((row >> 2) & 3u))); }
__device__ __forceinline__ float wave_sum(float v) {
#pragma unroll
    for (int o = 1; o < 64; o <<= 1) v += __shfl_xor(v, o);
    return v;
}
#define LDS_WAIT() asm volatile("s_waitcnt lgkmcnt(0)" ::: "memory")
#define VM_WAIT() asm volatile("s_waitcnt vmcnt(0)" ::: "memory")
#define MFMA32(a, b, c) __builtin_amdgcn_mfma_f32_32x32x16_bf16((a), (b), (c), 0, 0, 0)
#define MFMA16(a, b, c) __builtin_amdgcn_mfma_f32_16x16x32_bf16((a), (b), (c), 0, 0, 0)
__device__ __forceinline__ s16x4 tr_read(LAS const char* p) { return __builtin_bit_cast(s16x4, __builtin_amdgcn_ds_read_tr16_b64_v4i16((LAS s16x4*)p)); }
__device__ __forceinline__ bf16x8 cat8(s16x4 a, s16x4 b) { return (bf16x8){a[0], a[1], a[2], a[3], b[0], b[1], b[2], b[3]}; }

namespace pg8 {
constexpr int BM = 256, BK = 64, HALF = 128, HTB = HALF * BK * 2, STAGE_BYTES = 8 * HTB, NXCD = 8, WGM = 8;
__device__ __forceinline__ int lds_byte(int r, int c) { const int st = (r >> 4) * 2 + (c >> 5), rr = r & 15, cc = c & 31, ob = rr * 64 + cc * 2; return st * 1024 + (ob ^ (((ob >> 9) & 1) << 5)); }
__device__ __forceinline__ void stage_rc(int b, int& R, int& C) { const int st = b / 1024, sb = b % 1024, swz = sb ^ (((sb >> 9) & 1) << 5); R = (st >> 1) * 16 + swz / 64; C = (st & 1) * 32 + (swz % 64) / 2; }
__device__ __forceinline__ int perm32(int rho) { const int n = rho >> 4, i = rho & 15; return 8 * (i >> 2) + 4 * n + (i & 3); }

struct Unit { int pm, pn, a0, a1; };

struct StaticOrder {
    int nM, nN, nwg, G, c, K;
    __device__ void init(int M, int N, int K_, int G_, int c_) { nM = M / BM; nN = N / BM; nwg = nM * nN; G = G_; c = c_; K = K_; }
    __device__ bool next(int i, Unit& u) const {
        const long L = (long)i * G + c; if (L >= nwg) return false;
        int wgid = (int)L; { const int q = nwg / NXCD, r = nwg % NXCD, xcd = wgid % NXCD, off = wgid / NXCD; wgid = (xcd < r ? xcd * (q + 1) : r * (q + 1) + (xcd - r) * q) + off; }
        const int nig = WGM * nN, gid = wgid / nig, fm = gid * WGM, gsz = (nM - fm) < WGM ? (nM - fm) : WGM;
        u.pm = fm + ((wgid % nig) % gsz); u.pn = (wgid % nig) / gsz; u.a0 = 0; u.a1 = 0; return true;
    }
    __device__ __forceinline__ unsigned a_off(const Unit& u, int R) const { return (unsigned)(u.pm * BM + R) * (unsigned)(K * 2); }
};

template <class Epi, class Sched, bool ALIGN_EPI>
__device__ __forceinline__ void gemm_phase(LAS unsigned char* lds, const bf16_t* Ap, const bf16_t* Btp, const int K, const Sched& S, const Epi& E) {
    const int tid = threadIdx.x, wid = __builtin_amdgcn_readfirstlane(tid >> 6), lane = tid & 63, wr = wid >> 2, wc = wid & 3, fr = lane & 15, fq = lane >> 4;
    const int nt = K / BK;
    int RA[2], CA[2]; unsigned voffB[2];
#pragma unroll
    for (int i = 0; i < 2; ++i) { int R, C; stage_rc(tid * 16 + i * 8192, R, C); const int Rb = Epi::PERM ? ((R & ~31) + perm32(R & 31)) : R;
        RA[i] = R; CA[i] = C * 2; voffB[i] = (unsigned)(Rb * K + C) * 2u; }
    const size_t kstep = (size_t)(BK * 2);
    const size_t hstep = (size_t)HALF * K * 2;
    const size_t tstep = 2 * hstep;
    const unsigned ldsw = (unsigned)wid * 1024u;
    const int aoff = lds_byte(wr * 64 + fr, fq * 8), boff = lds_byte(wc * 32 + fr, fq * 8);
#define PG8_SA(b, h) (((b) * 2 + (h)) * HTB)
#define PG8_SB(b, h) ((4 + (b) * 2 + (h)) * HTB)
#define PG8_STAGE_B(bufoff, gbase) do { _Pragma("unroll") for (int _i = 0; _i < 2; ++_i) \
        __builtin_amdgcn_global_load_lds((const unsigned*)((const char*)(gbase) + voffB[_i]), (LAS unsigned*)(lds + (bufoff) + ldsw + _i * 8192), 16, 0, 0); } while (0)
#define PG8_STAGE_A(bufoff, offs, h, kb) do { _Pragma("unroll") for (int _i = 0; _i < 2; ++_i) \
        __builtin_amdgcn_global_load_lds((const unsigned*)((const char*)Ap + (size_t)(offs)[h][_i] + (size_t)(kb)), (LAS unsigned*)(lds + (bufoff) + ldsw + _i * 8192), 16, 0, 0); } while (0)
#define PG8_LDA(dst, b, h) do { _Pragma("unroll") for (int m = 0; m < 4; ++m) _Pragma("unroll") for (int k = 0; k < 2; ++k) dst[m][k] = *(const LAS bf16x8*)(lds + PG8_SA(b, h) + aoff + m * 2048 + k * 1024); } while (0)
#define PG8_LDB(dst, b, h) do { _Pragma("unroll") for (int n = 0; n < 2; ++n) _Pragma("unroll") for (int k = 0; k < 2; ++k) dst[n][k] = *(const LAS bf16x8*)(lds + PG8_SB(b, h) + boff + n * 2048 + k * 1024); } while (0)
#define PG8_MMA(ai, bj, At, Bt) do { __builtin_amdgcn_s_setprio(1); _Pragma("unroll") for (int m = 0; m < 4; ++m) _Pragma("unroll") for (int n = 0; n < 2; ++n) _Pragma("unroll") for (int k = 0; k < 2; ++k) \
        acc[ai][bj][m][n] = __builtin_amdgcn_mfma_f32_16x16x32_bf16(Bt[n][k], At[m][k], acc[ai][bj][m][n], 0, 0, 0); __builtin_amdgcn_s_setprio(0); } while (0)
#define PG8_WAIT_V(n) asm volatile("s_waitcnt vmcnt(" #n ")" ::: "memory")
#define PG8_WAIT_L(n) asm volatile("s_waitcnt lgkmcnt(" #n ")" ::: "memory")
#define PG8_BAR __builtin_amdgcn_s_barrier()
#define PG8_SCHED __builtin_amdgcn_sched_barrier(0)
#define PG8_OFFS(dst, u) do { _Pragma("unroll") for (int _h = 0; _h < 2; ++_h) _Pragma("unroll") for (int _i = 0; _i < 2; ++_i) dst[_h][_i] = S.a_off(u, _h * HALF + RA[_i]) + (unsigned)CA[_i]; } while (0)
    Unit cur, nxt; int ui = 0;
    if (!S.next(0, cur)) return;
    f32x4 acc[2][2][4][2];
#pragma unroll
    for (int a = 0; a < 2; ++a)
#pragma unroll
        for (int b = 0; b < 2; ++b)
#pragma unroll
            for (int m = 0; m < 4; ++m)
#pragma unroll
                for (int n = 0; n < 2; ++n) acc[a][b][m][n] = (f32x4){0.f, 0.f, 0.f, 0.f};
    bf16x8 At[4][2], B0[2][2], B1[2][2];
    unsigned offc[2][2], offn[2][2];
    PG8_OFFS(offc, cur);
    const char* cB = (const char*)Btp + (size_t)cur.pn * tstep;
    PG8_STAGE_B(PG8_SB(0, 0), cB); PG8_STAGE_B(PG8_SB(0, 1), cB + hstep); PG8_STAGE_A(PG8_SA(0, 0), offc, 0, 0); PG8_STAGE_A(PG8_SA(0, 1), offc, 1, 0);
    if (wr == 1) PG8_BAR;
    PG8_WAIT_V(2); PG8_BAR;
    PG8_STAGE_B(PG8_SB(1, 0), cB + kstep); PG8_STAGE_A(PG8_SA(1, 0), offc, 0, kstep); PG8_STAGE_B(PG8_SB(1, 1), cB + hstep + kstep);
    PG8_WAIT_V(6); PG8_BAR;
    for (;;) {
        const bool has_next = S.next(ui + 1, nxt);
        if (has_next) { PG8_OFFS(offn, nxt); }
        else {
#pragma unroll
            for (int _h = 0; _h < 2; ++_h)
#pragma unroll
                for (int _i = 0; _i < 2; ++_i) offn[_h][_i] = offc[_h][_i];
        }
        const char* nB = has_next ? (const char*)Btp + (size_t)nxt.pn * tstep : cB;
#pragma unroll 1
        for (int t = 0; t < nt; t += 2) {
            const bool last = (t == nt - 2);
            const size_t k1 = (size_t)(t + 1) * kstep;
            const size_t k2 = last ? 0 : (size_t)(t + 2) * kstep, k3 = k2 + kstep;
            unsigned o2[2][2];
#pragma unroll
            for (int _h = 0; _h < 2; ++_h)
#pragma unroll
                for (int _i = 0; _i < 2; ++_i) o2[_h][_i] = last ? offn[_h][_i] : offc[_h][_i];
            const char* b2 = last ? nB : cB + (size_t)(t + 2) * kstep; const char* b3 = b2 + kstep;
            PG8_LDB(B0, 0, 0); PG8_LDB(B1, 0, 1); PG8_SCHED; PG8_LDA(At, 0, 0); PG8_STAGE_A(PG8_SA(1, 1), offc, 1, k1);
            PG8_WAIT_V(8); PG8_WAIT_L(0); PG8_BAR; PG8_MMA(0, 0, At, B0); PG8_MMA(0, 1, At, B1); PG8_BAR; PG8_SCHED;
            PG8_LDA(At, 0, 1); PG8_STAGE_B(PG8_SB(0, 0), b2); PG8_STAGE_B(PG8_SB(0, 1), b2 + hstep); PG8_STAGE_A(PG8_SA(0, 0), o2, 0, k2);
            PG8_WAIT_V(8); PG8_WAIT_L(0); PG8_BAR; PG8_MMA(1, 0, At, B0); PG8_MMA(1, 1, At, B1); PG8_BAR; PG8_SCHED;
            PG8_LDB(B0, 1, 0); PG8_LDB(B1, 1, 1); PG8_SCHED; PG8_LDA(At, 1, 0); PG8_STAGE_A(PG8_SA(0, 1), o2, 1, k2);
            PG8_WAIT_V(8); PG8_WAIT_L(0); PG8_BAR; PG8_MMA(0, 0, At, B0); PG8_MMA(0, 1, At, B1); PG8_BAR; PG8_SCHED;
            PG8_LDA(At, 1, 1); PG8_STAGE_B(PG8_SB(1, 0), b3); PG8_STAGE_B(PG8_SB(1, 1), b3 + hstep); PG8_STAGE_A(PG8_SA(1, 0), o2, 0, k3);
            PG8_WAIT_V(8); PG8_WAIT_L(0); PG8_BAR; PG8_MMA(1, 0, At, B0); PG8_MMA(1, 1, At, B1); PG8_BAR; PG8_SCHED;
        }
        if constexpr (ALIGN_EPI) { if (wr == 0) PG8_BAR; }
        E(acc, cur, wr, wc, fr, fq);
        if (!has_next) break;
#pragma unroll
        for (int a = 0; a < 2; ++a)
#pragma unroll
            for (int b = 0; b < 2; ++b)
#pragma unroll
                for (int m = 0; m < 4; ++m)
#pragma unroll
                    for (int n = 0; n < 2; ++n) acc[a][b][m][n] = (f32x4){0.f, 0.f, 0.f, 0.f};
        cur = nxt; cB = nB; ++ui;
#pragma unroll
        for (int _h = 0; _h < 2; ++_h)
#pragma unroll
            for (int _i = 0; _i < 2; ++_i) offc[_h][_i] = offn[_h][_i];
        if constexpr (ALIGN_EPI) { if (wr == 1) PG8_BAR; }
    }
    PG8_WAIT_V(0);
    if constexpr (!ALIGN_EPI) { if (wr == 0) PG8_BAR; }
    PG8_BAR;
#undef PG8_SA
#undef PG8_SB
#undef PG8_STAGE_A
#undef PG8_STAGE_B
#undef PG8_LDA
#undef PG8_LDB
#undef PG8_MMA
#undef PG8_WAIT_V
#undef PG8_WAIT_L
#undef PG8_BAR
#undef PG8_SCHED
#undef PG8_OFFS
}
}

#define XB_TMO      128
#define XB_XCNT(j)  (256  + 64 * (j))
#define XB_XSUB(j)  (1280 + 64 * (j))
#define XB_XGEN(j)  (2304 + 64 * (j))
#define XB_TOP      3328
#define XB_TOPGEN   3392
#define XCD_BAR_WORDS 3456
#define XB_SPIN_CAP (1u << 18)
__device__ __forceinline__ unsigned xb_ld(unsigned* p)              { return __hip_atomic_load(p, __ATOMIC_RELAXED, __HIP_MEMORY_SCOPE_AGENT); }
__device__ __forceinline__ unsigned xb_add(unsigned* p, unsigned v) { return __hip_atomic_fetch_add(p, v, __ATOMIC_RELAXED, __HIP_MEMORY_SCOPE_AGENT); }
__device__ __forceinline__ unsigned xb_xcc_id() { return (unsigned)__builtin_amdgcn_s_getreg((3 << 11) | 20) & 0xFu; }
#define XB_SPIN(cond, bar) do { unsigned _sp = 0; while (cond) { __builtin_amdgcn_s_sleep(1); \
    if ((++_sp & 255u) == 0u) { if (xb_ld(&(bar)[XB_TMO])) break; if (_sp > XB_SPIN_CAP) { atomicAdd(&(bar)[XB_TMO], 1u); break; } } } } while (0)
struct XcdBarrier { unsigned* bar; unsigned x; volatile LAS unsigned* st; };
__device__ __forceinline__ XcdBarrier xcd_barrier_post(unsigned* bar, volatile LAS unsigned* st) {
    XcdBarrier b; b.bar = bar; b.x = xb_xcc_id(); b.st = st;
    if (threadIdx.x == 0) (void)xb_add(&bar[XB_XCNT(b.x)], 1u);
    return b;
}
__device__ __forceinline__ void xcd_barrier_complete(unsigned* bar, unsigned x, unsigned& nloc, unsigned& nx) {
    const unsigned G = gridDim.x * gridDim.y * gridDim.z;
    unsigned sum, cnt, mine, sp = 0u;
    for (;;) {
        sum = 0u; cnt = 0u; mine = 0u;
#pragma unroll
        for (unsigned j = 0; j < 16; ++j) { const unsigned c = xb_ld(&bar[XB_XCNT(j)]); sum += c; cnt += (c > 0u) ? 1u : 0u; mine = (j == x) ? c : mine; }
        if (sum == G) break;
        __builtin_amdgcn_s_sleep(1);
        if ((++sp & 255u) == 0u) { if (xb_ld(&bar[XB_TMO])) break; if (sp > XB_SPIN_CAP) { atomicAdd(&bar[XB_TMO], 1u); break; } }
    }
    nloc = mine > 0u ? mine : 1u; nx = cnt > 0u ? cnt : 1u;
}
__device__ __forceinline__ void xcd_barrier(const XcdBarrier& b) {
    asm volatile("s_waitcnt vmcnt(0)" ::: "memory");
    __syncthreads();
    if (threadIdx.x == 0) {
        unsigned* bar = b.bar;
        __builtin_amdgcn_s_waitcnt(0);
        unsigned nloc = b.st[0], nx = b.st[1];
        if (nloc == 0u) { xcd_barrier_complete(bar, b.x, nloc, nx); b.st[0] = nloc; b.st[1] = nx; }
        const unsigned old = xb_add(&bar[XB_XSUB(b.x)], 1u);
        const unsigned gen = old / nloc;
        if (old + 1u == (gen + 1u) * nloc) {
            __builtin_amdgcn_fence(__ATOMIC_RELEASE, "agent");
            asm volatile("s_waitcnt vmcnt(0)" ::: "memory");
            const unsigned og = xb_add(&bar[XB_TOP], 1u);
            const unsigned tg = og / nx;
            if (og + 1u == (tg + 1u) * nx) xb_add(&bar[XB_TOPGEN], 1u);
            else XB_SPIN(xb_ld(&bar[XB_TOPGEN]) == tg, bar);
            __builtin_amdgcn_fence(__ATOMIC_ACQUIRE, "agent");
            xb_add(&bar[XB_XGEN(b.x)], 1u);
            asm volatile("s_waitcnt vmcnt(0)" ::: "memory");
        } else {
            XB_SPIN(xb_ld(&bar[XB_XGEN(b.x)]) == gen, bar);
            __builtin_amdgcn_fence(__ATOMIC_ACQUIRE, "agent");
            asm volatile("s_waitcnt vmcnt(0)" ::: "memory");
        }
    }
    __syncthreads();
}

struct Args { const float* in[24]; float* out; unsigned char* ws; int ph_lo, ph_hi; };
struct Frame {
    LAS unsigned char* lds;
    volatile LAS unsigned* MISC;
    const Args* a;
    unsigned char* ws;
    unsigned* ctl;
    int tid, lane, wave, vcu, G;
};
#define FIN(i) (F.a->in[i])
#define F_x FIN(0)
#define F_c FIN(1)
#define F_w_ada FIN(2)
#define F_b_ada FIN(3)
#define F_g_attn FIN(4)
#define F_w_in FIN(5)
#define F_g_kv FIN(6)
#define F_w_uk FIN(7)
#define F_w_uv FIN(8)
#define F_lq1 FIN(9)
#define F_lk1 FIN(10)
#define F_lq2 FIN(11)
#define F_lk2 FIN(12)
#define F_g_sub FIN(13)
#define F_w_out FIN(14)
#define F_g_moe FIN(15)
#define F_w_group FIN(16)
#define F_b_group FIN(17)
#define F_w_router FIN(18)
#define F_b_router FIN(19)
#define F_w_gate FIN(20)
#define F_w_up FIN(21)
#define F_w_down FIN(22)
#define F_g_final FIN(23)
#define F_out (F.a->out)
#define F_mod ((float*)(F.ws + WS_MOD))
#define F_Win ((bf16_t*)(F.ws + WS_WIN))
#define F_Wout ((bf16_t*)(F.ws + WS_WOUT))
#define F_Wrt ((bf16_t*)(F.ws + WS_WRT))
#define F_Wuk ((bf16_t*)(F.ws + WS_WUK))
#define F_WuvT ((bf16_t*)(F.ws + WS_WUVT))
#define F_Wup ((bf16_t*)(F.ws + WS_WUP))
#define F_Wdn ((bf16_t*)(F.ws + WS_WDN))
#define F_XN ((bf16_t*)(F.ws + WS_XN))
#define F_DQ ((bf16_t*)(F.ws + WS_DQ))
#define F_FQ ((bf16_t*)(F.ws + WS_FQ))
#define F_FK ((bf16_t*)(F.ws + WS_FK))
#define F_FV ((bf16_t*)(F.ws + WS_FV))
#define F_YS ((bf16_t*)(F.ws + WS_YS))
#define F_O ((bf16_t*)(F.ws + WS_O))
#define F_DLAT ((bf16_t*)(F.ws + WS_DLAT))
#define F_CKV ((bf16_t*)(F.ws + WS_CKV))
#define F_IQ ((bf16_t*)(F.ws + WS_IQ))
#define F_IK ((bf16_t*)(F.ws + WS_IK))
#define F_HS ((bf16_t*)(F.ws + WS_HS))
#define F_IW ((float*)(F.ws + WS_IW))
#define F_LOG ((float*)(F.ws + WS_LOG))
#define F_GL ((float*)(F.ws + WS_GL))
#define F_REID ((int*)(F.ws + WS_REID))
#define F_RSLOT ((int*)(F.ws + WS_RSLOT))
#define F_TOK ((int*)(F.ws + WS_TOK))

__device__ __forceinline__ void p0_mod(Frame& F) {
    LAS float* ca = (LAS float*)(F.lds);
    LAS float* red = (LAS float*)(F.lds + 32768);
    for (int i = F.tid; i < NB * DM; i += NTHREADS) { const float v = F_c[i]; ca[i] = v / (1.f + __expf(-v)); }
    __syncthreads();
    const int kr = F.lane >> 3, c4 = F.lane & 7;
    for (int item = blockIdx.x; item < 192; item += F.G) {
        const int n0 = item * 32;
        float acc[4][8];
#pragma unroll
        for (int j = 0; j < 4; ++j)
#pragma unroll
            for (int b = 0; b < 8; ++b) acc[j][b] = 0.f;
#pragma unroll 4
        for (int it = 0; it < 16; ++it) {
            const int k = F.wave * 128 + it * 8 + kr;
            const f32x4 w = *(const f32x4*)(F_w_ada + (size_t)k * 6144 + n0 + c4 * 4);
#pragma unroll
            for (int b = 0; b < 8; ++b) { const float cv = ca[b * DM + k];
#pragma unroll
                for (int j = 0; j < 4; ++j) acc[j][b] += w[j] * cv; }
        }
#pragma unroll
        for (int j = 0; j < 4; ++j)
#pragma unroll
            for (int b = 0; b < 8; ++b) { float v = acc[j][b]; v += __shfl_xor(v, 8); v += __shfl_xor(v, 16); v += __shfl_xor(v, 32);
                if (kr == 0) red[(F.wave * 32 + c4 * 4 + j) * 8 + b] = v; }
        __syncthreads();
        if (F.tid < 256) { const int col = F.tid >> 3, b = F.tid & 7; float s = 0.f;
#pragma unroll
            for (int w = 0; w < 8; ++w) s += red[(w * 32 + col) * 8 + b];
            F_mod[b * 6144 + n0 + col] = s + F_b_ada[n0 + col]; }
        __syncthreads();
    }
}
__device__ __forceinline__ void tr_block(const float* W, int ldw, int k0, int c0, int nv, bf16_t* WT, int ldt, int r0, LAS float* scr, int lane) {
#pragma unroll
    for (int i = 0; i < 8; ++i) { const int kk = 8 * i + (lane >> 3), n4 = (lane & 7) * 4;
        const f32x4 v = (n4 < nv) ? *(const f32x4*)(W + (size_t)(k0 + kk) * ldw + c0 + n4) : (f32x4){0.f, 0.f, 0.f, 0.f};
        LAS float* d = scr + kk * 33 + n4; d[0] = v.x; d[1] = v.y; d[2] = v.z; d[3] = v.w; }
    LDS_WAIT(); asm volatile("" ::: "memory");
    const int c = lane & 7;
#pragma unroll
    for (int j = 0; j < 4; ++j) { const int n = (lane >> 3) + 8 * j; const LAS float* s = scr + (8 * c) * 33 + n;
        u32x4 o; o.x = pk2(s[0 * 33], s[1 * 33]); o.y = pk2(s[2 * 33], s[3 * 33]); o.z = pk2(s[4 * 33], s[5 * 33]); o.w = pk2(s[6 * 33], s[7 * 33]);
        *(u32x4*)(WT + (size_t)(r0 + n) * ldt + k0 + 8 * c) = o; }
    LDS_WAIT(); asm volatile("" ::: "memory");
}
__device__ __forceinline__ void p0_weights(Frame& F) {
    LAS float* scr = (LAS float*)(F.lds + F.wave * 16384);
    const int gw = F.vcu * NWAVES + F.wave, NGW = F.G * NWAVES;
    constexpr int I_IN = 16 * 80, I_OUT = 16 * 32, I_RT = 16 * 8, I_UV = 0, I_UP = 32 * 2 * 2 * 4 * 16, I_DN = 32 * 4 * 32;
    constexpr int NITEMS = I_IN + I_OUT + I_RT + I_UV + I_UP + I_DN;
    for (int it = gw; it < NITEMS; it += NGW) {
        int r = it;
        if (r < I_IN) { const int kb = r / 80, nb = r % 80, n0 = nb * 32; int c0 = 0, nv = 32;
            if (n0 < 512) c0 = n0; else if (n0 < 1024) c0 = 804 + (n0 - 512); else if (n0 < 1536) c0 = 1316 + (n0 - 1024); else if (n0 < 2048) c0 = 1828 + (n0 - 1536);
            else if (n0 < 2176) c0 = 512 + (n0 - 2048); else if (n0 < 2304) c0 = 640 + (n0 - 2176); else if (n0 == 2304) c0 = 768; else if (n0 == 2336) { c0 = 800; nv = 4; } else { c0 = 0; nv = 0; }
            tr_block(F_w_in, 2340, kb * 64, c0, nv, F_Win, DM, n0, scr, F.lane); continue; } r -= I_IN;
        if (r < I_OUT) { const int kb = r / 32, nb = r % 32; tr_block(F_w_out, DM, kb * 64, nb * 32, 32, F_Wout, DM, nb * 32, scr, F.lane); continue; } r -= I_OUT;
        if (r < I_RT) { const int kb = r / 8, nb = r % 8;
            if (nb == 0) tr_block(F_w_router, 32, kb * 64, 0, 32, F_Wrt, DM, 0, scr, F.lane);
            else if (nb == 1) tr_block(F_w_group, 4, kb * 64, 0, 4, F_Wrt, DM, 32, scr, F.lane);
            else tr_block(F_w_group, 4, kb * 64, 0, 0, F_Wrt, DM, nb * 32, scr, F.lane);
            continue; } r -= I_RT;
        if (r < I_UP) { const int kb = r & 15, nb4 = (r >> 4) & 3, gu = (r >> 6) & 1, jt = (r >> 7) & 1, e = r >> 8;
            tr_block((gu ? F_w_up : F_w_gate) + (size_t)e * 262144, 256, kb * 64, jt * 128 + nb4 * 32, 32, F_Wup, DM, e * 512 + jt * 256 + gu * 128 + nb4 * 32, scr, F.lane); continue; } r -= I_UP;
        { const int nb = r & 31, kb = (r >> 5) & 3, e = r >> 7;
            tr_block(F_w_down + (size_t)e * 262144, DM, kb * 64, nb * 32, 32, F_Wdn + (size_t)e * 262144, 256, nb * 32, scr, F.lane); }
    }
    for (int pce = blockIdx.x * NTHREADS + F.tid; pce < 2 * 8192; pce += F.G * NTHREADS) {
        const int which = pce >> 13, f = (pce >> 6) & 127, ln = pce & 63, r32 = ln & 31, hi = ln >> 5;
        float v[8];
        if (which == 0) { const int h = f >> 4, cb = (f >> 2) & 3, s_ = f & 3; const float* src = F_w_uk + (size_t)h * 8192 + (size_t)(32 * cb + r32) * 64 + 16 * s_ + 8 * hi;
#pragma unroll
            for (int j = 0; j < 8; ++j) v[j] = src[j]; }
        else { const int h = f >> 4, db = (f >> 3) & 1, s_ = f & 7; const float* src = F_w_uv + (size_t)h * 8192 + (size_t)(16 * s_ + 8 * hi) * 64 + 32 * db + r32;
#pragma unroll
            for (int j = 0; j < 8; ++j) v[j] = src[(size_t)j * 64]; }
        u32x4 o; o.x = pk2(v[0], v[1]); o.y = pk2(v[2], v[3]); o.z = pk2(v[4], v[5]); o.w = pk2(v[6], v[7]);
        *(u32x4*)((which == 0 ? F_Wuk : F_WuvT) + (size_t)(f * 64 + ln) * 8) = o;
    }
}

__device__ __forceinline__ void modnorm_rows(Frame& F, const float* src, const float* g, int shift_off, int scale_off, bf16_t* dst) {
    const int gw = F.vcu * NWAVES + F.wave, NGW = F.G * NWAVES;
    constexpr int RPW = 32;
    for (int it = gw; it < NT / RPW; it += NGW) {
        const int m0 = it * RPW, b = m0 / SEQ;
        f32x4 G[4], SH[4];
#pragma unroll
        for (int j = 0; j < 4; ++j) { const f32x4 gg = *((const f32x4*)g + F.lane + 64 * j);
            const f32x4 sc = *((const f32x4*)(F_mod + b * 6144 + scale_off) + F.lane + 64 * j); SH[j] = *((const f32x4*)(F_mod + b * 6144 + shift_off) + F.lane + 64 * j);
            G[j] = gg * (sc + 1.f); }
        f32x4 v[4];
#pragma unroll
        for (int j = 0; j < 4; ++j) v[j] = *((const f32x4*)(src + (size_t)m0 * DM) + F.lane + 64 * j);
#pragma unroll 1
        for (int r = 0; r < RPW; ++r) {
            const size_t m = (size_t)m0 + r;
            f32x4 nx[4];
            const size_t mn = (r + 1 < RPW) ? m + 1 : m;
#pragma unroll
            for (int j = 0; j < 4; ++j) nx[j] = *((const f32x4*)(src + mn * DM) + F.lane + 64 * j);
            float s = 0.f;
#pragma unroll
            for (int j = 0; j < 4; ++j) s += (v[j].x * v[j].x + v[j].y * v[j].y) + (v[j].z * v[j].z + v[j].w * v[j].w);
            const float rstd = 1.f / sqrtf(wave_sum(s) * (1.f / DM) + RMS_EPS);
            u32x2* o8 = (u32x2*)(dst + m * DM) + F.lane;
#pragma unroll
            for (int j = 0; j < 4; ++j) { const f32x4 y = (v[j] * rstd) * G[j] + SH[j]; u32x2 o; o.x = pk2(y.x, y.y); o.y = pk2(y.z, y.w); o8[64 * j] = o; }
#pragma unroll
            for (int j = 0; j < 4; ++j) v[j] = nx[j];
        }
    }
}
__device__ __forceinline__ void ckv_rows(Frame& F) {
    const int gw = F.vcu * NWAVES + F.wave, NGW = F.G * NWAVES;
    const int sub = F.lane >> 5, l32 = F.lane & 31;
    const f32x4 gg = *((const f32x4*)F_g_kv + l32);
    for (int it = gw; it < NT / 2; it += NGW) {
        const size_t row = (size_t)it * 2 + sub;
        const u32x2 w = *((const u32x2*)(F_DLAT + row * 128) + l32);
        const float a = bflo(w.x), b = bfhi(w.x), c = bflo(w.y), d = bfhi(w.y);
        float s = (a * a + b * b) + (c * c + d * d);
#pragma unroll
        for (int o = 1; o < 32; o <<= 1) s += __shfl_xor(s, o);
        const float rstd = 1.f / sqrtf(s * (1.f / 128.f) + RMS_EPS);
        u32x2 o; o.x = pk2(a * rstd * gg.x, b * rstd * gg.y); o.y = pk2(c * rstd * gg.z, d * rstd * gg.w);
        *((u32x2*)(F_CKV + row * 128) + l32) = o;
    }
}

struct EpiProj {
    static constexpr bool PERM = true;
    bf16_t *DQ, *FQ, *FK, *FV, *DLAT, *IQ, *IK; float* IW;
    __device__ __forceinline__ void operator()(const f32x4 (&acc)[2][2][4][2], const pg8::Unit& u, int wr, int wc, int fr, int fq) const {
        const int row0 = u.pm * 256 + wr * 64 + fr;
#pragma unroll
        for (int bj = 0; bj < 2; ++bj) {
            const int sg = 2 * u.pn + bj;
            if (sg < 18) {
                bf16_t* base; int ld, col; float sc = 1.f;
                if (sg < 16) { const int t = sg >> 2; base = (t == 0) ? DQ : (t == 1) ? FQ : (t == 2) ? FK : FV; ld = 512; col = (sg & 3) * 128 + wc * 32 + 8 * fq; if (t == 1) sc = DIFF_C2; }
                else { base = (sg == 16) ? DLAT : IQ; ld = 128; col = wc * 32 + 8 * fq; }
#pragma unroll
                for (int ai = 0; ai < 2; ++ai)
#pragma unroll
                    for (int m = 0; m < 4; ++m) { const f32x4 v0 = acc[ai][bj][m][0] * sc, v1 = acc[ai][bj][m][1] * sc;
                        u32x4 w; w.x = pk2(v0[0], v0[1]); w.y = pk2(v0[2], v0[3]); w.z = pk2(v1[0], v1[1]); w.w = pk2(v1[2], v1[3]);
                        *(u32x4*)(base + (size_t)(row0 + ai * 128 + m * 16) * ld + col) = w; }
            } else if (sg == 18) {
                if (wc == 0) {
#pragma unroll
                    for (int ai = 0; ai < 2; ++ai)
#pragma unroll
                        for (int m = 0; m < 4; ++m) { const f32x4 v0 = acc[ai][bj][m][0], v1 = acc[ai][bj][m][1];
                            u32x4 w; w.x = pk2(v0[0], v0[1]); w.y = pk2(v0[2], v0[3]); w.z = pk2(v1[0], v1[1]); w.w = pk2(v1[2], v1[3]);
                            const size_t t = (size_t)(row0 + ai * 128 + m * 16);
                            *(u32x4*)(IK + (t >> 5) * 1024 + ((size_t)fq * 32 + (t & 31)) * 8) = w; }
                } else if (wc == 1 && fq == 0) {
#pragma unroll
                    for (int ai = 0; ai < 2; ++ai)
#pragma unroll
                        for (int m = 0; m < 4; ++m) *(f32x4*)(IW + (size_t)(row0 + ai * 128 + m * 16) * 4) = acc[ai][bj][m][0] * IW_SCALE;
                }
            }
        }
    }
};
struct EpiX1 {
    static constexpr bool PERM = false;
    const float* x; const float* mod; float* x1;
    __device__ __forceinline__ void operator()(const f32x4 (&acc)[2][2][4][2], const pg8::Unit& u, int wr, int wc, int fr, int fq) const {
        const int row0 = u.pm * 256 + wr * 64 + fr; const int b = (u.pm * 256) / SEQ;
#pragma unroll
        for (int bj = 0; bj < 2; ++bj)
#pragma unroll
            for (int n = 0; n < 2; ++n) { const int col = u.pn * 256 + bj * 128 + wc * 32 + n * 16 + 4 * fq;
                const f32x4 gv = *(const f32x4*)(mod + b * 6144 + 2048 + col);
#pragma unroll
                for (int ai = 0; ai < 2; ++ai)
#pragma unroll
                    for (int m = 0; m < 4; ++m) { const size_t off = (size_t)(row0 + ai * 128 + m * 16) * DM + col;
                        const f32x4 xv = *(const f32x4*)(x + off); *(f32x4*)(x1 + off) = xv + gv * acc[ai][bj][m][n]; } }
    }
};
struct EpiLogits {
    static constexpr bool PERM = false;
    float* LOG; const float* b_router; const float* b_group;
    __device__ __forceinline__ void operator()(const f32x4 (&acc)[2][2][4][2], const pg8::Unit& u, int wr, int wc, int fr, int fq) const {
        if (wc > 1) return;
        const int row0 = u.pm * 256 + wr * 64 + fr;
#pragma unroll
        for (int n = 0; n < 2; ++n) { const int col = wc * 32 + n * 16 + 4 * fq;
            if (col < 36) { const f32x4 bv = (col < 32) ? *(const f32x4*)(b_router + col) : *(const f32x4*)(b_group);
#pragma unroll
                for (int ai = 0; ai < 2; ++ai)
#pragma unroll
                    for (int m = 0; m < 4; ++m) *(f32x4*)(LOG + (size_t)(row0 + ai * 128 + m * 16) * 64 + col) = acc[ai][0][m][n] + bv; } }
    }
};
__device__ __forceinline__ float silu_f(float v) { return v * __builtin_amdgcn_rcpf(1.f + __expf(-v)); }
struct EpiUp {
    static constexpr bool PERM = true;
    bf16_t* HS;
    __device__ __forceinline__ void operator()(const f32x4 (&acc)[2][2][4][2], const pg8::Unit& u, int wr, int wc, int fr, int fq) const {
        const int row0 = u.pm * 256 + wr * 64 + fr; const int col = (u.pn & 1) * 128 + wc * 32 + 8 * fq;
#pragma unroll
        for (int ai = 0; ai < 2; ++ai)
#pragma unroll
            for (int m = 0; m < 4; ++m) { const f32x4 g0 = acc[ai][0][m][0], g1 = acc[ai][0][m][1], u0 = acc[ai][1][m][0], u1 = acc[ai][1][m][1];
                u32x4 w; w.x = pk2(silu_f(g0[0]) * u0[0], silu_f(g0[1]) * u0[1]); w.y = pk2(silu_f(g0[2]) * u0[2], silu_f(g0[3]) * u0[3]);
                w.z = pk2(silu_f(g1[0]) * u1[0], silu_f(g1[1]) * u1[1]); w.w = pk2(silu_f(g1[2]) * u1[2], silu_f(g1[3]) * u1[3]);
                *(u32x4*)(HS + (size_t)(row0 + ai * 128 + m * 16) * 256 + col) = w; }
    }
};
struct EpiDown {
    static constexpr bool PERM = true;
    bf16_t* YS; const float* GL; const LAS int* ecnt;
    __device__ __forceinline__ void operator()(const f32x4 (&acc)[2][2][4][2], const pg8::Unit& u, int wr, int wc, int fr, int fq) const {
        const int r0 = wr * 64 + fr; const int e = u.a0; const int cnt = ecnt[e];
        const int colb = (u.pn & 3) * 256 + wc * 32 + 8 * fq;
#pragma unroll
        for (int ai = 0; ai < 2; ++ai)
#pragma unroll
            for (int m = 0; m < 4; ++m) { const int r = r0 + ai * 128 + m * 16; int slot = u.a1 + r; slot = slot < cnt ? slot : cnt - 1;
                const float g = GL[(size_t)e * NT + slot];
#pragma unroll
                for (int bj = 0; bj < 2; ++bj) { const f32x4 v0 = acc[ai][bj][m][0] * g, v1 = acc[ai][bj][m][1] * g;
                    u32x4 w; w.x = pk2(v0[0], v0[1]); w.y = pk2(v0[2], v0[3]); w.z = pk2(v1[0], v1[1]); w.w = pk2(v1[2], v1[3]);
                    *(u32x4*)(YS + (size_t)(u.pm * 256 + r) * DM + colb + bj * 128) = w; } }
    }
};

struct MoeTab { LAS int* ecnt; LAS int* toff; };
__device__ __forceinline__ MoeTab moe_tables(Frame& F) {
    MoeTab t; t.ecnt = (LAS int*)(F.lds + MISC_OFF + 128); t.toff = t.ecnt + 32;
    __syncthreads();
    if (F.tid < 32) t.ecnt[F.tid] = (int)__hip_atomic_load(F.ctl + CW_ECNT + 64 * F.tid, __ATOMIC_RELAXED, __HIP_MEMORY_SCOPE_AGENT);
    __syncthreads();
    if (F.tid == 0) { int s = 0; for (int e = 0; e < 32; ++e) { t.toff[e] = s; s += (t.ecnt[e] + 255) >> 8; } t.toff[32] = s; }
    __syncthreads();
    return t;
}
template <int NPN, bool GATHER> struct MoeOrder {
    MoeTab tab; int G, c, K; const int* TOK;
    __device__ bool next(int i, pg8::Unit& u) const {
        const long L = (long)i * G + c; const int total = tab.toff[32] * NPN; if (L >= total) return false;
        const int rt = (int)(L / NPN), pl = (int)(L % NPN);
        int e = 0;
#pragma unroll 1
        for (int j = 1; j < 32; ++j) e = (tab.toff[j] <= rt) ? j : e;
        u.pm = rt; u.pn = e * NPN + pl; u.a0 = e; u.a1 = (rt - tab.toff[e]) * 256; return true;
    }
    __device__ __forceinline__ unsigned a_off(const pg8::Unit& u, int R) const {
        if constexpr (GATHER) { const int cnt = tab.ecnt[u.a0]; int slot = u.a1 + R; slot = slot < cnt ? slot : cnt - 1; return (unsigned)TOK[(size_t)u.a0 * NT + slot] * (unsigned)(K * 2); }
        else return (unsigned)(u.pm * 256 + R) * (unsigned)(K * 2);
    }
};
__device__ __forceinline__ void route_panel(Frame& F, int pm) {
    LAS int* lc = (LAS int*)(F.lds);
    LAS int* lb = lc + 32;
    {
        const bool act = F.tid < 256; const int tok = pm * 256 + (act ? F.tid : 0);
        if (F.tid < 32) lc[F.tid] = 0;
        __syncthreads();
        const float* lg = F_LOG + (size_t)tok * 64;
        float gl[4];
        { const f32x4 v = *(const f32x4*)(lg + 32); gl[0] = v[0]; gl[1] = v[1]; gl[2] = v[2]; gl[3] = v[3]; }
        int gs = 0; float gm = gl[0];
#pragma unroll
        for (int j = 1; j < 4; ++j) if (gl[j] > gm) { gm = gl[j]; gs = j; }
        float den = 0.f;
#pragma unroll
        for (int j = 0; j < 4; ++j) den += __expf(gl[j] - gm);
        const float pg = 1.f / den;
        float el[8];
        { const f32x4 a = *(const f32x4*)(lg + gs * 8), b = *(const f32x4*)(lg + gs * 8 + 4); el[0] = a[0]; el[1] = a[1]; el[2] = a[2]; el[3] = a[3]; el[4] = b[0]; el[5] = b[1]; el[6] = b[2]; el[7] = b[3]; }
        int i0 = 0; float v0 = el[0];
#pragma unroll
        for (int j = 1; j < 8; ++j) if (el[j] > v0) { v0 = el[j]; i0 = j; }
        int i1 = -1; float v1 = -INFINITY;
#pragma unroll
        for (int j = 0; j < 8; ++j) if (j != i0 && (i1 < 0 || el[j] > v1)) { v1 = el[j]; i1 = j; }
        const float ex = __expf(v1 - v0); const float w0 = pg / (1.f + ex), w1 = w0 * ex;
        const int e0 = gs * 8 + i0, e1 = gs * 8 + i1;
        int r0 = 0, r1 = 0;
        if (act) { r0 = __hip_atomic_fetch_add(lc + e0, 1, __ATOMIC_RELAXED, __HIP_MEMORY_SCOPE_WORKGROUP); r1 = __hip_atomic_fetch_add(lc + e1, 1, __ATOMIC_RELAXED, __HIP_MEMORY_SCOPE_WORKGROUP); }
        __syncthreads();
        if (F.tid < 32) lb[F.tid] = (int)__hip_atomic_fetch_add(F.ctl + CW_ECNT + 64 * F.tid, (unsigned)lc[F.tid], __ATOMIC_RELAXED, __HIP_MEMORY_SCOPE_AGENT);
        __syncthreads();
        if (act) { const int s0 = lb[e0] + r0, s1 = lb[e1] + r1;
            F_TOK[(size_t)e0 * NT + s0] = tok; F_TOK[(size_t)e1 * NT + s1] = tok;
            F_GL[(size_t)e0 * NT + s0] = w0; F_GL[(size_t)e1 * NT + s1] = w1;
            *(int2*)(F_REID + (size_t)tok * 2) = make_int2(e0, e1);
            *(int2*)(F_RSLOT + (size_t)tok * 2) = make_int2(s0, s1); }
        __syncthreads();
    }
}
__device__ __forceinline__ void combine_rows(Frame& F, const MoeTab& tab) {
    const int gw = F.vcu * NWAVES + F.wave, NGW = F.G * NWAVES;
    constexpr int RPW = 32;
    for (int it = gw; it < NT / RPW; it += NGW) {
        const int m0 = it * RPW, b = m0 / SEQ;
        f32x4 GM[4], GF[4];
#pragma unroll
        for (int j = 0; j < 4; ++j) { GM[j] = *((const f32x4*)(F_mod + b * 6144 + 5120) + F.lane + 64 * j); GF[j] = *((const f32x4*)F_g_final + F.lane + 64 * j); }
        int2 ee = *(const int2*)(F_REID + (size_t)m0 * 2), ss = *(const int2*)(F_RSLOT + (size_t)m0 * 2);
        f32x4 xv[4]; u32x2 ya[4], yc[4];
        { const size_t p0 = (size_t)tab.toff[ee.x] * 256 + ss.x, p1 = (size_t)tab.toff[ee.y] * 256 + ss.y;
#pragma unroll
          for (int j = 0; j < 4; ++j) { xv[j] = *((const f32x4*)(F_out + (size_t)m0 * DM) + F.lane + 64 * j); ya[j] = *((const u32x2*)(F_YS + p0 * DM) + F.lane + 64 * j); yc[j] = *((const u32x2*)(F_YS + p1 * DM) + F.lane + 64 * j); } }
#pragma unroll 1
        for (int r = 0; r < RPW; ++r) {
            const size_t m = (size_t)m0 + r; const size_t mn = (r + 1 < RPW) ? m + 1 : m;
            const int2 een = *(const int2*)(F_REID + mn * 2), ssn = *(const int2*)(F_RSLOT + mn * 2);
            f32x4 v[4]; float s = 0.f;
#pragma unroll
            for (int j = 0; j < 4; ++j) { const u32x2 a = ya[j], c = yc[j];
                const f32x4 ys = {bflo(a.x) + bflo(c.x), bfhi(a.x) + bfhi(c.x), bflo(a.y) + bflo(c.y), bfhi(a.y) + bfhi(c.y)};
                v[j] = xv[j] + GM[j] * ys; s += (v[j].x * v[j].x + v[j].y * v[j].y) + (v[j].z * v[j].z + v[j].w * v[j].w); }
            { const size_t p0 = (size_t)tab.toff[een.x] * 256 + ssn.x, p1 = (size_t)tab.toff[een.y] * 256 + ssn.y;
#pragma unroll
              for (int j = 0; j < 4; ++j) { xv[j] = *((const f32x4*)(F_out + mn * DM) + F.lane + 64 * j); ya[j] = *((const u32x2*)(F_YS + p0 * DM) + F.lane + 64 * j); yc[j] = *((const u32x2*)(F_YS + p1 * DM) + F.lane + 64 * j); } }
            const float rstd = 1.f / sqrtf(wave_sum(s) * (1.f / DM) + RMS_EPS);
            f32x4* orow = (f32x4*)(F_out + m * DM) + F.lane;
#pragma unroll
            for (int j = 0; j < 4; ++j) orow[64 * j] = (v[j] * rstd) * GF[j];
        }
    }
}

constexpr float DIFF_SKIP_LOG2 = 150.f;
__device__ __forceinline__ int diff_tstart(int h, int qb) {
    const float slope2 = exp2f(-2.0f * (float)(h + 1)) * LOG2E;
    const float tmax = ((float)(128 * qb - 63) - DIFF_SKIP_LOG2 / slope2) * (1.f / 64.f);
    int t = (int)floorf(tmax) + 1; return t < 0 ? 0 : t;
}
__device__ __forceinline__ void knorm_rows(Frame& F) {
    const int gw = F.vcu * NWAVES + F.wave, NGW = F.G * NWAVES;
    float* KN2 = (float*)(F.ws + WS_KN2);
    for (int it = gw; it < NB * 128; it += NGW) {
        const int b = it >> 7, tile = it & 127;
        const u32x4* rp = (const u32x4*)(F_FK + ((size_t)(b * SEQ + tile * 64)) * 512) + F.lane;
        float mx = 0.f;
#pragma unroll 4
        for (int r = 0; r < 64; ++r) { const u32x4 v = rp[(size_t)r * 64];
            float s = bflo(v.x) * bflo(v.x) + bfhi(v.x) * bfhi(v.x); s += bflo(v.y) * bflo(v.y) + bfhi(v.y) * bfhi(v.y); s += bflo(v.z) * bflo(v.z) + bfhi(v.z) * bfhi(v.z); s += bflo(v.w) * bflo(v.w) + bfhi(v.w) * bfhi(v.w);
            s += __shfl_xor(s, 1); s += __shfl_xor(s, 2); s += __shfl_xor(s, 4);
            mx = fmaxf(mx, s); }
        if ((F.lane & 7) == 0) { const int hs = F.lane >> 3; KN2[((size_t)(b * 8 + hs)) * 128 + tile] = mx; }
    }
}
__device__ __forceinline__ void diff_unit(Frame& F, int b, int h, int qb, float lam, float lam_init) {
    int tid = F.tid; asm volatile("" : "+v"(tid));
    const int lane = tid & 63, wave = F.wave;
    const int r32 = lane & 31, hi = lane >> 5;
    const int st = wave >> 2, wq = wave & 3;
    const int q0 = qb * 128, nt = 2 * qb + 2;
    const int t0 = diff_tstart(h, qb);
    const float slope2 = exp2f(-2.0f * (float)(h + 1)) * LOG2E;
    LAS unsigned char* L = F.lds;
    const int qpos = q0 + 32 * wq + r32;
    bf16x8 qf[4];
    { const bf16_t* qp = F_FQ + ((size_t)(b * SEQ + qpos) * 512 + h * 128 + st * 64 + hi * 8);
#pragma unroll
      for (int s = 0; s < 4; ++s) qf[s] = *(const bf16x8*)(qp + 16 * s); }
    float mref;
    { float qs = 0.f;
#pragma unroll
      for (int s = 0; s < 4; ++s)
#pragma unroll
          for (int j = 0; j < 8; ++j) { const float v = bf2f((unsigned short)qf[s][j]); qs += v * v; }
      qs += __shfl_xor(qs, 32);
      const float* kn = (const float*)(F.ws + WS_KN2) + ((size_t)(b * 8 + h * 2 + st)) * 128;
      float km = 0.f;
      for (int t = t0 + lane; t < nt; t += 64) km = fmaxf(km, kn[t]);
#pragma unroll
      for (int o = 1; o < 64; o <<= 1) km = fmaxf(km, __shfl_xor(km, o));
      mref = sqrtf(qs) * sqrtf(km); }
    const int srow = 4 * wave + (lane >> 4), sslot = lane & 15;
    const unsigned schunk = (unsigned)sslot ^ ((((unsigned)srow & 3u) << 2) | (((unsigned)srow >> 2) & 3u));
    const size_t gk = ((size_t)(b * SEQ) * 512 + h * 128) + (size_t)srow * 512 + schunk * 8;
    const unsigned ldsb = (unsigned)(uintptr_t)(L + wave * 1024);
#define DIFF_GLDS(gp, ldsoff) do { unsigned keep_; asm volatile("s_mov_b32 %0, m0\n\ts_mov_b32 m0, %2\n\ts_nop 0\n\tglobal_load_lds_dwordx4 %1, off\n\ts_mov_b32 m0, %0" : "=&s"(keep_) : "v"(gp), "s"((unsigned)__builtin_amdgcn_readfirstlane(ldsb + (ldsoff))) : "memory"); } while (0)
#define DIFF_STAGE(t, bo) do { const size_t go = gk + (size_t)(t) * 64 * 512; \
        DIFF_GLDS(F_FK + go, (bo)); DIFF_GLDS(F_FK + go + 32 * 512, (bo) + 8192); DIFF_GLDS(F_FV + go, 49152 + (bo)); DIFF_GLDS(F_FV + go + 32 * 512, 49152 + (bo) + 8192); } while (0)
    const unsigned kswz = ((unsigned)(r32 & 3) << 2) | ((unsigned)(r32 >> 2) & 3u);
    unsigned koff[4];
#pragma unroll
    for (int s = 0; s < 4; ++s) koff[s] = 256u * r32 + 16u * (((unsigned)(8 * st + 2 * s + hi)) ^ kswz);
    const int qq = (lane & 15) >> 2, pp = lane & 3, blk = (lane >> 4) & 1;
    unsigned vo[2][4];
#pragma unroll
    for (int tt = 0; tt < 2; ++tt)
#pragma unroll
        for (int cb = 0; cb < 4; ++cb) vo[tt][cb] = 256u * (unsigned)(8 * tt + 4 * hi + qq) + 16u * (((unsigned)(4 * cb + 2 * blk + (pp >> 1))) ^ (((unsigned)qq << 2) | ((unsigned)(2 * tt + hi) & 3u))) + 8u * (unsigned)(pp & 1);
    int b0 = 0, b1 = 16384, b2 = 32768;
    DIFF_STAGE(t0, b0); DIFF_STAGE(t0 + 1, b1);
    asm volatile("s_waitcnt vmcnt(0)" ::: "memory");
    __syncthreads();
    float lrow = 0.f;
    f32x16 o[4];
#pragma unroll
    for (int cb = 0; cb < 4; ++cb)
#pragma unroll
        for (int r = 0; r < 16; ++r) o[cb][r] = 0.f;
    f32x16 p[2];
#define DIFF_KFR(dst, Kb_, kh_) do { _Pragma("unroll") for (int s = 0; s < 4; ++s) dst[s] = *(const LAS bf16x8*)((Kb_) + (kh_) * 8192 + koff[s]); } while (0)
#define DIFF_QKH(dst, kf_, t_, kh_) do { const float cbias = slope2 * (float)(64 * (t_) + 32 * (kh_) + 4 * hi - qpos) - mref; f32x16 c; \
        _Pragma("unroll") for (int r = 0; r < 16; ++r) c[r] = fmaf(slope2, (float)((r & 3) + 8 * (r >> 2)), cbias); \
        _Pragma("unroll") for (int s = 0; s < 4; ++s) c = MFMA32(kf_[s], qf[s], c); dst = c; } while (0)
#define DIFF_VFR(dst, cb_) do { _Pragma("unroll") for (int ks = 0; ks < 4; ++ks) { const s16x4 v0_ = tr_read((const LAS char*)(Vb + vo[0][cb_] + 4096 * ks)); const s16x4 v1_ = tr_read((const LAS char*)(Vb + vo[1][cb_] + 4096 * ks)); dst[ks] = cat8(v0_, v1_); } } while (0)
    { bf16x8 ka[4], kb_[4]; DIFF_KFR(ka, L + b0, 0); DIFF_KFR(kb_, L + b0, 1); DIFF_QKH(p[0], ka, t0, 0); DIFF_QKH(p[1], kb_, t0, 1); }
#pragma unroll 1
    for (int t = t0; t < nt; ++t) {
        const bool more = (t + 1 < nt);
        if (t + 2 < nt) DIFF_STAGE(t + 2, b2);
        const LAS unsigned char* Kn = L + b1;
        const LAS unsigned char* Vb = L + 49152 + b0;
        bf16x8 kfa[4], kfb[4], vfa[4], vfb[4];
        DIFF_VFR(vfa, 0);
        if (more) { DIFF_KFR(kfa, Kn, 0); DIFF_KFR(kfb, Kn, 1); }
        __builtin_amdgcn_sched_barrier(0);
        if (t >= nt - 2) {
#pragma unroll
            for (int kh = 0; kh < 2; ++kh)
#pragma unroll
                for (int r = 0; r < 16; ++r) { const int kpos = 64 * t + 32 * kh + crow(r, hi); if (kpos > qpos) p[kh][r] = -INFINITY; }
        }
        float ps = 0.f;
#pragma unroll
        for (int kh = 0; kh < 2; ++kh)
#pragma unroll
            for (int r = 0; r < 16; ++r) { const float e = __builtin_amdgcn_exp2f(p[kh][r]); p[kh][r] = e; ps += e; }
        lrow += ps;
        bf16x8 pa[4];
#pragma unroll
        for (int ks = 0; ks < 4; ++ks) { const int kh = ks >> 1, r0 = (ks & 1) * 8;
            u32x4 w; w.x = pk2(p[kh][r0], p[kh][r0 + 1]); w.y = pk2(p[kh][r0 + 2], p[kh][r0 + 3]); w.z = pk2(p[kh][r0 + 4], p[kh][r0 + 5]); w.w = pk2(p[kh][r0 + 6], p[kh][r0 + 7]);
            pa[ks] = __builtin_bit_cast(bf16x8, w); }
        __builtin_amdgcn_sched_barrier(0);
        DIFF_VFR(vfb, 1);
        __builtin_amdgcn_sched_barrier(0);
#pragma unroll
        for (int ks = 0; ks < 4; ++ks) o[0] = MFMA32(vfa[ks], pa[ks], o[0]);
        __builtin_amdgcn_sched_barrier(0);
        DIFF_VFR(vfa, 2);
        __builtin_amdgcn_sched_barrier(0);
#pragma unroll
        for (int ks = 0; ks < 4; ++ks) o[1] = MFMA32(vfb[ks], pa[ks], o[1]);
        __builtin_amdgcn_sched_barrier(0);
        DIFF_VFR(vfb, 3);
        __builtin_amdgcn_sched_barrier(0);
#pragma unroll
        for (int ks = 0; ks < 4; ++ks) o[2] = MFMA32(vfa[ks], pa[ks], o[2]);
        if (more) { DIFF_QKH(p[0], kfa, t + 1, 0); }
#pragma unroll
        for (int ks = 0; ks < 4; ++ks) o[3] = MFMA32(vfb[ks], pa[ks], o[3]);
        if (more) { DIFF_QKH(p[1], kfb, t + 1, 1); }
        asm volatile("s_waitcnt vmcnt(0)" ::: "memory");
        __syncthreads();
        { const int tb_ = b0; b0 = b1; b1 = b2; b2 = tb_; }
    }
#undef DIFF_VFR
#undef DIFF_KFR
#undef DIFF_QKH
#undef DIFF_STAGE
#undef DIFF_GLDS
    lrow += __shfl_xor(lrow, 32);
    const float rl = 1.f / lrow;
    LAS float* X = (LAS float*)L;
    if (st == 1) {
#pragma unroll
        for (int cb = 0; cb < 4; ++cb)
#pragma unroll
            for (int r = 0; r < 16; ++r) X[(wq * 64 + cb * 16 + r) * 64 + lane] = o[cb][r] * rl;
    }
    __syncthreads();
    if (st == 0) {
        float ss = 0.f;
#pragma unroll
        for (int cb = 0; cb < 4; ++cb)
#pragma unroll
            for (int r = 0; r < 16; ++r) { const float d = o[cb][r] * rl - lam * X[(wq * 64 + cb * 16 + r) * 64 + lane]; o[cb][r] = d; ss += d * d; }
        ss += __shfl_xor(ss, 32);
        const float rstd = (1.f - lam_init) / sqrtf(ss * (1.f / 128.f) + RMS_EPS);
        bf16_t* orow = F_O + (size_t)(b * SEQ + qpos) * DM + 512 + h * 128;
#pragma unroll
        for (int cb = 0; cb < 4; ++cb)
#pragma unroll
            for (int r4 = 0; r4 < 4; ++r4) { const int c0 = 32 * cb + 8 * r4 + 4 * hi;
                const f32x4 gg = *(const f32x4*)(F_g_sub + c0);
                u32x2 w; w.x = pk2(o[cb][4 * r4] * rstd * gg[0], o[cb][4 * r4 + 1] * rstd * gg[1]); w.y = pk2(o[cb][4 * r4 + 2] * rstd * gg[2], o[cb][4 * r4 + 3] * rstd * gg[3]);
                *(u32x2*)(orow + c0) = w; }
    }
    __syncthreads();
}
__device__ __forceinline__ int wq_next(Frame& F, int qid) {
    LAS int* slot = (LAS int*)(F.lds + MISC_OFF + 96);
    __syncthreads();
    if (F.tid == 0) *slot = (int)__hip_atomic_fetch_add(F.ctl + CW_WQ + 64 * qid, 1u, __ATOMIC_RELAXED, __HIP_MEMORY_SCOPE_AGENT);
    __syncthreads();
    return *slot;
}
__device__ __forceinline__ void diff_phase(Frame& F) {
    if (F.G != 256) return;
    const float lam_init = 0.8f - 0.6f * 1.0f;
    float a = F_lq1[F.lane] * F_lk1[F.lane], c = F_lq2[F.lane] * F_lk2[F.lane];
    a = wave_sum(a); c = wave_sum(c);
    const float lam = __expf(a) - __expf(c) + lam_init;
    const int b = F.vcu >> 5;
    LAS int* cost = (LAS int*)(F.lds + 147456);
    LAS int* order = cost + 256;
    __syncthreads();
    if (F.tid < 256) { const int h = F.tid >> 6, qb = F.tid & 63; cost[F.tid] = (2 * qb + 2 - diff_tstart(h, qb)) + 4; }
    __syncthreads();
    if (F.tid < 256) { const int cm = cost[F.tid]; int rank = 0;
        for (int j = 0; j < 256; ++j) { const int cj = cost[j]; rank += (cj > cm || (cj == cm && j < F.tid)) ? 1 : 0; }
        order[rank] = F.tid; }
    __syncthreads();
#pragma unroll 1
    for (;;) { const int u = wq_next(F, 2 * b); if (u >= 256) break;
        const int id = order[u];
        diff_unit(F, b, id >> 6, id & 63, lam, lam_init); }
}

constexpr int DSA_NBIN = 1024;
constexpr int DSA_POOLCAP = 16384;
constexpr int DSA_SEL_OFF = 131072, DSA_SM_OFF = 147456, DSA_GI_OFF = 65536;
constexpr float DSA_SCALE2 = 0.125f * LOG2E;

__device__ __forceinline__ unsigned off_c(unsigned row, unsigned ch) { return 256u * row + 16u * (ch ^ (((row & 7u) << 1) | ((row >> 2) & 1u))); }
__device__ __forceinline__ unsigned f32_sortable(float f) { const unsigned u = __builtin_bit_cast(unsigned, f); return u ^ ((u >> 31) ? 0xffffffffu : 0x80000000u); }

__device__ __forceinline__ float relu_raw(float v) { int i = __builtin_bit_cast(int, v); i = i > 0 ? i : 0; return __builtin_bit_cast(float, i); }
typedef short s16x2_t __attribute__((ext_vector_type(2)));
template <int PASS>
__device__ __forceinline__ void dsa_pass(Frame& F, int b, int q0, const bf16x8 (&qf)[4][2], const float (&w)[4], int lane, int grp) {
    const int r32 = lane & 31, hi = lane >> 5;
    LAS unsigned* hist = (LAS unsigned*)F.lds;
    LAS unsigned long long* pool = (LAS unsigned long long*)F.lds;
    LAS unsigned short* sel = (LAS unsigned short*)(F.lds + DSA_SEL_OFF);
    LAS int* sm = (LAS int*)(F.lds + DSA_SM_OFF);
    const int qpos = q0 + r32;
    const int nkb = (q0 >> 5) + 1;
    int tb = 0, po = 0;
    if (PASS == 2) { tb = (sm[200 + r32] == grp) ? sm[r32] : 0x7fffffff; po = sm[96 + r32]; }
    LAS unsigned* hq = hist + r32 * DSA_NBIN;
    const bf16_t* kbase = F_IK + ((size_t)(b * (SEQ / 32)) * 1024 + lane * 8);
    bf16x8 n0 = {0, 0, 0, 0, 0, 0, 0, 0}, n1 = n0;
    if (F.wave < nkb) { const bf16_t* kp = kbase + (size_t)F.wave * 1024; n0 = *(const bf16x8*)kp; n1 = *(const bf16x8*)(kp + 512); }
#pragma unroll 1
    for (int kb = F.wave; kb < nkb; kb += NWAVES) {
        const bf16x8 a0 = n0, a1 = n1;
        if (kb + NWAVES < nkb) { const bf16_t* kp = kbase + (size_t)(kb + NWAVES) * 1024; n0 = *(const bf16x8*)kp; n1 = *(const bf16x8*)(kp + 512); }
        f32x16 sc;
#pragma unroll
        for (int r = 0; r < 16; ++r) sc[r] = 0.f;
#pragma unroll
        for (int h = 0; h < 4; ++h) {
            f32x16 acc;
#pragma unroll
            for (int r = 0; r < 16; ++r) acc[r] = 0.f;
            acc = MFMA32(a0, qf[h][0], acc); acc = MFMA32(a1, qf[h][1], acc);
#pragma unroll
            for (int r = 0; r < 16; ++r) sc[r] = fmaf(relu_raw(acc[r]), w[h], sc[r]);
            if (h == 1) __builtin_amdgcn_sched_barrier(0);
        }
        const bool diag = (kb == nkb - 1);
        const int lim = diag ? qpos - 32 * kb : 64;
        int bin[16];
#pragma unroll
        for (int r = 0; r < 16; r += 2) { const int pk = __builtin_bit_cast(int, __builtin_amdgcn_cvt_pknorm_i16(sc[r], sc[r + 1])); bin[r] = (((int)((unsigned)pk << 16)) >> 22) + 512; bin[r + 1] = (pk >> 22) + 512; }
        if (PASS == 1) {
            if (!diag) {
#pragma unroll
                for (int r = 0; r < 16; ++r) (void)__hip_atomic_fetch_add(hq + bin[r], 1u, __ATOMIC_RELAXED, __HIP_MEMORY_SCOPE_WORKGROUP);
            } else {
#pragma unroll
                for (int r = 0; r < 16; ++r) (void)__hip_atomic_fetch_add(hq + bin[r], (crow(r, hi) <= lim) ? 1u : 0u, __ATOMIC_RELAXED, __HIP_MEMORY_SCOPE_WORKGROUP);
            }
        } else {
            unsigned abm = 0u, eqm = 0u;
#pragma unroll
            for (int r = 0; r < 16; ++r) { const bool ok = crow(r, hi) <= lim; abm |= (ok && bin[r] > tb) ? (1u << r) : 0u; eqm |= (ok && bin[r] == tb) ? (1u << r) : 0u; }
            const unsigned basew = __hip_atomic_fetch_add((LAS unsigned*)(sm + 128) + r32, (unsigned)__builtin_popcount(abm) | ((unsigned)__builtin_popcount(eqm) << 16), __ATOMIC_RELAXED, __HIP_MEMORY_SCOPE_WORKGROUP);
            int sa = r32 * 256 + (int)(basew & 0xffffu), sc2 = po + (int)(basew >> 16);
            const int kb0 = 32 * kb + 4 * hi;
            while (abm) { const int r = __builtin_ctz(abm); abm &= abm - 1u; sel[sa] = (unsigned short)(kb0 + (r & 3) + 8 * (r >> 2)); ++sa; }
            while (eqm) { const int r = __builtin_ctz(eqm); eqm &= eqm - 1u;
                float v = sc[0];
#pragma unroll
                for (int j = 1; j < 16; ++j) v = (r == j) ? sc[j] : v;
                if (sc2 < DSA_POOLCAP) pool[sc2] = ((unsigned long long)f32_sortable(v + 0.f) << 16) | (unsigned long long)(0xffffu - (unsigned)(kb0 + (r & 3) + 8 * (r >> 2))); ++sc2; }
        }
    }
}

template <int NR>
__device__ __forceinline__ void dsa_resolve(const LAS unsigned long long* pq, int c, int r, LAS unsigned short* selq, int lane) {
    unsigned long long kk[NR];
#pragma unroll
    for (int i = 0; i < NR; ++i) { const int idx = 64 * i + lane; const bool in = idx < c; kk[i] = in ? pq[in ? idx : 0] : 0ull; }
    unsigned long long P = 0ull;
    if (c > r) {
        constexpr unsigned long long ZMIN = 0x80000000ull << 16, ZMAX = ZMIN | 0xffffull;
        int ngt = 0, nge = 0;
#pragma unroll
        for (int i = 0; i < NR; ++i) { ngt += __builtin_popcountll(__ballot(kk[i] > ZMAX)); nge += __builtin_popcountll(__ballot(kk[i] >= ZMIN)); }
        int bit = 47;
        if (ngt < r && r <= nge) { P = ZMIN | 0xe000ull; bit = 12; }
#pragma unroll 1
        for (; bit >= 0; --bit) {
            const unsigned long long trial = P | (1ull << bit);
            int cnt = 0;
#pragma unroll
            for (int i = 0; i < NR; ++i) cnt += __builtin_popcountll(__ballot(kk[i] >= trial));
            if (cnt >= r) { P = trial; if (cnt == r) break; }
        }
    }
    int outp = 0;
#pragma unroll
    for (int i = 0; i < NR; ++i) { const bool take = (64 * i + lane < c) && kk[i] >= P; const unsigned long long bal = __ballot(take);
        const int pos = outp + __builtin_popcountll(bal & ((1ull << lane) - 1ull));
        if (take && pos < r) selq[pos] = (unsigned short)(0xffffu - (unsigned)(kk[i] & 0xffffull));
        outp += __builtin_popcountll(bal); }
}

__device__ __forceinline__ void dsa_topk(Frame& F, int b, int qt) {
    int lane = F.lane; asm volatile("" : "+v"(lane));
    const int r32 = lane & 31, hi = lane >> 5, wave = F.wave;
    const int q0 = qt * 32;
    LAS unsigned* hist = (LAS unsigned*)F.lds;
    LAS unsigned long long* pool = (LAS unsigned long long*)F.lds;
    LAS unsigned short* sel = (LAS unsigned short*)(F.lds + DSA_SEL_OFF);
    LAS int* sm = (LAS int*)(F.lds + DSA_SM_OFF);
    if (q0 + 32 <= 256) {
        for (int i = F.tid; i < 32 * 256; i += NTHREADS) { const int q = i >> 8, j = i & 255; sel[i] = (j <= q0 + q) ? (unsigned short)j : (unsigned short)0xffffu; }
        __syncthreads();
        return;
    }

    bf16x8 qf[4][2]; float w[4];
    { const bf16_t* qp = F_IQ + ((size_t)(b * SEQ + q0 + r32) * 128 + hi * 8);
#pragma unroll
      for (int h = 0; h < 4; ++h) { qf[h][0] = *(const bf16x8*)(qp + h * 32); qf[h][1] = *(const bf16x8*)(qp + h * 32 + 16);
      }
      const f32x4 wv = *(const f32x4*)(F_IW + (size_t)(b * SEQ + q0 + r32) * 4);
      const float wm = fmaxf(fmaxf(fabsf(wv[0]), fabsf(wv[1])), fmaxf(fabsf(wv[2]), fabsf(wv[3]))); int ex = 0; (void)frexpf(wm, &ex);
      const float wsc = (wm > 0.f) ? ldexpf(1.f, -ex - 6) : 1.f;
      w[0] = wv[0] * wsc; w[1] = wv[1] * wsc; w[2] = wv[2] * wsc; w[3] = wv[3] * wsc; }
    for (int i = F.tid; i < 32 * DSA_NBIN / 4; i += NTHREADS) ((LAS u32x4*)hist)[i] = (u32x4){0u, 0u, 0u, 0u};
    for (int i = F.tid; i < 32 * 256 / 8; i += NTHREADS) ((LAS u32x4*)sel)[i] = (u32x4){0xffffffffu, 0xffffffffu, 0xffffffffu, 0xffffffffu};
    if (F.tid < 65) sm[128 + F.tid] = 0;
    __syncthreads();


    dsa_pass<1>(F, b, q0, qf, w, lane, 0);
    __syncthreads();


#pragma unroll 1
    for (int qi = 0; qi < 4; ++qi) {
        const int q = 4 * wave + qi;
        unsigned hv[16];
#pragma unroll
        for (int j4 = 0; j4 < 4; ++j4) { const u32x4 v = *(const LAS u32x4*)(hist + q * DSA_NBIN + 16 * lane + 4 * j4); hv[4 * j4] = v.x; hv[4 * j4 + 1] = v.y; hv[4 * j4 + 2] = v.z; hv[4 * j4 + 3] = v.w; }
        unsigned lsum = 0;
#pragma unroll
        for (int j = 0; j < 16; ++j) lsum += hv[j];
        unsigned incl = lsum;
#pragma unroll
        for (int o = 1; o < 64; o <<= 1) { const unsigned v = __shfl_down(incl, o); incl += (lane + o < 64) ? v : 0u; }
        const unsigned excl = incl - lsum;
        if (excl < 256u && incl >= 256u) {
            unsigned run = excl; int tbin = 0; unsigned nab = 0, cc = 0; bool found = false;
#pragma unroll
            for (int j = 15; j >= 0; --j) { if (!found) { if (run + hv[j] >= 256u) { found = true; tbin = 16 * lane + j; nab = run; cc = hv[j]; } else run += hv[j]; } }
            sm[q] = tbin; sm[32 + q] = (int)nab; sm[64 + q] = (int)cc;
        }
    }
    __syncthreads();
    if (F.tid == 0) {
        int off = 0, g = 0;
        for (int q = 0; q < 32; ++q) { const int c = sm[64 + q]; if (off + c > DSA_POOLCAP) { ++g; off = 0; } sm[96 + q] = off; sm[200 + q] = g; off += c; }
        sm[232] = g + 1;
    }
    __syncthreads();
    const int ngrp = __builtin_amdgcn_readfirstlane(sm[232]);

#pragma unroll 1
    for (int grp = 0; grp < ngrp; ++grp) {
    dsa_pass<2>(F, b, q0, qf, w, lane, grp);
    __syncthreads();

#pragma unroll 1
    for (int qi = 0; qi < 4; ++qi) {
        const int q = 4 * wave + qi;
        if (__builtin_amdgcn_readfirstlane(sm[200 + q]) != grp) continue;
        const int base = __builtin_amdgcn_readfirstlane(sm[96 + q]); int c = __builtin_amdgcn_readfirstlane(sm[64 + q]);
        const int nab = __builtin_amdgcn_readfirstlane(sm[32 + q]); const int r = 256 - nab;
        if (base + c > DSA_POOLCAP) c = (DSA_POOLCAP - base) > 0 ? (DSA_POOLCAP - base) : 0;
        LAS unsigned short* selq = sel + q * 256 + nab;
        const LAS unsigned long long* pq = pool + base;
        if (c <= 64) dsa_resolve<1>(pq, c, r, selq, lane);
        else if (c <= 128) dsa_resolve<2>(pq, c, r, selq, lane);
        else if (c <= 256) dsa_resolve<4>(pq, c, r, selq, lane);
        else if (c <= 512) dsa_resolve<8>(pq, c, r, selq, lane);
        else if (c <= 1024) dsa_resolve<16>(pq, c, r, selq, lane);
        else {
#define DSA_COUNT_GE(out_, thr_) do { int cnt_ = 0; _Pragma("unroll 4") for (int i0 = 0; i0 < c; i0 += 64) { const int i = i0 + lane; const unsigned long long v_ = pq[i < c ? i : 0]; cnt_ += __builtin_popcountll(__ballot((i < c) && v_ >= (thr_))); } out_ = cnt_; } while (0)
            constexpr unsigned long long ZMIN = 0x80000000ull << 16, ZMAX = ZMIN | 0xffffull;
            unsigned long long P = 0ull;
            if (c > r) {
                int ngt, nge; DSA_COUNT_GE(ngt, ZMAX + 1ull); DSA_COUNT_GE(nge, ZMIN);
                int bit = 47;
                if (ngt < r && r <= nge) { P = ZMIN | 0xe000ull; bit = 12; }
#pragma unroll 1
                for (; bit >= 0; --bit) {
                    const unsigned long long trial = P | (1ull << bit);
                    int cnt; DSA_COUNT_GE(cnt, trial);
                    if (cnt >= r) { P = trial; if (cnt == r) break; }
                }
            }
#undef DSA_COUNT_GE
            int outp = 0;
#pragma unroll 2
            for (int i0 = 0; i0 < c; i0 += 64) { const int i = i0 + lane; const unsigned long long v = pq[i < c ? i : 0]; const bool take = (i < c) && v >= P;
                const unsigned long long bal = __ballot(take); const int pos = outp + __builtin_popcountll(bal & ((1ull << lane) - 1ull));
                if (take && pos < r) selq[pos] = (unsigned short)(0xffffu - (unsigned)(v & 0xffffull));
                outp += __builtin_popcountll(bal); }
        }
    }
    __syncthreads();
    }

}

__device__ __forceinline__ void dsa_chunk(const bf16x8 (&af)[2][4], const bf16x8 (&bq)[4], f32x4 (&o)[8], float& lrow, LAS unsigned char* GI, LAS unsigned short* sel,
                                          int q, int qpos, int ch, int g, float slope2, float cq, unsigned wrA0, unsigned trA0, unsigned gwr) {
    asm volatile("" : "+v"(wrA0), "+v"(trA0));
    unsigned short kk[2][4];
#pragma unroll
    for (int rb = 0; rb < 2; ++rb) { const u32x2 v = *(const LAS u32x2*)(sel + q * 256 + 32 * ch + 16 * rb + 4 * g); kk[rb][0] = (unsigned short)(v.x & 0xffffu); kk[rb][1] = (unsigned short)(v.x >> 16); kk[rb][2] = (unsigned short)(v.y & 0xffffu); kk[rb][3] = (unsigned short)(v.y >> 16); }
#pragma unroll
    for (int j = 0; j < 8; ++j) *(LAS bf16x8*)(GI + (gwr ^ ((j & 1) ? 144u : 0u)) + 1024 * j) = af[j >> 2][j & 3];
    f32x4 sacc[2];
    { bf16x8 ar[2][4];
#pragma unroll
      for (int rb = 0; rb < 2; ++rb)
#pragma unroll
          for (int s = 0; s < 4; ++s) ar[rb][s] = *(const LAS bf16x8*)(GI + (wrA0 ^ (unsigned)(s << 6)) + 4096 * rb);
#pragma unroll
      for (int rb = 0; rb < 2; ++rb) { sacc[rb] = (f32x4){0.f, 0.f, 0.f, 0.f};
#pragma unroll
          for (int s = 0; s < 4; ++s) sacc[rb] = MFMA16(ar[rb][s], bq[s], sacc[rb]); } }
    float ps = 0.f; float pv[8];
#pragma unroll
    for (int rb = 0; rb < 2; ++rb)
#pragma unroll
        for (int i = 0; i < 4; ++i) { const unsigned key = kk[rb][i]; const bool ok = (key != 0xffffu) && ((int)key <= qpos);
            const float v = fmaf(sacc[rb][i], DSA_SCALE2, fmaf(-slope2, (float)(qpos - (int)key), cq));
            const float e = ok ? __builtin_amdgcn_exp2f(v) : 0.f; pv[4 * rb + i] = e; ps += e; }
    lrow += ps;
    u32x4 pw; pw.x = pk2(pv[0], pv[1]); pw.y = pk2(pv[2], pv[3]); pw.z = pk2(pv[4], pv[5]); pw.w = pk2(pv[6], pv[7]);
    const bf16x8 bp = __builtin_bit_cast(bf16x8, pw);
#pragma unroll
    for (int c4 = 0; c4 < 2; ++c4) {
        bf16x8 vf[4];
#pragma unroll
        for (int i = 0; i < 4; ++i) { const unsigned ta = trA0 ^ (unsigned)((4 * c4 + i) << 5);
            const s16x4 v0 = tr_read((const LAS char*)(GI + ta)); const s16x4 v1 = tr_read((const LAS char*)(GI + ta + 4096)); vf[i] = cat8(v0, v1); }
        __builtin_amdgcn_sched_barrier(0);
#pragma unroll
        for (int i = 0; i < 4; ++i) o[4 * c4 + i] = MFMA16(vf[i], bp, o[4 * c4 + i]);
        __builtin_amdgcn_sched_barrier(0);
    }
}

__device__ __forceinline__ void dsa_attend(Frame& F, int b, int qt, float kvmax) {
    int lane = F.lane; asm volatile("" : "+v"(lane));
    const int r32 = lane & 31, hi = lane >> 5, wave = F.wave;
    const int q0 = qt * 32; const size_t t0 = (size_t)b * SEQ + q0;
    LAS unsigned char* QA = F.lds;
    LAS unsigned char* GI = F.lds + DSA_GI_OFF + wave * 8192;
    LAS unsigned short* sel = (LAS unsigned short*)(F.lds + DSA_SEL_OFF);

    LAS float* QN2 = (LAS float*)(F.lds + DSA_SM_OFF + 1024);
    { const int h = wave; float qs = 0.f;
      bf16x8 bq[4];
      { const bf16_t* qp = F_DQ + ((t0 + r32) * 512 + h * 64 + hi * 8);
#pragma unroll
        for (int s = 0; s < 4; ++s) bq[s] = *(const bf16x8*)(qp + 16 * s); }
      bf16x8 wf[4][4];
#pragma unroll
      for (int cb = 0; cb < 4; ++cb) { const bf16_t* wp = F_Wuk + ((size_t)((h * 4 + cb) * 4) * 64 + lane) * 8;
#pragma unroll
          for (int s = 0; s < 4; ++s) wf[cb][s] = *(const bf16x8*)(wp + 512 * s); }
      __builtin_amdgcn_sched_barrier(0);
#pragma unroll
      for (int cb = 0; cb < 4; ++cb) {
          f32x16 acc;
#pragma unroll
          for (int r = 0; r < 16; ++r) acc[r] = 0.f;
#pragma unroll
          for (int s = 0; s < 4; ++s) acc = MFMA32(wf[cb][s], bq[s], acc);
#pragma unroll
          for (int r4 = 0; r4 < 4; ++r4) { u32x2 wv; wv.x = pk2(acc[4 * r4], acc[4 * r4 + 1]); wv.y = pk2(acc[4 * r4 + 2], acc[4 * r4 + 3]);
              qs += bflo(wv.x) * bflo(wv.x) + bfhi(wv.x) * bfhi(wv.x) + bflo(wv.y) * bflo(wv.y) + bfhi(wv.y) * bfhi(wv.y);
              *(LAS u32x2*)(QA + ((r32 * 8 + h) * 128 + 32 * cb + 8 * r4 + 4 * hi) * 2) = wv; }
      }
      qs += __shfl_xor(qs, 32);
      if (hi == 0) QN2[r32 * 8 + h] = qs; }
    __syncthreads();

    const int n = lane & 15, g = lane >> 4;
    const float slope2 = exp2f(-(float)((n & 7) + 1)) * LOG2E;
    const int qq = n >> 2, pp = n & 3;
    const unsigned gwr = off_c((unsigned)(lane >> 4), (unsigned)(lane & 15));
    const unsigned wrA0 = off_c(n, g), trA0 = off_c(4u * g + qq, (unsigned)(pp >> 1)) + 8u * (pp & 1);
    const bf16_t* ckvb = F_CKV + (size_t)b * SEQ * 128 + 8 * g;
    const int grow = lane >> 4, gch = lane & 15;
    const bf16_t* ckvg = F_CKV + (size_t)b * SEQ * 128 + 8 * gch;
#define DSA_GATHER(dst, q_, ch_) do { _Pragma("unroll") for (int j = 0; j < 8; ++j) { unsigned key = sel[(q_) * 256 + 32 * (ch_) + 4 * j + grow]; key = key == 0xffffu ? 0u : key; \
        dst[j >> 2][j & 3] = *(const bf16x8*)(ckvg + (size_t)key * 128); } } while (0)
    bf16x8 afA[2][4], afB[2][4];
    DSA_GATHER(afA, 4 * wave, 0);
#pragma unroll 1
    for (int qi = 0; qi < 4; ++qi) {
        const int q = 4 * wave + qi; const int qpos = q0 + q;
        bf16x8 bq[4];
#pragma unroll
        for (int s = 0; s < 4; ++s) { bf16x8 v = *(const LAS bf16x8*)(QA + ((q * 8 + (n & 7)) * 128 + 32 * s + 8 * g) * 2); if (n >= 8) v = (bf16x8){0, 0, 0, 0, 0, 0, 0, 0}; bq[s] = v; }
        float lrow = 0.f;
        f32x4 o[8];
#pragma unroll
        for (int cb = 0; cb < 8; ++cb) o[cb] = (f32x4){0.f, 0.f, 0.f, 0.f};
        float cq;
        { const u32x2 kv4 = *(const LAS u32x2*)(sel + q * 256 + 4 * lane); int km = -1;
          { const int k0 = (int)(kv4.x & 0xffffu), k1 = (int)(kv4.x >> 16), k2 = (int)(kv4.y & 0xffffu), k3 = (int)(kv4.y >> 16);
            km = (k0 != 0xffff && k0 > km) ? k0 : km; km = (k1 != 0xffff && k1 > km) ? k1 : km; km = (k2 != 0xffff && k2 > km) ? k2 : km; km = (k3 != 0xffff && k3 > km) ? k3 : km; }
#pragma unroll
          for (int o_ = 1; o_ < 64; o_ <<= 1) { const int t = __shfl_xor(km, o_); km = t > km ? t : km; }
          const float bound = sqrtf(QN2[q * 8 + (n & 7)]) * kvmax * DSA_SCALE2;
          cq = slope2 * (float)(qpos - km) - bound; }
#pragma unroll 1
        for (int ch2 = 0; ch2 < 4; ++ch2) {
            DSA_GATHER(afB, q, 2 * ch2 + 1);
            dsa_chunk(afA, bq, o, lrow, GI, sel, q, qpos, 2 * ch2, g, slope2, cq, wrA0, trA0, gwr);
            { const int nq_ = (ch2 < 3) ? q : ((qi < 3) ? q + 1 : q), nc_ = (ch2 < 3) ? 2 * ch2 + 2 : 0; DSA_GATHER(afA, nq_, nc_); }
            dsa_chunk(afB, bq, o, lrow, GI, sel, q, qpos, 2 * ch2 + 1, g, slope2, cq, wrA0, trA0, gwr);
        }
        lrow += __shfl_xor(lrow, 16); lrow += __shfl_xor(lrow, 32);
        const float rl = 1.f / lrow;
        if (n < 8) {
#pragma unroll
            for (int cb = 0; cb < 8; ++cb) { u32x2 wv; wv.x = pk2(o[cb][0] * rl, o[cb][1] * rl); wv.y = pk2(o[cb][2] * rl, o[cb][3] * rl);
                *(LAS u32x2*)(QA + ((q * 8 + n) * 128 + 16 * cb + 4 * g) * 2) = wv; }
        }
    }
#undef DSA_GATHER
    __syncthreads();

    { const int h = wave;
      bf16x8 bo[8];
#pragma unroll
      for (int s = 0; s < 8; ++s) bo[s] = *(const LAS bf16x8*)(QA + ((r32 * 8 + h) * 128 + 16 * s + 8 * hi) * 2);
      bf16x8 wo[2][8];
#pragma unroll
      for (int db = 0; db < 2; ++db) { const bf16_t* wp = F_WuvT + ((size_t)((h * 2 + db) * 8) * 64 + lane) * 8;
#pragma unroll
          for (int s = 0; s < 8; ++s) wo[db][s] = *(const bf16x8*)(wp + 512 * s); }
      __builtin_amdgcn_sched_barrier(0);
#pragma unroll
      for (int db = 0; db < 2; ++db) {
          f32x16 acc;
#pragma unroll
          for (int r = 0; r < 16; ++r) acc[r] = 0.f;
#pragma unroll
          for (int s = 0; s < 8; ++s) acc = MFMA32(wo[db][s], bo[s], acc);
          bf16_t* op = F_O + (t0 + r32) * DM + h * 64 + 32 * db + 4 * hi;
#pragma unroll
          for (int r4 = 0; r4 < 4; ++r4) { u32x2 wv; wv.x = pk2(acc[4 * r4], acc[4 * r4 + 1]); wv.y = pk2(acc[4 * r4 + 2], acc[4 * r4 + 3]);
              *(u32x2*)(op + 8 * r4) = wv; }
      } }
    __syncthreads();

}
__device__ __forceinline__ void dsa_unit(Frame& F, int b, int qt, float kvmax) {
    dsa_topk(F, b, qt);
    dsa_attend(F, b, qt, kvmax);
}
__device__ __forceinline__ void dsa_phase(Frame& F) {
    if (F.G != 256) return;
    const int b = F.vcu >> 5;
    float gm = fmaxf(fabsf(F_g_kv[F.lane]), fabsf(F_g_kv[F.lane + 64]));
#pragma unroll
    for (int o = 1; o < 64; o <<= 1) gm = fmaxf(gm, __shfl_xor(gm, o));
    const float kvmax = 11.313708499f * gm * 1.01f;
#pragma unroll 1
    for (;;) { const int u = wq_next(F, 2 * b + 1); if (u >= 256) break; dsa_unit(F, b, 255 - u, kvmax); }
}

constexpr int N_PHASES = 12;
__global__ void __launch_bounds__(NTHREADS, 2) fwd_kernel(Args args) {
    extern __shared__ __attribute__((aligned(16))) unsigned char lds[];
    Frame F;
    F.lds = (LAS unsigned char*)lds;
    F.MISC = (volatile LAS unsigned*)(F.lds + MISC_OFF);
    F.tid = threadIdx.x; F.lane = F.tid & 63; F.wave = __builtin_amdgcn_readfirstlane(F.tid >> 6);
    F.G = gridDim.x; { const int bx = blockIdx.x; F.vcu = (F.G % 8 == 0) ? (bx % 8) * (F.G / 8) + bx / 8 : bx; }
    F.a = &args; F.ws = args.ws; F.ctl = (unsigned*)(args.ws + WS_CTL);
    for (int u = F.tid; u < (LDS_BYTES - MISC_OFF) / 4; u += NTHREADS) ((LAS unsigned*)(F.lds + MISC_OFF))[u] = 0u;
    __syncthreads();
    XcdBarrier bar; bar.bar = (unsigned*)(F.ctl + CW_BAR); bar.x = 0; bar.st = nullptr;
    if (!MK_SPLIT) bar = xcd_barrier_post((unsigned*)(F.ctl + CW_BAR), F.MISC + 8);
    const int lo = args.ph_lo, hi = args.ph_hi;
#define IN(k) (lo <= (k) && (k) < hi)
#define RUN(k, ...) do { if (IN(k)) { __VA_ARGS__; } } while (0)
#define SEAM(k) do { if (IN(k) && (IN((k) + 1) || ((k) == 7 && IN(9)))) xcd_barrier(bar); } while (0)


    RUN(0, p0_mod(F); __syncthreads(); p0_weights(F));
    SEAM(0);
    RUN(1, modnorm_rows(F, F_x, F_g_attn, 0, 1024, F_XN));
    SEAM(1);
    RUN(2, pg8::StaticOrder S; S.init(NT, NPROJ, DM, F.G, (int)blockIdx.x); EpiProj E{F_DQ, F_FQ, F_FK, F_FV, F_DLAT, F_IQ, F_IK, F_IW}; pg8::gemm_phase<EpiProj, pg8::StaticOrder, true>(F.lds, F_XN, F_Win, DM, S, E));
    SEAM(2);
    RUN(3, ckv_rows(F); knorm_rows(F));
    SEAM(3);
    RUN(4, diff_phase(F); dsa_phase(F));
    SEAM(4);
    RUN(5, pg8::StaticOrder S; S.init(NT, DM, DM, F.G, (int)blockIdx.x); EpiX1 E{F_x, F_mod, F_out}; pg8::gemm_phase<EpiX1, pg8::StaticOrder, true>(F.lds, F_O, F_Wout, DM, S, E));
    SEAM(5);
    RUN(6, modnorm_rows(F, F_out, F_g_moe, 3072, 4096, F_XN));
    SEAM(6);
    RUN(7, pg8::StaticOrder S; S.init(NT, 256, DM, F.G, (int)blockIdx.x); EpiLogits E{F_LOG, F_b_router, F_b_group}; pg8::gemm_phase<EpiLogits, pg8::StaticOrder, false>(F.lds, F_XN, F_Wrt, DM, S, E);
        VM_WAIT(); __syncthreads(); { pg8::Unit u; for (int i = 0; S.next(i, u); ++i) route_panel(F, u.pm); });
    SEAM(7);
    RUN(9, const MoeTab tab = moe_tables(F); MoeOrder<2, true> S{tab, F.G, (int)blockIdx.x, DM, F_TOK}; EpiUp E{F_HS}; pg8::gemm_phase<EpiUp, MoeOrder<2, true>, true>(F.lds, F_XN, F_Wup, DM, S, E));
    SEAM(9);
    RUN(10, const MoeTab tab = moe_tables(F); MoeOrder<4, false> S{tab, F.G, (int)blockIdx.x, DEXP, F_TOK}; EpiDown E{F_YS, F_GL, tab.ecnt}; pg8::gemm_phase<EpiDown, MoeOrder<4, false>, true>(F.lds, F_HS, F_Wdn, DEXP, S, E));
    SEAM(10);
    RUN(11, const MoeTab tab = moe_tables(F); combine_rows(F, tab));
#undef IN
#undef SEAM
}

extern "C" void kernel_launch(void* const* d_in, const int* in_sizes, int n_in, void* d_out, int out_size, void* d_ws, size_t ws_size, hipStream_t stream) {
    static int grid = 0;
    if (grid == 0) {
        if (n_in != 24 || in_sizes[0] != NT * DM || out_size != NT * DM || ws_size < WS_END) { fprintf(stderr, "kernel_launch: unexpected problem (n_in %d, in0 %d, out %d, ws %zu)\n", n_in, n_in > 0 ? in_sizes[0] : -1, out_size, ws_size); grid = -1; return; }
        int dev = 0, cus = 0, per_cu = 0;
        if (hipGetDevice(&dev) != hipSuccess || hipDeviceGetAttribute(&cus, hipDeviceAttributeMultiprocessorCount, dev) != hipSuccess) { grid = -1; return; }
        if (hipFuncSetAttribute((const void*)fwd_kernel, hipFuncAttributeMaxDynamicSharedMemorySize, LDS_BYTES) != hipSuccess) { fprintf(stderr, "kernel_launch: hipFuncSetAttribute failed\n"); grid = -1; return; }
        if (hipOccupancyMaxActiveBlocksPerMultiprocessor(&per_cu, (const void*)fwd_kernel, NTHREADS, LDS_BYTES) != hipSuccess || per_cu < 1) { fprintf(stderr, "kernel_launch: occupancy query reports %d\n", per_cu); }
        (void)hipGetLastError();
        grid = cus;
    }
    if (grid < 0) return;
    if (hipMemsetAsync((char*)d_ws + WS_CTL, 0, CTL_ZERO_BYTES, stream) != hipSuccess) return;
    Args a{};
    for (int i = 0; i < 24; ++i) a.in[i] = (const float*)d_in[i];
    a.out = (float*)d_out; a.ws = (unsigned char*)d_ws;
#if MK_SPLIT
    for (int p = 0; p < N_PHASES; ++p) { a.ph_lo = p; a.ph_hi = p + 1; hipLaunchKernelGGL(fwd_kernel, dim3(grid), dim3(NTHREADS), LDS_BYTES, stream, a); }
#else
    a.ph_lo = 0; a.ph_hi = N_PHASES;
    hipLaunchKernelGGL(fwd_kernel, dim3(grid), dim3(NTHREADS), LDS_BYTES, stream, a);
#endif
}
```

```cpp
#include <hip/hip_runtime.h>
#include <cstdio>
#include <cstdint>

#define LAS __attribute__((address_space(3)))
#define GAS __attribute__((address_space(1)))
typedef unsigned short bf16_t;
typedef short bf16x8 __attribute__((ext_vector_type(8)));
typedef short s16x4 __attribute__((ext_vector_type(4)));
typedef float f32x2 __attribute__((ext_vector_type(2)));
typedef float f32x4 __attribute__((ext_vector_type(4)));
typedef float f32x16 __attribute__((ext_vector_type(16)));
typedef unsigned u32x2 __attribute__((ext_vector_type(2)));
typedef unsigned u32x4 __attribute__((ext_vector_type(4)));
typedef __bf16 bf16x2_t __attribute__((ext_vector_type(2)));

#ifndef MK_SPLIT
#define MK_SPLIT 0
#endif

constexpr int NB = 8, SEQ = 8192, NT = NB * SEQ, DM = 1024;
constexpr int NPROJ = 2560;
constexpr int NEXP = 32, DEXP = 256;
constexpr int PMAX = 2 * NT + NEXP * 256;
constexpr float LOG2E = 1.4426950408889634f;
constexpr float RMS_EPS = 1e-6f;
constexpr float DIFF_C2 = 0.125f * LOG2E;
constexpr float IW_SCALE = 0.5f * 0.17677669529663687f;
constexpr int NWAVES = 8, NTHREADS = 512;

constexpr size_t MiB = 1u << 20;
constexpr size_t WS_CTL = 0, CTL_ZERO_BYTES = 128 * 1024;
constexpr size_t WS_MOD = 1 * MiB;
constexpr size_t WS_KN2 = 1 * MiB + 512 * 1024;
constexpr size_t WS_WIN = 2 * MiB;
constexpr size_t WS_WOUT = 8 * MiB;
constexpr size_t WS_WRT = 10 * MiB;
constexpr size_t WS_WUK = 11 * MiB;
constexpr size_t WS_WUVT = 11 * MiB + 512 * 1024;
constexpr size_t WS_WUP = 12 * MiB;
constexpr size_t WS_WDN = 44 * MiB;
constexpr size_t WS_XN = 64 * MiB;
constexpr size_t WS_DQ = 192 * MiB, WS_FQ = 256 * MiB, WS_FK = 320 * MiB, WS_FV = 384 * MiB;
constexpr size_t WS_YS = 192 * MiB;
constexpr size_t WS_O = 464 * MiB;
constexpr size_t WS_DLAT = 592 * MiB;
constexpr size_t WS_CKV = 608 * MiB;
constexpr size_t WS_IQ = 624 * MiB;
constexpr size_t WS_IK = 640 * MiB;
constexpr size_t WS_IW = 644 * MiB;
constexpr size_t WS_LOG = 646 * MiB;
constexpr size_t WS_REID = 662 * MiB;
constexpr size_t WS_RSLOT = 663 * MiB;
constexpr size_t WS_TOK = 664 * MiB;
constexpr size_t WS_GL = 672 * MiB;
constexpr size_t WS_HS = 680 * MiB;
constexpr size_t WS_END = 752 * MiB;
static_assert(WS_YS + (size_t)PMAX * 2048 <= WS_O && WS_HS + (size_t)PMAX * 512 <= WS_END, "d_ws map");
constexpr int CW_BAR = 4096;
constexpr int CW_ECNT = 16384;
constexpr int CW_WQ = 20480;

constexpr int LDS_BYTES = 155648;
constexpr int MISC_OFF = LDS_BYTES - 512;

__device__ __forceinline__ unsigned f2bf(float f) { unsigned u = __builtin_bit_cast(unsigned, f); return (u + 0x7fffu + ((u >> 16) & 1u)) >> 16; }
__device__ __forceinline__ unsigned pk2(float lo, float hi) { f32x2 v = {lo, hi}; bf16x2_t b = __builtin_convertvector(v, bf16x2_t); return __builtin_bit_cast(unsigned, b); }
__device__ __forceinline__ float bf2f(unsigned short h) { return __builtin_bit_cast(float, (unsigned)h << 16); }
__device__ __forceinline__ float bflo(unsigned w) { return __builtin_bit_cast(float, w << 16); }
__device__ __forceinline__ float bfhi(unsigned w) { return __builtin_bit_cast(float, w & 0xffff0000u); }
__device__ __forceinline__ int crow(int r, int hi) { return (r & 3) + 8 * (r >> 2) + 4 * hi; }
__device__ __forceinline__ unsigned off_b(unsigned row, unsigned ch) { return 256u * row + 16u * (ch ^ (((row & 3u) << 2) | ((row >> 2) & 3u))); }
__device__ __forceinline__ float wave_sum(float v) {
#pragma unroll
    for (int o = 1; o < 64; o <<= 1) v += __shfl_xor(v, o);
    return v;
}
#define LDS_WAIT() asm volatile("s_waitcnt lgkmcnt(0)" ::: "memory")
#define VM_WAIT() asm volatile("s_waitcnt vmcnt(0)" ::: "memory")
#define MFMA32(a, b, c) __builtin_amdgcn_mfma_f32_32x32x16_bf16((a), (b), (c), 0, 0, 0)
#define MFMA16(a, b, c) __builtin_amdgcn_mfma_f32_16x16x32_bf16((a), (b), (c), 0, 0, 0)
__device__ __forceinline__ s16x4 tr_read(LAS const char* p) { return __builtin_bit_cast(s16x4, __builtin_amdgcn_ds_read_tr16_b64_v4i16((LAS s16x4*)p)); }
__device__ __forceinline__ bf16x8 cat8(s16x4 a, s16x4 b) { return (bf16x8){a[0], a[1], a[2], a[3], b[0], b[1], b[2], b[3]}; }

namespace pg8 {
constexpr int BM = 256, BK = 64, HALF = 128, HTB = HALF * BK * 2, STAGE_BYTES = 8 * HTB, NXCD = 8, WGM = 8;
__device__ __forceinline__ int lds_byte(int r, int c) { const int st = (r >> 4) * 2 + (c >> 5), rr = r & 15, cc = c & 31, ob = rr * 64 + cc * 2; return st * 1024 + (ob ^ (((ob >> 9) & 1) << 5)); }
__device__ __forceinline__ void stage_rc(int b, int& R, int& C) { const int st = b / 1024, sb = b % 1024, swz = sb ^ (((sb >> 9) & 1) << 5); R = (st >> 1) * 16 + swz / 64; C = (st & 1) * 32 + (swz % 64) / 2; }
__device__ __forceinline__ int perm32(int rho) { const int n = rho >> 4, i = rho & 15; return 8 * (i >> 2) + 4 * n + (i & 3); }

struct Unit { int pm, pn, a0, a1; };

struct StaticOrder {
    int nM, nN, nwg, G, c, K;
    __device__ void init(int M, int N, int K_, int G_, int c_) { nM = M / BM; nN = N / BM; nwg = nM * nN; G = G_; c = c_; K = K_; }
    __device__ bool next(int i, Unit& u) const {
        const long L = (long)i * G + c; if (L >= nwg) return false;
        int wgid = (int)L; { const int q = nwg / NXCD, r = nwg % NXCD, xcd = wgid % NXCD, off = wgid / NXCD; wgid = (xcd < r ? xcd * (q + 1) : r * (q + 1) + (xcd - r) * q) + off; }
        const int nig = WGM * nN, gid = wgid / nig, fm = gid * WGM, gsz = (nM - fm) < WGM ? (nM - fm) : WGM;
        u.pm = fm + ((wgid % nig) % gsz); u.pn = (wgid % nig) / gsz; u.a0 = 0; u.a1 = 0; return true;
    }
    __device__ __forceinline__ unsigned a_off(const Unit& u, int R) const { return (unsigned)(u.pm * BM + R) * (unsigned)(K * 2); }
};

template <class Epi, class Sched, bool ALIGN_EPI>
__device__ __forceinline__ void gemm_phase(LAS unsigned char* lds, const bf16_t* Ap, const bf16_t* Btp, const int K, const Sched& S, const Epi& E) {
    const int tid = threadIdx.x, wid = __builtin_amdgcn_readfirstlane(tid >> 6), lane = tid & 63, wr = wid >> 2, wc = wid & 3, fr = lane & 15, fq = lane >> 4;
    const int nt = K / BK;
    int RA[2], CA[2]; unsigned voffB[2];
#pragma unroll
    for (int i = 0; i < 2; ++i) { int R, C; stage_rc(tid * 16 + i * 8192, R, C); const int Rb = Epi::PERM ? ((R & ~31) + perm32(R & 31)) : R;
        RA[i] = R; CA[i] = C * 2; voffB[i] = (unsigned)(Rb * K + C) * 2u; }
    const size_t kstep = (size_t)(BK * 2);
    const size_t hstep = (size_t)HALF * K * 2;
    const size_t tstep = 2 * hstep;
    const unsigned ldsw = (unsigned)wid * 1024u;
    const int aoff = lds_byte(wr * 64 + fr, fq * 8), boff = lds_byte(wc * 32 + fr, fq * 8);
#define PG8_SA(b, h) (((b) * 2 + (h)) * HTB)
#define PG8_SB(b, h) ((4 + (b) * 2 + (h)) * HTB)
#define PG8_STAGE_B(bufoff, gbase) do { _Pragma("unroll") for (int _i = 0; _i < 2; ++_i) \
        __builtin_amdgcn_global_load_lds((const unsigned*)((const char*)(gbase) + voffB[_i]), (LAS unsigned*)(lds + (bufoff) + ldsw + _i * 8192), 16, 0, 0); } while (0)
#define PG8_STAGE_A(bufoff, offs, h, kb) do { _Pragma("unroll") for (int _i = 0; _i < 2; ++_i) \
        __builtin_amdgcn_global_load_lds((const unsigned*)((const char*)Ap + (size_t)(offs)[h][_i] + (size_t)(kb)), (LAS unsigned*)(lds + (bufoff) + ldsw + _i * 8192), 16, 0, 0); } while (0)
#define PG8_LDA(dst, b, h) do { _Pragma("unroll") for (int m = 0; m < 4; ++m) _Pragma("unroll") for (int k = 0; k < 2; ++k) dst[m][k] = *(const LAS bf16x8*)(lds + PG8_SA(b, h) + aoff + m * 2048 + k * 1024); } while (0)
#define PG8_LDB(dst, b, h) do { _Pragma("unroll") for (int n = 0; n < 2; ++n) _Pragma("unroll") for (int k = 0; k < 2; ++k) dst[n][k] = *(const LAS bf16x8*)(lds + PG8_SB(b, h) + boff + n * 2048 + k * 1024); } while (0)
#define PG8_MMA(ai, bj, At, Bt) do { __builtin_amdgcn_s_setprio(1); _Pragma("unroll") for (int m = 0; m < 4; ++m) _Pragma("unroll") for (int n = 0; n < 2; ++n) _Pragma("unroll") for (int k = 0; k < 2; ++k) \
        acc[ai][bj][m][n] = __builtin_amdgcn_mfma_f32_16x16x32_bf16(Bt[n][k], At[m][k], acc[ai][bj][m][n], 0, 0, 0); __builtin_amdgcn_s_setprio(0); } while (0)
#define PG8_WAIT_V(n) asm volatile("s_waitcnt vmcnt(" #n ")" ::: "memory")
#define PG8_WAIT_L(n) asm volatile("s_waitcnt lgkmcnt(" #n ")" ::: "memory")
#define PG8_BAR __builtin_amdgcn_s_barrier()
#define PG8_SCHED __builtin_amdgcn_sched_barrier(0)
#define PG8_OFFS(dst, u) do { _Pragma("unroll") for (int _h = 0; _h < 2; ++_h) _Pragma("unroll") for (int _i = 0; _i < 2; ++_i) dst[_h][_i] = S.a_off(u, _h * HALF + RA[_i]) + (unsigned)CA[_i]; } while (0)
    Unit cur, nxt; int ui = 0;
    if (!S.next(0, cur)) return;
    f32x4 acc[2][2][4][2];
#pragma unroll
    for (int a = 0; a < 2; ++a)
#pragma unroll
        for (int b = 0; b < 2; ++b)
#pragma unroll
            for (int m = 0; m < 4; ++m)
#pragma unroll
                for (int n = 0; n < 2; ++n) acc[a][b][m][n] = (f32x4){0.f, 0.f, 0.f, 0.f};
    bf16x8 At[4][2], B0[2][2], B1[2][2];
    unsigned offc[2][2], offn[2][2];
    PG8_OFFS(offc, cur);
    const char* cB = (const char*)Btp + (size_t)cur.pn * tstep;
    PG8_STAGE_B(PG8_SB(0, 0), cB); PG8_STAGE_B(PG8_SB(0, 1), cB + hstep); PG8_STAGE_A(PG8_SA(0, 0), offc, 0, 0); PG8_STAGE_A(PG8_SA(0, 1), offc, 1, 0);
    if (wr == 1) PG8_BAR;
    PG8_WAIT_V(2); PG8_BAR;
    PG8_STAGE_B(PG8_SB(1, 0), cB + kstep); PG8_STAGE_A(PG8_SA(1, 0), offc, 0, kstep); PG8_STAGE_B(PG8_SB(1, 1), cB + hstep + kstep);
    PG8_WAIT_V(6); PG8_BAR;
    for (;;) {
        const bool has_next = S.next(ui + 1, nxt);
        if (has_next) { PG8_OFFS(offn, nxt); }
        else {
#pragma unroll
            for (int _h = 0; _h < 2; ++_h)
#pragma unroll
                for (int _i = 0; _i < 2; ++_i) offn[_h][_i] = offc[_h][_i];
        }
        const char* nB = has_next ? (const char*)Btp + (size_t)nxt.pn * tstep : cB;
#pragma unroll 1
        for (int t = 0; t < nt; t += 2) {
            const bool last = (t == nt - 2);
            const size_t k1 = (size_t)(t + 1) * kstep;
            const size_t k2 = last ? 0 : (size_t)(t + 2) * kstep, k3 = k2 + kstep;
            unsigned o2[2][2];
#pragma unroll
            for (int _h = 0; _h < 2; ++_h)
#pragma unroll
                for (int _i = 0; _i < 2; ++_i) o2[_h][_i] = last ? offn[_h][_i] : offc[_h][_i];
            const char* b2 = last ? nB : cB + (size_t)(t + 2) * kstep; const char* b3 = b2 + kstep;
            PG8_LDB(B0, 0, 0); PG8_LDB(B1, 0, 1); PG8_SCHED; PG8_LDA(At, 0, 0); PG8_STAGE_A(PG8_SA(1, 1), offc, 1, k1);
            PG8_WAIT_V(8); PG8_WAIT_L(0); PG8_BAR; PG8_MMA(0, 0, At, B0); PG8_MMA(0, 1, At, B1); PG8_BAR; PG8_SCHED;
            PG8_LDA(At, 0, 1); PG8_STAGE_B(PG8_SB(0, 0), b2); PG8_STAGE_B(PG8_SB(0, 1), b2 + hstep); PG8_STAGE_A(PG8_SA(0, 0), o2, 0, k2);
            PG8_WAIT_V(8); PG8_WAIT_L(0); PG8_BAR; PG8_MMA(1, 0, At, B0); PG8_MMA(1, 1, At, B1); PG8_BAR; PG8_SCHED;
            PG8_LDB(B0, 1, 0); PG8_LDB(B1, 1, 1); PG8_SCHED; PG8_LDA(At, 1, 0); PG8_STAGE_A(PG8_SA(0, 1), o2, 1, k2);
            PG8_WAIT_V(8); PG8_WAIT_L(0); PG8_BAR; PG8_MMA(0, 0, At, B0); PG8_MMA(0, 1, At, B1); PG8_BAR; PG8_SCHED;
            PG8_LDA(At, 1, 1); PG8_STAGE_B(PG8_SB(1, 0), b3); PG8_STAGE_B(PG8_SB(1, 1), b3 + hstep); PG8_STAGE_A(PG8_SA(1, 0), o2, 0, k3);
            PG8_WAIT_V(8); PG8_WAIT_L(0); PG8_BAR; PG8_MMA(1, 0, At, B0); PG8_MMA(1, 1, At, B1); PG8_BAR; PG8_SCHED;
        }
        if constexpr (ALIGN_EPI) { if (wr == 0) PG8_BAR; }
        E(acc, cur, wr, wc, fr, fq);
        if (!has_next) break;
#pragma unroll
        for (int a = 0; a < 2; ++a)
#pragma unroll
            for (int b = 0; b < 2; ++b)
#pragma unroll
                for (int m = 0; m < 4; ++m)
#pragma unroll
                    for (int n = 0; n < 2; ++n) acc[a][b][m][n] = (f32x4){0.f, 0.f, 0.f, 0.f};
        cur = nxt; cB = nB; ++ui;
#pragma unroll
        for (int _h = 0; _h < 2; ++_h)
#pragma unroll
            for (int _i = 0; _i < 2; ++_i) offc[_h][_i] = offn[_h][_i];
        if constexpr (ALIGN_EPI) { if (wr == 1) PG8_BAR; }
    }
    PG8_WAIT_V(0);
    if constexpr (!ALIGN_EPI) { if (wr == 0) PG8_BAR; }
    PG8_BAR;
#undef PG8_SA
#undef PG8_SB
#undef PG8_STAGE_A
#undef PG8_STAGE_B
#undef PG8_LDA
#undef PG8_LDB
#undef PG8_MMA
#undef PG8_WAIT_V
#undef PG8_WAIT_L
#undef PG8_BAR
#undef PG8_SCHED
#undef PG8_OFFS
}
}

#define XB_TMO      128
#define XB_XCNT(j)  (256  + 64 * (j))
#define XB_XSUB(j)  (1280 + 64 * (j))
#define XB_XGEN(j)  (2304 + 64 * (j))
#define XB_TOP      3328
#define XB_TOPGEN   3392
#define XCD_BAR_WORDS 3456
#define XB_SPIN_CAP (1u << 18)
__device__ __forceinline__ unsigned xb_ld(unsigned* p)              { return __hip_atomic_load(p, __ATOMIC_RELAXED, __HIP_MEMORY_SCOPE_AGENT); }
__device__ __forceinline__ unsigned xb_add(unsigned* p, unsigned v) { return __hip_atomic_fetch_add(p, v, __ATOMIC_RELAXED, __HIP_MEMORY_SCOPE_AGENT); }
__device__ __forceinline__ unsigned xb_xcc_id() { return (unsigned)__builtin_amdgcn_s_getreg((3 << 11) | 20) & 0xFu; }
#define XB_SPIN(cond, bar) do { unsigned _sp = 0; while (cond) { __builtin_amdgcn_s_sleep(1); \
    if ((++_sp & 255u) == 0u) { if (xb_ld(&(bar)[XB_TMO])) break; if (_sp > XB_SPIN_CAP) { atomicAdd(&(bar)[XB_TMO], 1u); break; } } } } while (0)
struct XcdBarrier { unsigned* bar; unsigned x; volatile LAS unsigned* st; };
__device__ __forceinline__ XcdBarrier xcd_barrier_post(unsigned* bar, volatile LAS unsigned* st) {
    XcdBarrier b; b.bar = bar; b.x = xb_xcc_id(); b.st = st;
    if (threadIdx.x == 0) (void)xb_add(&bar[XB_XCNT(b.x)], 1u);
    return b;
}
__device__ __forceinline__ void xcd_barrier_complete(unsigned* bar, unsigned x, unsigned& nloc, unsigned& nx) {
    const unsigned G = gridDim.x * gridDim.y * gridDim.z;
    unsigned sum, cnt, mine, sp = 0u;
    for (;;) {
        sum = 0u; cnt = 0u; mine = 0u;
#pragma unroll
        for (unsigned j = 0; j < 16; ++j) { const unsigned c = xb_ld(&bar[XB_XCNT(j)]); sum += c; cnt += (c > 0u) ? 1u : 0u; mine = (j == x) ? c : mine; }
        if (sum == G) break;
        __builtin_amdgcn_s_sleep(1);
        if ((++sp & 255u) == 0u) { if (xb_ld(&bar[XB_TMO])) break; if (sp > XB_SPIN_CAP) { atomicAdd(&bar[XB_TMO], 1u); break; } }
    }
    nloc = mine > 0u ? mine : 1u; nx = cnt > 0u ? cnt : 1u;
}
__device__ __forceinline__ void xcd_barrier(const XcdBarrier& b) {
    asm volatile("s_waitcnt vmcnt(0)" ::: "memory");
    __syncthreads();
    if (threadIdx.x == 0) {
        unsigned* bar = b.bar;
        __builtin_amdgcn_s_waitcnt(0);
        unsigned nloc = b.st[0], nx = b.st[1];
        if (nloc == 0u) { xcd_barrier_complete(bar, b.x, nloc, nx); b.st[0] = nloc; b.st[1] = nx; }
        const unsigned old = xb_add(&bar[XB_XSUB(b.x)], 1u);
        const unsigned gen = old / nloc;
        if (old + 1u == (gen + 1u) * nloc) {
            __builtin_amdgcn_fence(__ATOMIC_RELEASE, "agent");
            asm volatile("s_waitcnt vmcnt(0)" ::: "memory");
            const unsigned og = xb_add(&bar[XB_TOP], 1u);
            const unsigned tg = og / nx;
            if (og + 1u == (tg + 1u) * nx) xb_add(&bar[XB_TOPGEN], 1u);
            else XB_SPIN(xb_ld(&bar[XB_TOPGEN]) == tg, bar);
            __builtin_amdgcn_fence(__ATOMIC_ACQUIRE, "agent");
            xb_add(&bar[XB_XGEN(b.x)], 1u);
            asm volatile("s_waitcnt vmcnt(0)" ::: "memory");
        } else {
            XB_SPIN(xb_ld(&bar[XB_XGEN(b.x)]) == gen, bar);
            __builtin_amdgcn_fence(__ATOMIC_ACQUIRE, "agent");
            asm volatile("s_waitcnt vmcnt(0)" ::: "memory");
        }
    }
    __syncthreads();
}

struct Args { const float* in[24]; float* out; unsigned char* ws; int ph_lo, ph_hi; };
struct Frame {
    LAS unsigned char* lds;
    volatile LAS unsigned* MISC;
    const Args* a;
    unsigned char* ws;
    unsigned* ctl;
    int tid, lane, wave, vcu, G;
};
#define FIN(i) (F.a->in[i])
#define F_x FIN(0)
#define F_c FIN(1)
#define F_w_ada FIN(2)
#define F_b_ada FIN(3)
#define F_g_attn FIN(4)
#define F_w_in FIN(5)
#define F_g_kv FIN(6)
#define F_w_uk FIN(7)
#define F_w_uv FIN(8)
#define F_lq1 FIN(9)
#define F_lk1 FIN(10)
#define F_lq2 FIN(11)
#define F_lk2 FIN(12)
#define F_g_sub FIN(13)
#define F_w_out FIN(14)
#define F_g_moe FIN(15)
#define F_w_group FIN(16)
#define F_b_group FIN(17)
#define F_w_router FIN(18)
#define F_b_router FIN(19)
#define F_w_gate FIN(20)
#define F_w_up FIN(21)
#define F_w_down FIN(22)
#define F_g_final FIN(23)
#define F_out (F.a->out)
#define F_mod ((float*)(F.ws + WS_MOD))
#define F_Win ((bf16_t*)(F.ws + WS_WIN))
#define F_Wout ((bf16_t*)(F.ws + WS_WOUT))
#define F_Wrt ((bf16_t*)(F.ws + WS_WRT))
#define F_Wuk ((bf16_t*)(F.ws + WS_WUK))
#define F_WuvT ((bf16_t*)(F.ws + WS_WUVT))
#define F_Wup ((bf16_t*)(F.ws + WS_WUP))
#define F_Wdn ((bf16_t*)(F.ws + WS_WDN))
#define F_XN ((bf16_t*)(F.ws + WS_XN))
#define F_DQ ((bf16_t*)(F.ws + WS_DQ))
#define F_FQ ((bf16_t*)(F.ws + WS_FQ))
#define F_FK ((bf16_t*)(F.ws + WS_FK))
#define F_FV ((bf16_t*)(F.ws + WS_FV))
#define F_YS ((bf16_t*)(F.ws + WS_YS))
#define F_O ((bf16_t*)(F.ws + WS_O))
#define F_DLAT ((bf16_t*)(F.ws + WS_DLAT))
#define F_CKV ((bf16_t*)(F.ws + WS_CKV))
#define F_IQ ((bf16_t*)(F.ws + WS_IQ))
#define F_IK ((bf16_t*)(F.ws + WS_IK))
#define F_HS ((bf16_t*)(F.ws + WS_HS))
#define F_IW ((float*)(F.ws + WS_IW))
#define F_LOG ((float*)(F.ws + WS_LOG))
#define F_GL ((float*)(F.ws + WS_GL))
#define F_REID ((int*)(F.ws + WS_REID))
#define F_RSLOT ((int*)(F.ws + WS_RSLOT))
#define F_TOK ((int*)(F.ws + WS_TOK))

__device__ __forceinline__ void p0_mod(Frame& F) {
    LAS float* ca = (LAS float*)(F.lds);
    LAS float* red = (LAS float*)(F.lds + 32768);
    for (int i = F.tid; i < NB * DM; i += NTHREADS) { const float v = F_c[i]; ca[i] = v / (1.f + __expf(-v)); }
    __syncthreads();
    const int kr = F.lane >> 3, c4 = F.lane & 7;
    for (int item = blockIdx.x; item < 192; item += F.G) {
        const int n0 = item * 32;
        float acc[4][8];
#pragma unroll
        for (int j = 0; j < 4; ++j)
#pragma unroll
            for (int b = 0; b < 8; ++b) acc[j][b] = 0.f;
#pragma unroll 4
        for (int it = 0; it < 16; ++it) {
            const int k = F.wave * 128 + it * 8 + kr;
            const f32x4 w = *(const f32x4*)(F_w_ada + (size_t)k * 6144 + n0 + c4 * 4);
#pragma unroll
            for (int b = 0; b < 8; ++b) { const float cv = ca[b * DM + k];
#pragma unroll
                for (int j = 0; j < 4; ++j) acc[j][b] += w[j] * cv; }
        }
#pragma unroll
        for (int j = 0; j < 4; ++j)
#pragma unroll
            for (int b = 0; b < 8; ++b) { float v = acc[j][b]; v += __shfl_xor(v, 8); v += __shfl_xor(v, 16); v += __shfl_xor(v, 32);
                if (kr == 0) red[(F.wave * 32 + c4 * 4 + j) * 8 + b] = v; }
        __syncthreads();
        if (F.tid < 256) { const int col = F.tid >> 3, b = F.tid & 7; float s = 0.f;
#pragma unroll
            for (int w = 0; w < 8; ++w) s += red[(w * 32 + col) * 8 + b];
            F_mod[b * 6144 + n0 + col] = s + F_b_ada[n0 + col]; }
        __syncthreads();
    }
}
__device__ __forceinline__ void tr_block(const float* W, int ldw, int k0, int c0, int nv, bf16_t* WT, int ldt, int r0, LAS float* scr, int lane) {
#pragma unroll
    for (int i = 0; i < 8; ++i) { const int kk = 8 * i + (lane >> 3), n4 = (lane & 7) * 4;
        const f32x4 v = (n4 < nv) ? *(const f32x4*)(W + (size_t)(k0 + kk) * ldw + c0 + n4) : (f32x4){0.f, 0.f, 0.f, 0.f};
        LAS float* d = scr + kk * 33 + n4; d[0] = v.x; d[1] = v.y; d[2] = v.z; d[3] = v.w; }
    LDS_WAIT(); asm volatile("" ::: "memory");
    const int c = lane & 7;
#pragma unroll
    for (int j = 0; j < 4; ++j) { const int n = (lane >> 3) + 8 * j; const LAS float* s = scr + (8 * c) * 33 + n;
        u32x4 o; o.x = pk2(s[0 * 33], s[1 * 33]); o.y = pk2(s[2 * 33], s[3 * 33]); o.z = pk2(s[4 * 33], s[5 * 33]); o.w = pk2(s[6 * 33], s[7 * 33]);
        *(u32x4*)(WT + (size_t)(r0 + n) * ldt + k0 + 8 * c) = o; }
    LDS_WAIT(); asm volatile("" ::: "memory");
}
__device__ __forceinline__ void p0_weights(Frame& F) {
    LAS float* scr = (LAS float*)(F.lds + F.wave * 16384);
    const int gw = F.vcu * NWAVES + F.wave, NGW = F.G * NWAVES;
    constexpr int I_IN = 16 * 80, I_OUT = 16 * 32, I_RT = 16 * 8, I_UV = 0, I_UP = 32 * 2 * 2 * 4 * 16, I_DN = 32 * 4 * 32;
    constexpr int NITEMS = I_IN + I_OUT + I_RT + I_UV + I_UP + I_DN;
    for (int it = gw; it < NITEMS; it += NGW) {
        int r = it;
        if (r < I_IN) { const int kb = r / 80, nb = r % 80, n0 = nb * 32; int c0 = 0, nv = 32;
            if (n0 < 512) c0 = n0; else if (n0 < 1024) c0 = 804 + (n0 - 512); else if (n0 < 1536) c0 = 1316 + (n0 - 1024); else if (n0 < 2048) c0 = 1828 + (n0 - 1536);
            else if (n0 < 2176) c0 = 512 + (n0 - 2048); else if (n0 < 2304) c0 = 640 + (n0 - 2176); else if (n0 == 2304) c0 = 768; else if (n0 == 2336) { c0 = 800; nv = 4; } else { c0 = 0; nv = 0; }
            tr_block(F_w_in, 2340, kb * 64, c0, nv, F_Win, DM, n0, scr, F.lane); continue; } r -= I_IN;
        if (r < I_OUT) { const int kb = r / 32, nb = r % 32; tr_block(F_w_out, DM, kb * 64, nb * 32, 32, F_Wout, DM, nb * 32, scr, F.lane); continue; } r -= I_OUT;
        if (r < I_RT) { const int kb = r / 8, nb = r % 8;
            if (nb == 0) tr_block(F_w_router, 32, kb * 64, 0, 32, F_Wrt, DM, 0, scr, F.lane);
            else if (nb == 1) tr_block(F_w_group, 4, kb * 64, 0, 4, F_Wrt, DM, 32, scr, F.lane);
            else tr_block(F_w_group, 4, kb * 64, 0, 0, F_Wrt, DM, nb * 32, scr, F.lane);
            continue; } r -= I_RT;
        if (r < I_UP) { const int kb = r & 15, nb4 = (r >> 4) & 3, gu = (r >> 6) & 1, jt = (r >> 7) & 1, e = r >> 8;
            tr_block((gu ? F_w_up : F_w_gate) + (size_t)e * 262144, 256, kb * 64, jt * 128 + nb4 * 32, 32, F_Wup, DM, e * 512 + jt * 256 + gu * 128 + nb4 * 32, scr, F.lane); continue; } r -= I_UP;
        { const int nb = r & 31, kb = (r >> 5) & 3, e = r >> 7;
            tr_block(F_w_down + (size_t)e * 262144, DM, kb * 64, nb * 32, 32, F_Wdn + (size_t)e * 262144, 256, nb * 32, scr, F.lane); }
    }
    for (int pce = blockIdx.x * NTHREADS + F.tid; pce < 2 * 8192; pce += F.G * NTHREADS) {
        const int which = pce >> 13, f = (pce >> 6) & 127, ln = pce & 63, r32 = ln & 31, hi = ln >> 5;
        float v[8];
        if (which == 0) { const int h = f >> 4, cb = (f >> 2) & 3, s_ = f & 3; const float* src = F_w_uk + (size_t)h * 8192 + (size_t)(32 * cb + r32) * 64 + 16 * s_ + 8 * hi;
#pragma unroll
            for (int j = 0; j < 8; ++j) v[j] = src[j]; }
        else { const int h = f >> 4, db = (f >> 3) & 1, s_ = f & 7; const float* src = F_w_uv + (size_t)h * 8192 + (size_t)(16 * s_ + 8 * hi) * 64 + 32 * db + r32;
#pragma unroll
            for (int j = 0; j < 8; ++j) v[j] = src[(size_t)j * 64]; }
        u32x4 o; o.x = pk2(v[0], v[1]); o.y = pk2(v[2], v[3]); o.z = pk2(v[4], v[5]); o.w = pk2(v[6], v[7]);
        *(u32x4*)((which == 0 ? F_Wuk : F_WuvT) + (size_t)(f * 64 + ln) * 8) = o;
    }
}

__device__ __forceinline__ void modnorm_rows(Frame& F, const float* src, const float* g, int shift_off, int scale_off, bf16_t* dst) {
    const int gw = F.vcu * NWAVES + F.wave, NGW = F.G * NWAVES;
    constexpr int RPW = 32;
    for (int it = gw; it < NT / RPW; it += NGW) {
        const int m0 = it * RPW, b = m0 / SEQ;
        f32x4 G[4], SH[4];
#pragma unroll
        for (int j = 0; j < 4; ++j) { const f32x4 gg = *((const f32x4*)g + F.lane + 64 * j);
            const f32x4 sc = *((const f32x4*)(F_mod + b * 6144 + scale_off) + F.lane + 64 * j); SH[j] = *((const f32x4*)(F_mod + b * 6144 + shift_off) + F.lane + 64 * j);
            G[j] = gg * (sc + 1.f); }
        f32x4 v[4];
#pragma unroll
        for (int j = 0; j < 4; ++j) v[j] = *((const f32x4*)(src + (size_t)m0 * DM) + F.lane + 64 * j);
#pragma unroll 1
        for (int r = 0; r < RPW; ++r) {
            const size_t m = (size_t)m0 + r;
            f32x4 nx[4];
            const size_t mn = (r + 1 < RPW) ? m + 1 : m;
#pragma unroll
            for (int j = 0; j < 4; ++j) nx[j] = *((const f32x4*)(src + mn * DM) + F.lane + 64 * j);
            float s = 0.f;
#pragma unroll
            for (int j = 0; j < 4; ++j) s += (v[j].x * v[j].x + v[j].y * v[j].y) + (v[j].z * v[j].z + v[j].w * v[j].w);
            const float rstd = 1.f / sqrtf(wave_sum(s) * (1.f / DM) + RMS_EPS);
            u32x2* o8 = (u32x2*)(dst + m * DM) + F.lane;
#pragma unroll
            for (int j = 0; j < 4; ++j) { const f32x4 y = (v[j] * rstd) * G[j] + SH[j]; u32x2 o; o.x = pk2(y.x, y.y); o.y = pk2(y.z, y.w); o8[64 * j] = o; }
#pragma unroll
            for (int j = 0; j < 4; ++j) v[j] = nx[j];
        }
    }
}
__device__ __forceinline__ void ckv_rows(Frame& F) {
    const int gw = F.vcu * NWAVES + F.wave, NGW = F.G * NWAVES;
    const int sub = F.lane >> 5, l32 = F.lane & 31;
    const f32x4 gg = *((const f32x4*)F_g_kv + l32);
    for (int it = gw; it < NT / 2; it += NGW) {
        const size_t row = (size_t)it * 2 + sub;
        const u32x2 w = *((const u32x2*)(F_DLAT + row * 128) + l32);
        const float a = bflo(w.x), b = bfhi(w.x), c = bflo(w.y), d = bfhi(w.y);
        float s = (a * a + b * b) + (c * c + d * d);
#pragma unroll
        for (int o = 1; o < 32; o <<= 1) s += __shfl_xor(s, o);
        const float rstd = 1.f / sqrtf(s * (1.f / 128.f) + RMS_EPS);
        u32x2 o; o.x = pk2(a * rstd * gg.x, b * rstd * gg.y); o.y = pk2(c * rstd * gg.z, d * rstd * gg.w);
        *((u32x2*)(F_CKV + row * 128) + l32) = o;
    }
}

__device__ __forceinline__ void patch_store16(LAS unsigned char* P, int fr, int fq, u32x4 w, bf16_t* seg0, int ld) {
    *(LAS u32x4*)(P + fr * 80 + fq * 16) = w;
    const int lane = fr + 16 * fq, r = lane >> 2, c = lane & 3;
    const u32x4 v = *(const LAS u32x4*)(P + r * 80 + c * 16);
    *(u32x4*)(seg0 + (size_t)r * ld + c * 8) = v;
}
struct EpiProj {
    static constexpr bool PERM = true;
    bf16_t *DQ, *FQ, *FK, *FV, *DLAT, *IQ, *IK; float* IW; LAS unsigned char* patch;
    __device__ __forceinline__ void operator()(const f32x4 (&acc)[2][2][4][2], const pg8::Unit& u, int wr, int wc, int fr, int fq) const {
        const int row0 = u.pm * 256 + wr * 64 + fr; LAS unsigned char* P = patch + (wr * 4 + wc) * 2560;
#pragma unroll
        for (int bj = 0; bj < 2; ++bj) {
            const int sg = 2 * u.pn + bj;
            if (sg < 18) {
                bf16_t* base; int ld, col; float sc = 1.f;
                if (sg < 16) { const int t = sg >> 2; base = (t == 0) ? DQ : (t == 1) ? FQ : (t == 2) ? FK : FV; ld = 512; col = (sg & 3) * 128 + wc * 32 + 8 * fq; if (t == 1) sc = DIFF_C2; }
                else { base = (sg == 16) ? DLAT : IQ; ld = 128; col = wc * 32 + 8 * fq; }
#pragma unroll
                for (int ai = 0; ai < 2; ++ai)
#pragma unroll
                    for (int m = 0; m < 4; ++m) { const f32x4 v0 = acc[ai][bj][m][0] * sc, v1 = acc[ai][bj][m][1] * sc;
                        u32x4 w; w.x = pk2(v0[0], v0[1]); w.y = pk2(v0[2], v0[3]); w.z = pk2(v1[0], v1[1]); w.w = pk2(v1[2], v1[3]);
                        patch_store16(P, fr, fq, w, base + (size_t)(row0 - fr + ai * 128 + m * 16) * ld + (col - 8 * fq), ld); }
            } else if (sg == 18) {
                if (wc == 0) {
#pragma unroll
                    for (int ai = 0; ai < 2; ++ai)
#pragma unroll
                        for (int m = 0; m < 4; ++m) { const f32x4 v0 = acc[ai][bj][m][0], v1 = acc[ai][bj][m][1];
                            u32x4 w; w.x = pk2(v0[0], v0[1]); w.y = pk2(v0[2], v0[3]); w.z = pk2(v1[0], v1[1]); w.w = pk2(v1[2], v1[3]);
                            const size_t t = (size_t)(row0 + ai * 128 + m * 16);
                            *(u32x4*)(IK + (t >> 5) * 1024 + ((size_t)fq * 32 + (t & 31)) * 8) = w; }
                } else if (wc == 1 && fq == 0) {
#pragma unroll
                    for (int ai = 0; ai < 2; ++ai)
#pragma unroll
                        for (int m = 0; m < 4; ++m) *(f32x4*)(IW + (size_t)(row0 + ai * 128 + m * 16) * 4) = acc[ai][bj][m][0] * IW_SCALE;
                }
            }
        }
    }
};
struct EpiX1 {
    static constexpr bool PERM = false;
    const float* x; const float* mod; float* x1; LAS unsigned char* patch;
    __device__ __forceinline__ void operator()(const f32x4 (&acc)[2][2][4][2], const pg8::Unit& u, int wr, int wc, int fr, int fq) const {
        const int lane = fr + 16 * fq; const int b = (u.pm * 256) / SEQ;
        LAS unsigned char* P = patch + (wr * 4 + wc) * 2560;
        const int rr = lane >> 3, cc = lane & 7;
#pragma unroll
        for (int bj = 0; bj < 2; ++bj) {
            const int colb = u.pn * 256 + bj * 128 + wc * 32;
            const f32x4 gv = *(const f32x4*)(mod + b * 6144 + 2048 + colb + 4 * cc);
#pragma unroll
            for (int ai = 0; ai < 2; ++ai)
#pragma unroll
                for (int m = 0; m < 4; ++m) {
                    const size_t row0 = (size_t)(u.pm * 256 + wr * 64 + ai * 128 + m * 16);
                    const f32x4 xa = *(const f32x4*)(x + (row0 + rr) * DM + colb + 4 * cc), xb = *(const f32x4*)(x + (row0 + rr + 8) * DM + colb + 4 * cc);
                    *(LAS f32x4*)(P + fr * 144 + (4 * fq) * 4) = acc[ai][bj][m][0];
                    *(LAS f32x4*)(P + fr * 144 + (16 + 4 * fq) * 4) = acc[ai][bj][m][1];
                    const f32x4 va = *(const LAS f32x4*)(P + rr * 144 + cc * 16), vb = *(const LAS f32x4*)(P + (rr + 8) * 144 + cc * 16);
                    *(f32x4*)(x1 + (row0 + rr) * DM + colb + 4 * cc) = xa + gv * va;
                    *(f32x4*)(x1 + (row0 + rr + 8) * DM + colb + 4 * cc) = xb + gv * vb;
                }
        }
    }
};
struct EpiLogits {
    static constexpr bool PERM = false;
    float* LOG; const float* b_router; const float* b_group;
    __device__ __forceinline__ void operator()(const f32x4 (&acc)[2][2][4][2], const pg8::Unit& u, int wr, int wc, int fr, int fq) const {
        if (wc > 1) return;
        const int row0 = u.pm * 256 + wr * 64 + fr;
#pragma unroll
        for (int n = 0; n < 2; ++n) { const int col = wc * 32 + n * 16 + 4 * fq;
            if (col < 36) { const f32x4 bv = (col < 32) ? *(const f32x4*)(b_router + col) : *(const f32x4*)(b_group);
#pragma unroll
                for (int ai = 0; ai < 2; ++ai)
#pragma unroll
                    for (int m = 0; m < 4; ++m) *(f32x4*)(LOG + (size_t)(row0 + ai * 128 + m * 16) * 64 + col) = acc[ai][0][m][n] + bv; } }
    }
};
__device__ __forceinline__ float silu_f(float v) { return v * __builtin_amdgcn_rcpf(1.f + __expf(-v)); }
struct EpiUp {
    static constexpr bool PERM = true;
    bf16_t* HS; LAS unsigned char* patch;
    __device__ __forceinline__ void operator()(const f32x4 (&acc)[2][2][4][2], const pg8::Unit& u, int wr, int wc, int fr, int fq) const {
        const int row0 = u.pm * 256 + wr * 64 + fr; const int col = (u.pn & 1) * 128 + wc * 32 + 8 * fq; LAS unsigned char* P = patch + (wr * 4 + wc) * 2560;
#pragma unroll
        for (int ai = 0; ai < 2; ++ai)
#pragma unroll
            for (int m = 0; m < 4; ++m) { const f32x4 g0 = acc[ai][0][m][0], g1 = acc[ai][0][m][1], u0 = acc[ai][1][m][0], u1 = acc[ai][1][m][1];
                u32x4 w; w.x = pk2(silu_f(g0[0]) * u0[0], silu_f(g0[1]) * u0[1]); w.y = pk2(silu_f(g0[2]) * u0[2], silu_f(g0[3]) * u0[3]);
                w.z = pk2(silu_f(g1[0]) * u1[0], silu_f(g1[1]) * u1[1]); w.w = pk2(silu_f(g1[2]) * u1[2], silu_f(g1[3]) * u1[3]);
                patch_store16(P, fr, fq, w, HS + (size_t)(row0 - fr + ai * 128 + m * 16) * 256 + (col - 8 * fq), 256); }
    }
};
struct EpiDown {
    static constexpr bool PERM = true;
    bf16_t* YS; const float* GL; const LAS int* ecnt; LAS unsigned char* patch;
    __device__ __forceinline__ void operator()(const f32x4 (&acc)[2][2][4][2], const pg8::Unit& u, int wr, int wc, int fr, int fq) const {
        LAS unsigned char* P = patch + (wr * 4 + wc) * 2560;
        const int r0 = wr * 64 + fr; const int e = u.a0; const int cnt = ecnt[e];
        const int colb = (u.pn & 3) * 256 + wc * 32 + 8 * fq;
#pragma unroll
        for (int ai = 0; ai < 2; ++ai)
#pragma unroll
            for (int m = 0; m < 4; ++m) { const int r = r0 + ai * 128 + m * 16; int slot = u.a1 + r; slot = slot < cnt ? slot : cnt - 1;
                const float g = GL[(size_t)e * NT + slot];
#pragma unroll
                for (int bj = 0; bj < 2; ++bj) { const f32x4 v0 = acc[ai][bj][m][0] * g, v1 = acc[ai][bj][m][1] * g;
                    u32x4 w; w.x = pk2(v0[0], v0[1]); w.y = pk2(v0[2], v0[3]); w.z = pk2(v1[0], v1[1]); w.w = pk2(v1[2], v1[3]);
                    patch_store16(P, fr, fq, w, YS + (size_t)(u.pm * 256 + r - fr) * DM + (colb - 8 * fq) + bj * 128, DM); } }
    }
};

struct MoeTab { LAS int* ecnt; LAS int* toff; };
__device__ __forceinline__ MoeTab moe_tables(Frame& F) {
    MoeTab t; t.ecnt = (LAS int*)(F.lds + MISC_OFF + 128); t.toff = t.ecnt + 32;
    __syncthreads();
    if (F.tid < 32) t.ecnt[F.tid] = (int)__hip_atomic_load(F.ctl + CW_ECNT + 64 * F.tid, __ATOMIC_RELAXED, __HIP_MEMORY_SCOPE_AGENT);
    __syncthreads();
    if (F.tid == 0) { int s = 0; for (int e = 0; e < 32; ++e) { t.toff[e] = s; s += (t.ecnt[e] + 255) >> 8; } t.toff[32] = s; }
    __syncthreads();
    return t;
}
template <int NPN, bool GATHER> struct MoeOrder {
    MoeTab tab; int G, c, K; const int* TOK;
    __device__ bool next(int i, pg8::Unit& u) const {
        const long L = (long)i * G + c; const int total = tab.toff[32] * NPN; if (L >= total) return false;
        const int rt = (int)(L / NPN), pl = (int)(L % NPN);
        int e = 0;
#pragma unroll 1
        for (int j = 1; j < 32; ++j) e = (tab.toff[j] <= rt) ? j : e;
        u.pm = rt; u.pn = e * NPN + pl; u.a0 = e; u.a1 = (rt - tab.toff[e]) * 256; return true;
    }
    __device__ __forceinline__ unsigned a_off(const pg8::Unit& u, int R) const {
        if constexpr (GATHER) { const int cnt = tab.ecnt[u.a0]; int slot = u.a1 + R; slot = slot < cnt ? slot : cnt - 1; return (unsigned)TOK[(size_t)u.a0 * NT + slot] * (unsigned)(K * 2); }
        else return (unsigned)(u.pm * 256 + R) * (unsigned)(K * 2);
    }
};
__device__ __forceinline__ void route_panel(Frame& F, int pm) {
    LAS int* lc = (LAS int*)(F.lds);
    LAS int* lb = lc + 32;
    {
        const bool act = F.tid < 256; const int tok = pm * 256 + (act ? F.tid : 0);
        if (F.tid < 32) lc[F.tid] = 0;
        __syncthreads();
        const float* lg = F_LOG + (size_t)tok * 64;
        float gl[4];
        { const f32x4 v = *(const f32x4*)(lg + 32); gl[0] = v[0]; gl[1] = v[1]; gl[2] = v[2]; gl[3] = v[3]; }
        int gs = 0; float gm = gl[0];
#pragma unroll
        for (int j = 1; j < 4; ++j) if (gl[j] > gm) { gm = gl[j]; gs = j; }
        float den = 0.f;
#pragma unroll
        for (int j = 0; j < 4; ++j) den += __expf(gl[j] - gm);
        const float pg = 1.f / den;
        float el[8];
        { const f32x4 a = *(const f32x4*)(lg + gs * 8), b = *(const f32x4*)(lg + gs * 8 + 4); el[0] = a[0]; el[1] = a[1]; el[2] = a[2]; el[3] = a[3]; el[4] = b[0]; el[5] = b[1]; el[6] = b[2]; el[7] = b[3]; }
        int i0 = 0; float v0 = el[0];
#pragma unroll
        for (int j = 1; j < 8; ++j) if (el[j] > v0) { v0 = el[j]; i0 = j; }
        int i1 = -1; float v1 = -INFINITY;
#pragma unroll
        for (int j = 0; j < 8; ++j) if (j != i0 && (i1 < 0 || el[j] > v1)) { v1 = el[j]; i1 = j; }
        const float ex = __expf(v1 - v0); const float w0 = pg / (1.f + ex), w1 = w0 * ex;
        const int e0 = gs * 8 + i0, e1 = gs * 8 + i1;
        int r0 = 0, r1 = 0;
        if (act) { r0 = __hip_atomic_fetch_add(lc + e0, 1, __ATOMIC_RELAXED, __HIP_MEMORY_SCOPE_WORKGROUP); r1 = __hip_atomic_fetch_add(lc + e1, 1, __ATOMIC_RELAXED, __HIP_MEMORY_SCOPE_WORKGROUP); }
        __syncthreads();
        if (F.tid < 32) lb[F.tid] = (int)__hip_atomic_fetch_add(F.ctl + CW_ECNT + 64 * F.tid, (unsigned)lc[F.tid], __ATOMIC_RELAXED, __HIP_MEMORY_SCOPE_AGENT);
        __syncthreads();
        if (act) { const int s0 = lb[e0] + r0, s1 = lb[e1] + r1;
            F_TOK[(size_t)e0 * NT + s0] = tok; F_TOK[(size_t)e1 * NT + s1] = tok;
            F_GL[(size_t)e0 * NT + s0] = w0; F_GL[(size_t)e1 * NT + s1] = w1;
            *(int2*)(F_REID + (size_t)tok * 2) = make_int2(e0, e1);
            *(int2*)(F_RSLOT + (size_t)tok * 2) = make_int2(s0, s1); }
        __syncthreads();
    }
}
__device__ __forceinline__ void combine_rows(Frame& F, const MoeTab& tab) {
    const int gw = F.vcu * NWAVES + F.wave, NGW = F.G * NWAVES;
    constexpr int RPW = 32;
    for (int it = gw; it < NT / RPW; it += NGW) {
        const int m0 = it * RPW, b = m0 / SEQ;
        f32x4 GM[4], GF[4];
#pragma unroll
        for (int j = 0; j < 4; ++j) { GM[j] = *((const f32x4*)(F_mod + b * 6144 + 5120) + F.lane + 64 * j); GF[j] = *((const f32x4*)F_g_final + F.lane + 64 * j); }
        int2 ee = *(const int2*)(F_REID + (size_t)m0 * 2), ss = *(const int2*)(F_RSLOT + (size_t)m0 * 2);
        f32x4 xv[4]; u32x2 ya[4], yc[4];
        { const size_t p0 = (size_t)tab.toff[ee.x] * 256 + ss.x, p1 = (size_t)tab.toff[ee.y] * 256 + ss.y;
#pragma unroll
          for (int j = 0; j < 4; ++j) { xv[j] = *((const f32x4*)(F_out + (size_t)m0 * DM) + F.lane + 64 * j); ya[j] = *((const u32x2*)(F_YS + p0 * DM) + F.lane + 64 * j); yc[j] = *((const u32x2*)(F_YS + p1 * DM) + F.lane + 64 * j); } }
#pragma unroll 1
        for (int r = 0; r < RPW; ++r) {
            const size_t m = (size_t)m0 + r; const size_t mn = (r + 1 < RPW) ? m + 1 : m;
            const int2 een = *(const int2*)(F_REID + mn * 2), ssn = *(const int2*)(F_RSLOT + mn * 2);
            f32x4 v[4]; float s = 0.f;
#pragma unroll
            for (int j = 0; j < 4; ++j) { const u32x2 a = ya[j], c = yc[j];
                const f32x4 ys = {bflo(a.x) + bflo(c.x), bfhi(a.x) + bfhi(c.x), bflo(a.y) + bflo(c.y), bfhi(a.y) + bfhi(c.y)};
                v[j] = xv[j] + GM[j] * ys; s += (v[j].x * v[j].x + v[j].y * v[j].y) + (v[j].z * v[j].z + v[j].w * v[j].w); }
            { const size_t p0 = (size_t)tab.toff[een.x] * 256 + ssn.x, p1 = (size_t)tab.toff[een.y] * 256 + ssn.y;
#pragma unroll
              for (int j = 0; j < 4; ++j) { xv[j] = *((const f32x4*)(F_out + mn * DM) + F.lane + 64 * j); ya[j] = *((const u32x2*)(F_YS + p0 * DM) + F.lane + 64 * j); yc[j] = *((const u32x2*)(F_YS + p1 * DM) + F.lane + 64 * j); } }
            const float rstd = 1.f / sqrtf(wave_sum(s) * (1.f / DM) + RMS_EPS);
            f32x4* orow = (f32x4*)(F_out + m * DM) + F.lane;
#pragma unroll
            for (int j = 0; j < 4; ++j) orow[64 * j] = (v[j] * rstd) * GF[j];
        }
    }
}

constexpr float DIFF_SKIP_LOG2 = 150.f;
__device__ __forceinline__ int diff_tstart(int h, int qb) {
    const float slope2 = exp2f(-2.0f * (float)(h + 1)) * LOG2E;
    const float tmax = ((float)(128 * qb - 63) - DIFF_SKIP_LOG2 / slope2) * (1.f / 64.f);
    int t = (int)floorf(tmax) + 1; return t < 0 ? 0 : t;
}
__device__ __forceinline__ void knorm_rows(Frame& F) {
    const int gw = F.vcu * NWAVES + F.wave, NGW = F.G * NWAVES;
    float* KN2 = (float*)(F.ws + WS_KN2);
    for (int it = gw; it < NB * 128; it += NGW) {
        const int b = it >> 7, tile = it & 127;
        const u32x4* rp = (const u32x4*)(F_FK + ((size_t)(b * SEQ + tile * 64)) * 512) + F.lane;
        float mx = 0.f;
#pragma unroll 4
        for (int r = 0; r < 64; ++r) { const u32x4 v = rp[(size_t)r * 64];
            float s = bflo(v.x) * bflo(v.x) + bfhi(v.x) * bfhi(v.x); s += bflo(v.y) * bflo(v.y) + bfhi(v.y) * bfhi(v.y); s += bflo(v.z) * bflo(v.z) + bfhi(v.z) * bfhi(v.z); s += bflo(v.w) * bflo(v.w) + bfhi(v.w) * bfhi(v.w);
            s += __shfl_xor(s, 1); s += __shfl_xor(s, 2); s += __shfl_xor(s, 4);
            mx = fmaxf(mx, s); }
        if ((F.lane & 7) == 0) { const int hs = F.lane >> 3; KN2[((size_t)(b * 8 + hs)) * 128 + tile] = mx; }
    }
}
__device__ __forceinline__ void diff_unit(Frame& F, int b, int h, int qb, float lam, float lam_init) {
    int tid = F.tid; asm volatile("" : "+v"(tid));
    const int lane = tid & 63, wave = F.wave;
    const int r32 = lane & 31, hi = lane >> 5;
    const int st = wave >> 2, wq = wave & 3;
    const int q0 = qb * 128, nt = 2 * qb + 2;
    const int t0 = diff_tstart(h, qb);
    const float slope2 = exp2f(-2.0f * (float)(h + 1)) * LOG2E;
    LAS unsigned char* L = F.lds;
    const int qpos = q0 + 32 * wq + r32;
    bf16x8 qf[4];
    { const bf16_t* qp = F_FQ + ((size_t)(b * SEQ + qpos) * 512 + h * 128 + st * 64 + hi * 8);
#pragma unroll
      for (int s = 0; s < 4; ++s) qf[s] = *(const bf16x8*)(qp + 16 * s); }
    float mref;
    { float qs = 0.f;
#pragma unroll
      for (int s = 0; s < 4; ++s)
#pragma unroll
          for (int j = 0; j < 8; ++j) { const float v = bf2f((unsigned short)qf[s][j]); qs += v * v; }
      qs += __shfl_xor(qs, 32);
      const float* kn = (const float*)(F.ws + WS_KN2) + ((size_t)(b * 8 + h * 2 + st)) * 128;
      float km = 0.f;
      for (int t = t0 + lane; t < nt; t += 64) km = fmaxf(km, kn[t]);
#pragma unroll
      for (int o = 1; o < 64; o <<= 1) km = fmaxf(km, __shfl_xor(km, o));
      mref = sqrtf(qs) * sqrtf(km); }
    const int srow = 4 * wave + (lane >> 4), sslot = lane & 15;
    const unsigned schunk = (unsigned)sslot ^ ((((unsigned)srow & 3u) << 2) | (((unsigned)srow >> 2) & 3u));
    const size_t gk = ((size_t)(b * SEQ) * 512 + h * 128) + (size_t)srow * 512 + schunk * 8;
    const unsigned ldsb = (unsigned)(uintptr_t)(L + wave * 1024);
#define DIFF_GLDS(gp, ldsoff) do { unsigned keep_; asm volatile("s_mov_b32 %0, m0\n\ts_mov_b32 m0, %2\n\ts_nop 0\n\tglobal_load_lds_dwordx4 %1, off\n\ts_mov_b32 m0, %0" : "=&s"(keep_) : "v"(gp), "s"((unsigned)__builtin_amdgcn_readfirstlane(ldsb + (ldsoff))) : "memory"); } while (0)
#define DIFF_STAGE(t, bo) do { const size_t go = gk + (size_t)(t) * 64 * 512; \
        DIFF_GLDS(F_FK + go, (bo)); DIFF_GLDS(F_FK + go + 32 * 512, (bo) + 8192); DIFF_GLDS(F_FV + go, 49152 + (bo)); DIFF_GLDS(F_FV + go + 32 * 512, 49152 + (bo) + 8192); } while (0)
    const unsigned kswz = ((unsigned)(r32 & 3) << 2) | ((unsigned)(r32 >> 2) & 3u);
    unsigned koff[4];
#pragma unroll
    for (int s = 0; s < 4; ++s) koff[s] = 256u * r32 + 16u * (((unsigned)(8 * st + 2 * s + hi)) ^ kswz);
    const int qq = (lane & 15) >> 2, pp = lane & 3, blk = (lane >> 4) & 1;
    unsigned vo[2][4];
#pragma unroll
    for (int tt = 0; tt < 2; ++tt)
#pragma unroll
        for (int cb = 0; cb < 4; ++cb) vo[tt][cb] = 256u * (unsigned)(8 * tt + 4 * hi + qq) + 16u * (((unsigned)(4 * cb + 2 * blk + (pp >> 1))) ^ (((unsigned)qq << 2) | ((unsigned)(2 * tt + hi) & 3u))) + 8u * (unsigned)(pp & 1);
    int b0 = 0, b1 = 16384, b2 = 32768;
    DIFF_STAGE(t0, b0); DIFF_STAGE(t0 + 1, b1);
    asm volatile("s_waitcnt vmcnt(0)" ::: "memory");
    __syncthreads();
    float lrow = 0.f;
    f32x16 o[4];
#pragma unroll
    for (int cb = 0; cb < 4; ++cb)
#pragma unroll
        for (int r = 0; r < 16; ++r) o[cb][r] = 0.f;
    f32x16 p[2];
#define DIFF_KFR(dst, Kb_, kh_) do { _Pragma("unroll") for (int s = 0; s < 4; ++s) dst[s] = *(const LAS bf16x8*)((Kb_) + (kh_) * 8192 + koff[s]); } while (0)
#define DIFF_QKH(dst, kf_, t_, kh_) do { const float cbias = slope2 * (float)(64 * (t_) + 32 * (kh_) + 4 * hi - qpos) - mref; f32x16 c; \
        _Pragma("unroll") for (int r = 0; r < 16; ++r) c[r] = fmaf(slope2, (float)((r & 3) + 8 * (r >> 2)), cbias); \
        _Pragma("unroll") for (int s = 0; s < 4; ++s) c = MFMA32(kf_[s], qf[s], c); dst = c; } while (0)
#define DIFF_VFR(dst, cb_) do { _Pragma("unroll") for (int ks = 0; ks < 4; ++ks) { const s16x4 v0_ = tr_read((const LAS char*)(Vb + vo[0][cb_] + 4096 * ks)); const s16x4 v1_ = tr_read((const LAS char*)(Vb + vo[1][cb_] + 4096 * ks)); dst[ks] = cat8(v0_, v1_); } } while (0)
    { bf16x8 ka[4], kb_[4]; DIFF_KFR(ka, L + b0, 0); DIFF_KFR(kb_, L + b0, 1); DIFF_QKH(p[0], ka, t0, 0); DIFF_QKH(p[1], kb_, t0, 1); }
#pragma unroll 1
    for (int t = t0; t < nt; ++t) {
        const bool more = (t + 1 < nt);
        if (t + 2 < nt) DIFF_STAGE(t + 2, b2);
        const LAS unsigned char* Kn = L + b1;
        const LAS unsigned char* Vb = L + 49152 + b0;
        bf16x8 kfa[4], kfb[4], vfa[4], vfb[4];
        DIFF_VFR(vfa, 0);
        if (more) { DIFF_KFR(kfa, Kn, 0); DIFF_KFR(kfb, Kn, 1); }
        __builtin_amdgcn_sched_barrier(0);
        if (t >= nt - 2) {
#pragma unroll
            for (int kh = 0; kh < 2; ++kh)
#pragma unroll
                for (int r = 0; r < 16; ++r) { const int kpos = 64 * t + 32 * kh + crow(r, hi); if (kpos > qpos) p[kh][r] = -INFINITY; }
        }
        float ps = 0.f;
#pragma unroll
        for (int kh = 0; kh < 2; ++kh)
#pragma unroll
            for (int r = 0; r < 16; ++r) { const float e = __builtin_amdgcn_exp2f(p[kh][r]); p[kh][r] = e; ps += e; }
        lrow += ps;
        bf16x8 pa[4];
#pragma unroll
        for (int ks = 0; ks < 4; ++ks) { const int kh = ks >> 1, r0 = (ks & 1) * 8;
            u32x4 w; w.x = pk2(p[kh][r0], p[kh][r0 + 1]); w.y = pk2(p[kh][r0 + 2], p[kh][r0 + 3]); w.z = pk2(p[kh][r0 + 4], p[kh][r0 + 5]); w.w = pk2(p[kh][r0 + 6], p[kh][r0 + 7]);
            pa[ks] = __builtin_bit_cast(bf16x8, w); }
        __builtin_amdgcn_sched_barrier(0);
        DIFF_VFR(vfb, 1);
        __builtin_amdgcn_sched_barrier(0);
#pragma unroll
        for (int ks = 0; ks < 4; ++ks) o[0] = MFMA32(vfa[ks], pa[ks], o[0]);
        __builtin_amdgcn_sched_barrier(0);
        DIFF_VFR(vfa, 2);
        __builtin_amdgcn_sched_barrier(0);
#pragma unroll
        for (int ks = 0; ks < 4; ++ks) o[1] = MFMA32(vfb[ks], pa[ks], o[1]);
        __builtin_amdgcn_sched_barrier(0);
        DIFF_VFR(vfb, 3);
        __builtin_amdgcn_sched_barrier(0);
#pragma unroll
        for (int ks = 0; ks < 4; ++ks) o[2] = MFMA32(vfa[ks], pa[ks], o[2]);
        if (more) { DIFF_QKH(p[0], kfa, t + 1, 0); }
#pragma unroll
        for (int ks = 0; ks < 4; ++ks) o[3] = MFMA32(vfb[ks], pa[ks], o[3]);
        if (more) { DIFF_QKH(p[1], kfb, t + 1, 1); }
        asm volatile("s_waitcnt vmcnt(0)" ::: "memory");
        __syncthreads();
        { const int tb_ = b0; b0 = b1; b1 = b2; b2 = tb_; }
    }
#undef DIFF_VFR
#undef DIFF_KFR
#undef DIFF_QKH
#undef DIFF_STAGE
#undef DIFF_GLDS
    lrow += __shfl_xor(lrow, 32);
    const float rl = 1.f / lrow;
    LAS float* X = (LAS float*)L;
    if (st == 1) {
#pragma unroll
        for (int cb = 0; cb < 4; ++cb)
#pragma unroll
            for (int r = 0; r < 16; ++r) X[(wq * 64 + cb * 16 + r) * 64 + lane] = o[cb][r] * rl;
    }
    __syncthreads();
    if (st == 0) {
        float ss = 0.f;
#pragma unroll
        for (int cb = 0; cb < 4; ++cb)
#pragma unroll
            for (int r = 0; r < 16; ++r) { const float d = o[cb][r] * rl - lam * X[(wq * 64 + cb * 16 + r) * 64 + lane]; o[cb][r] = d; ss += d * d; }
        ss += __shfl_xor(ss, 32);
        const float rstd = (1.f - lam_init) / sqrtf(ss * (1.f / 128.f) + RMS_EPS);
        bf16_t* orow = F_O + (size_t)(b * SEQ + qpos) * DM + 512 + h * 128;
#pragma unroll
        for (int cb = 0; cb < 4; ++cb)
#pragma unroll
            for (int r4 = 0; r4 < 4; ++r4) { const int c0 = 32 * cb + 8 * r4 + 4 * hi;
                const f32x4 gg = *(const f32x4*)(F_g_sub + c0);
                u32x2 w; w.x = pk2(o[cb][4 * r4] * rstd * gg[0], o[cb][4 * r4 + 1] * rstd * gg[1]); w.y = pk2(o[cb][4 * r4 + 2] * rstd * gg[2], o[cb][4 * r4 + 3] * rstd * gg[3]);
                *(u32x2*)(orow + c0) = w; }
    }
    __syncthreads();
}
__device__ __forceinline__ int wq_next(Frame& F, int qid) {
    LAS int* slot = (LAS int*)(F.lds + MISC_OFF + 96);
    __syncthreads();
    if (F.tid == 0) *slot = (int)__hip_atomic_fetch_add(F.ctl + CW_WQ + 64 * qid, 1u, __ATOMIC_RELAXED, __HIP_MEMORY_SCOPE_AGENT);
    __syncthreads();
    return *slot;
}
__device__ __forceinline__ void diff_phase(Frame& F) {
    if (F.G != 256) return;
    const float lam_init = 0.8f - 0.6f * 1.0f;
    float a = F_lq1[F.lane] * F_lk1[F.lane], c = F_lq2[F.lane] * F_lk2[F.lane];
    a = wave_sum(a); c = wave_sum(c);
    const float lam = __expf(a) - __expf(c) + lam_init;
    const int b = F.vcu >> 5;
    LAS int* cost = (LAS int*)(F.lds + 147456);
    LAS int* order = cost + 256;
    __syncthreads();
    if (F.tid < 256) { const int h = F.tid >> 6, qb = F.tid & 63; cost[F.tid] = (2 * qb + 2 - diff_tstart(h, qb)) + 4; }
    __syncthreads();
    if (F.tid < 256) { const int cm = cost[F.tid]; int rank = 0;
        for (int j = 0; j < 256; ++j) { const int cj = cost[j]; rank += (cj > cm || (cj == cm && j < F.tid)) ? 1 : 0; }
        order[rank] = F.tid; }
    __syncthreads();
#pragma unroll 1
    for (;;) { const int u = wq_next(F, 2 * b); if (u >= 256) break;
        const int id = order[u];
        diff_unit(F, b, id >> 6, id & 63, lam, lam_init); }
}

constexpr int DSA_NBIN = 1024;
constexpr int DSA_POOLCAP = 16384;
constexpr int DSA_SEL_OFF = 131072, DSA_SM_OFF = 147456, DSA_GI_OFF = 65536;
constexpr float DSA_SCALE2 = 0.125f * LOG2E;

__device__ __forceinline__ unsigned off_c(unsigned row, unsigned ch) { return 256u * row + 16u * (ch ^ (((row & 7u) << 1) | ((row >> 2) & 1u))); }
__device__ __forceinline__ unsigned f32_sortable(float f) { const unsigned u = __builtin_bit_cast(unsigned, f); return u ^ ((u >> 31) ? 0xffffffffu : 0x80000000u); }

__device__ __forceinline__ float relu_raw(float v) { int i = __builtin_bit_cast(int, v); i = i > 0 ? i : 0; return __builtin_bit_cast(float, i); }
typedef short s16x2_t __attribute__((ext_vector_type(2)));
template <int PASS>
__device__ __forceinline__ void dsa_pass(Frame& F, int b, int q0, const bf16x8 (&qf)[4][2], const float (&w)[4], int lane, int grp) {
    const int r32 = lane & 31, hi = lane >> 5;
    LAS unsigned* hist = (LAS unsigned*)F.lds;
    LAS unsigned long long* pool = (LAS unsigned long long*)F.lds;
    LAS unsigned short* sel = (LAS unsigned short*)(F.lds + DSA_SEL_OFF);
    LAS int* sm = (LAS int*)(F.lds + DSA_SM_OFF);
    const int qpos = q0 + r32;
    const int nkb = (q0 >> 5) + 1;
    int tb = 0, po = 0;
    if (PASS == 2) { tb = (sm[200 + r32] == grp) ? sm[r32] : 0x7fffffff; po = sm[96 + r32]; }
    LAS unsigned* hq = hist + r32 * DSA_NBIN;
    const bf16_t* kbase = F_IK + ((size_t)(b * (SEQ / 32)) * 1024 + lane * 8);
    bf16x8 n0 = {0, 0, 0, 0, 0, 0, 0, 0}, n1 = n0;
    if (F.wave < nkb) { const bf16_t* kp = kbase + (size_t)F.wave * 1024; n0 = *(const bf16x8*)kp; n1 = *(const bf16x8*)(kp + 512); }
#pragma unroll 1
    for (int kb = F.wave; kb < nkb; kb += NWAVES) {
        const bf16x8 a0 = n0, a1 = n1;
        if (kb + NWAVES < nkb) { const bf16_t* kp = kbase + (size_t)(kb + NWAVES) * 1024; n0 = *(const bf16x8*)kp; n1 = *(const bf16x8*)(kp + 512); }
        f32x16 sc;
#pragma unroll
        for (int r = 0; r < 16; ++r) sc[r] = 0.f;
#pragma unroll
        for (int h = 0; h < 4; ++h) {
            f32x16 acc;
#pragma unroll
            for (int r = 0; r < 16; ++r) acc[r] = 0.f;
            acc = MFMA32(a0, qf[h][0], acc); acc = MFMA32(a1, qf[h][1], acc);
#pragma unroll
            for (int r = 0; r < 16; ++r) sc[r] = fmaf(relu_raw(acc[r]), w[h], sc[r]);
            if (h == 1) __builtin_amdgcn_sched_barrier(0);
        }
        const bool diag = (kb == nkb - 1);
        const int lim = diag ? qpos - 32 * kb : 64;
        int bin[16];
#pragma unroll
        for (int r = 0; r < 16; r += 2) { const int pk = __builtin_bit_cast(int, __builtin_amdgcn_cvt_pknorm_i16(sc[r], sc[r + 1])); bin[r] = (((int)((unsigned)pk << 16)) >> 22) + 512; bin[r + 1] = (pk >> 22) + 512; }
        if (PASS == 1) {
            if (!diag) {
#pragma unroll
                for (int r = 0; r < 16; ++r) (void)__hip_atomic_fetch_add(hq + bin[r], 1u, __ATOMIC_RELAXED, __HIP_MEMORY_SCOPE_WORKGROUP);
            } else {
#pragma unroll
                for (int r = 0; r < 16; ++r) (void)__hip_atomic_fetch_add(hq + bin[r], (crow(r, hi) <= lim) ? 1u : 0u, __ATOMIC_RELAXED, __HIP_MEMORY_SCOPE_WORKGROUP);
            }
        } else {
            unsigned abm = 0u, eqm = 0u;
#pragma unroll
            for (int r = 0; r < 16; ++r) { const bool ok = crow(r, hi) <= lim; abm |= (ok && bin[r] > tb) ? (1u << r) : 0u; eqm |= (ok && bin[r] == tb) ? (1u << r) : 0u; }
            const unsigned basew = __hip_atomic_fetch_add((LAS unsigned*)(sm + 128) + r32, (unsigned)__builtin_popcount(abm) | ((unsigned)__builtin_popcount(eqm) << 16), __ATOMIC_RELAXED, __HIP_MEMORY_SCOPE_WORKGROUP);
            int sa = r32 * 256 + (int)(basew & 0xffffu), sc2 = po + (int)(basew >> 16);
            const int kb0 = 32 * kb + 4 * hi;
            while (abm) { const int r = __builtin_ctz(abm); abm &= abm - 1u; sel[sa] = (unsigned short)(kb0 + (r & 3) + 8 * (r >> 2)); ++sa; }
            while (eqm) { const int r = __builtin_ctz(eqm); eqm &= eqm - 1u;
                float v = sc[0];
#pragma unroll
                for (int j = 1; j < 16; ++j) v = (r == j) ? sc[j] : v;
                if (sc2 < DSA_POOLCAP) pool[sc2] = ((unsigned long long)f32_sortable(v + 0.f) << 16) | (unsigned long long)(0xffffu - (unsigned)(kb0 + (r & 3) + 8 * (r >> 2))); ++sc2; }
        }
    }
}

template <int NR>
__device__ __forceinline__ void dsa_resolve(const LAS unsigned long long* pq, int c, int r, LAS unsigned short* selq, int lane) {
    unsigned long long kk[NR];
#pragma unroll
    for (int i = 0; i < NR; ++i) { const int idx = 64 * i + lane; const bool in = idx < c; kk[i] = in ? pq[in ? idx : 0] : 0ull; }
    unsigned long long P = 0ull;
    if (c > r) {
        constexpr unsigned long long ZMIN = 0x80000000ull << 16, ZMAX = ZMIN | 0xffffull;
        int ngt = 0, nge = 0;
#pragma unroll
        for (int i = 0; i < NR; ++i) { ngt += __builtin_popcountll(__ballot(kk[i] > ZMAX)); nge += __builtin_popcountll(__ballot(kk[i] >= ZMIN)); }
        int bit = 47;
        if (ngt < r && r <= nge) { P = ZMIN | 0xe000ull; bit = 12; }
#pragma unroll 1
        for (; bit >= 0; --bit) {
            const unsigned long long trial = P | (1ull << bit);
            int cnt = 0;
#pragma unroll
            for (int i = 0; i < NR; ++i) cnt += __builtin_popcountll(__ballot(kk[i] >= trial));
            if (cnt >= r) { P = trial; if (cnt == r) break; }
        }
    }
    int outp = 0;
#pragma unroll
    for (int i = 0; i < NR; ++i) { const bool take = (64 * i + lane < c) && kk[i] >= P; const unsigned long long bal = __ballot(take);
        const int pos = outp + __builtin_popcountll(bal & ((1ull << lane) - 1ull));
        if (take && pos < r) selq[pos] = (unsigned short)(0xffffu - (unsigned)(kk[i] & 0xffffull));
        outp += __builtin_popcountll(bal); }
}

__device__ __forceinline__ void dsa_topk(Frame& F, int b, int qt) {
    int lane = F.lane; asm volatile("" : "+v"(lane));
    const int r32 = lane & 31, hi = lane >> 5, wave = F.wave;
    const int q0 = qt * 32;
    LAS unsigned* hist = (LAS unsigned*)F.lds;
    LAS unsigned long long* pool = (LAS unsigned long long*)F.lds;
    LAS unsigned short* sel = (LAS unsigned short*)(F.lds + DSA_SEL_OFF);
    LAS int* sm = (LAS int*)(F.lds + DSA_SM_OFF);
    if (q0 + 32 <= 256) {
        for (int i = F.tid; i < 32 * 256; i += NTHREADS) { const int q = i >> 8, j = i & 255; sel[i] = (j <= q0 + q) ? (unsigned short)j : (unsigned short)0xffffu; }
        __syncthreads();
        return;
    }

    bf16x8 qf[4][2]; float w[4];
    { const bf16_t* qp = F_IQ + ((size_t)(b * SEQ + q0 + r32) * 128 + hi * 8);
#pragma unroll
      for (int h = 0; h < 4; ++h) { qf[h][0] = *(const bf16x8*)(qp + h * 32); qf[h][1] = *(const bf16x8*)(qp + h * 32 + 16);
      }
      const f32x4 wv = *(const f32x4*)(F_IW + (size_t)(b * SEQ + q0 + r32) * 4);
      const float wm = fmaxf(fmaxf(fabsf(wv[0]), fabsf(wv[1])), fmaxf(fabsf(wv[2]), fabsf(wv[3]))); int ex = 0; (void)frexpf(wm, &ex);
      const float wsc = (wm > 0.f) ? ldexpf(1.f, -ex - 6) : 1.f;
      w[0] = wv[0] * wsc; w[1] = wv[1] * wsc; w[2] = wv[2] * wsc; w[3] = wv[3] * wsc; }
    for (int i = F.tid; i < 32 * DSA_NBIN / 4; i += NTHREADS) ((LAS u32x4*)hist)[i] = (u32x4){0u, 0u, 0u, 0u};
    for (int i = F.tid; i < 32 * 256 / 8; i += NTHREADS) ((LAS u32x4*)sel)[i] = (u32x4){0xffffffffu, 0xffffffffu, 0xffffffffu, 0xffffffffu};
    if (F.tid < 65) sm[128 + F.tid] = 0;
    __syncthreads();


    dsa_pass<1>(F, b, q0, qf, w, lane, 0);
    __syncthreads();


#pragma unroll 1
    for (int qi = 0; qi < 4; ++qi) {
        const int q = 4 * wave + qi;
        unsigned hv[16];
#pragma unroll
        for (int j4 = 0; j4 < 4; ++j4) { const u32x4 v = *(const LAS u32x4*)(hist + q * DSA_NBIN + 16 * lane + 4 * j4); hv[4 * j4] = v.x; hv[4 * j4 + 1] = v.y; hv[4 * j4 + 2] = v.z; hv[4 * j4 + 3] = v.w; }
        unsigned lsum = 0;
#pragma unroll
        for (int j = 0; j < 16; ++j) lsum += hv[j];
        unsigned incl = lsum;
#pragma unroll
        for (int o = 1; o < 64; o <<= 1) { const unsigned v = __shfl_down(incl, o); incl += (lane + o < 64) ? v : 0u; }
        const unsigned excl = incl - lsum;
        if (excl < 256u && incl >= 256u) {
            unsigned run = excl; int tbin = 0; unsigned nab = 0, cc = 0; bool found = false;
#pragma unroll
            for (int j = 15; j >= 0; --j) { if (!found) { if (run + hv[j] >= 256u) { found = true; tbin = 16 * lane + j; nab = run; cc = hv[j]; } else run += hv[j]; } }
            sm[q] = tbin; sm[32 + q] = (int)nab; sm[64 + q] = (int)cc;
        }
    }
    __syncthreads();
    if (F.tid == 0) {
        int off = 0, g = 0;
        for (int q = 0; q < 32; ++q) { const int c = sm[64 + q]; if (off + c > DSA_POOLCAP) { ++g; off = 0; } sm[96 + q] = off; sm[200 + q] = g; off += c; }
        sm[232] = g + 1;
    }
    __syncthreads();
    const int ngrp = __builtin_amdgcn_readfirstlane(sm[232]);

#pragma unroll 1
    for (int grp = 0; grp < ngrp; ++grp) {
    dsa_pass<2>(F, b, q0, qf, w, lane, grp);
    __syncthreads();

#pragma unroll 1
    for (int qi = 0; qi < 4; ++qi) {
        const int q = 4 * wave + qi;
        if (__builtin_amdgcn_readfirstlane(sm[200 + q]) != grp) continue;
        const int base = __builtin_amdgcn_readfirstlane(sm[96 + q]); int c = __builtin_amdgcn_readfirstlane(sm[64 + q]);
        const int nab = __builtin_amdgcn_readfirstlane(sm[32 + q]); const int r = 256 - nab;
        if (base + c > DSA_POOLCAP) c = (DSA_POOLCAP - base) > 0 ? (DSA_POOLCAP - base) : 0;
        LAS unsigned short* selq = sel + q * 256 + nab;
        const LAS unsigned long long* pq = pool + base;
        if (c <= 64) dsa_resolve<1>(pq, c, r, selq, lane);
        else if (c <= 128) dsa_resolve<2>(pq, c, r, selq, lane);
        else if (c <= 256) dsa_resolve<4>(pq, c, r, selq, lane);
        else if (c <= 512) dsa_resolve<8>(pq, c, r, selq, lane);
        else if (c <= 1024) dsa_resolve<16>(pq, c, r, selq, lane);
        else {
#define DSA_COUNT_GE(out_, thr_) do { int cnt_ = 0; _Pragma("unroll 4") for (int i0 = 0; i0 < c; i0 += 64) { const int i = i0 + lane; const unsigned long long v_ = pq[i < c ? i : 0]; cnt_ += __builtin_popcountll(__ballot((i < c) && v_ >= (thr_))); } out_ = cnt_; } while (0)
            constexpr unsigned long long ZMIN = 0x80000000ull << 16, ZMAX = ZMIN | 0xffffull;
            unsigned long long P = 0ull;
            if (c > r) {
                int ngt, nge; DSA_COUNT_GE(ngt, ZMAX + 1ull); DSA_COUNT_GE(nge, ZMIN);
                int bit = 47;
                if (ngt < r && r <= nge) { P = ZMIN | 0xe000ull; bit = 12; }
#pragma unroll 1
                for (; bit >= 0; --bit) {
                    const unsigned long long trial = P | (1ull << bit);
                    int cnt; DSA_COUNT_GE(cnt, trial);
                    if (cnt >= r) { P = trial; if (cnt == r) break; }
                }
            }
#undef DSA_COUNT_GE
            int outp = 0;
#pragma unroll 2
            for (int i0 = 0; i0 < c; i0 += 64) { const int i = i0 + lane; const unsigned long long v = pq[i < c ? i : 0]; const bool take = (i < c) && v >= P;
                const unsigned long long bal = __ballot(take); const int pos = outp + __builtin_popcountll(bal & ((1ull << lane) - 1ull));
                if (take && pos < r) selq[pos] = (unsigned short)(0xffffu - (unsigned)(v & 0xffffull));
                outp += __builtin_popcountll(bal); }
        }
    }
    __syncthreads();
    }

}

__device__ __forceinline__ void dsa_chunk(const bf16x8 (&af)[2][4], const bf16x8 (&bq)[4], f32x4 (&o)[8], float& lrow, LAS unsigned char* GI, LAS unsigned short* sel,
                                          int q, int qpos, int ch, int g, float slope2, float cq, unsigned wrA0, unsigned trA0, unsigned gwr) {
    asm volatile("" : "+v"(wrA0), "+v"(trA0));
    unsigned short kk[2][4];
#pragma unroll
    for (int rb = 0; rb < 2; ++rb) { const u32x2 v = *(const LAS u32x2*)(sel + q * 256 + 32 * ch + 16 * rb + 4 * g); kk[rb][0] = (unsigned short)(v.x & 0xffffu); kk[rb][1] = (unsigned short)(v.x >> 16); kk[rb][2] = (unsigned short)(v.y & 0xffffu); kk[rb][3] = (unsigned short)(v.y >> 16); }
#pragma unroll
    for (int j = 0; j < 8; ++j) *(LAS bf16x8*)(GI + (gwr ^ ((j & 1) ? 144u : 0u)) + 1024 * j) = af[j >> 2][j & 3];
    f32x4 sacc[2];
    { bf16x8 ar[2][4];
#pragma unroll
      for (int rb = 0; rb < 2; ++rb)
#pragma unroll
          for (int s = 0; s < 4; ++s) ar[rb][s] = *(const LAS bf16x8*)(GI + (wrA0 ^ (unsigned)(s << 6)) + 4096 * rb);
#pragma unroll
      for (int rb = 0; rb < 2; ++rb) { sacc[rb] = (f32x4){0.f, 0.f, 0.f, 0.f};
#pragma unroll
          for (int s = 0; s < 4; ++s) sacc[rb] = MFMA16(ar[rb][s], bq[s], sacc[rb]); } }
    float ps = 0.f; float pv[8];
#pragma unroll
    for (int rb = 0; rb < 2; ++rb)
#pragma unroll
        for (int i = 0; i < 4; ++i) { const unsigned key = kk[rb][i]; const bool ok = (key != 0xffffu) && ((int)key <= qpos);
            const float v = fmaf(sacc[rb][i], DSA_SCALE2, fmaf(-slope2, (float)(qpos - (int)key), cq));
            const float e = ok ? __builtin_amdgcn_exp2f(v) : 0.f; pv[4 * rb + i] = e; ps += e; }
    lrow += ps;
    u32x4 pw; pw.x = pk2(pv[0], pv[1]); pw.y = pk2(pv[2], pv[3]); pw.z = pk2(pv[4], pv[5]); pw.w = pk2(pv[6], pv[7]);
    const bf16x8 bp = __builtin_bit_cast(bf16x8, pw);
#pragma unroll
    for (int c4 = 0; c4 < 2; ++c4) {
        bf16x8 vf[4];
#pragma unroll
        for (int i = 0; i < 4; ++i) { const unsigned ta = trA0 ^ (unsigned)((4 * c4 + i) << 5);
            const s16x4 v0 = tr_read((const LAS char*)(GI + ta)); const s16x4 v1 = tr_read((const LAS char*)(GI + ta + 4096)); vf[i] = cat8(v0, v1); }
        __builtin_amdgcn_sched_barrier(0);
#pragma unroll
        for (int i = 0; i < 4; ++i) o[4 * c4 + i] = MFMA16(vf[i], bp, o[4 * c4 + i]);
        __builtin_amdgcn_sched_barrier(0);
    }
}

__device__ __forceinline__ void dsa_attend(Frame& F, int b, int qt, float kvmax) {
    int lane = F.lane; asm volatile("" : "+v"(lane));
    const int r32 = lane & 31, hi = lane >> 5, wave = F.wave;
    const int q0 = qt * 32; const size_t t0 = (size_t)b * SEQ + q0;
    LAS unsigned char* QA = F.lds;
    LAS unsigned char* GI = F.lds + DSA_GI_OFF + wave * 8192;
    LAS unsigned short* sel = (LAS unsigned short*)(F.lds + DSA_SEL_OFF);

    LAS float* QN2 = (LAS float*)(F.lds + DSA_SM_OFF + 1024);
    { const int h = wave; float qs = 0.f;
      bf16x8 bq[4];
      { const bf16_t* qp = F_DQ + ((t0 + r32) * 512 + h * 64 + hi * 8);
#pragma unroll
        for (int s = 0; s < 4; ++s) bq[s] = *(const bf16x8*)(qp + 16 * s); }
      bf16x8 wf[4][4];
#pragma unroll
      for (int cb = 0; cb < 4; ++cb) { const bf16_t* wp = F_Wuk + ((size_t)((h * 4 + cb) * 4) * 64 + lane) * 8;
#pragma unroll
          for (int s = 0; s < 4; ++s) wf[cb][s] = *(const bf16x8*)(wp + 512 * s); }
      __builtin_amdgcn_sched_barrier(0);
#pragma unroll
      for (int cb = 0; cb < 4; ++cb) {
          f32x16 acc;
#pragma unroll
          for (int r = 0; r < 16; ++r) acc[r] = 0.f;
#pragma unroll
          for (int s = 0; s < 4; ++s) acc = MFMA32(wf[cb][s], bq[s], acc);
#pragma unroll
          for (int r4 = 0; r4 < 4; ++r4) { u32x2 wv; wv.x = pk2(acc[4 * r4], acc[4 * r4 + 1]); wv.y = pk2(acc[4 * r4 + 2], acc[4 * r4 + 3]);
              qs += bflo(wv.x) * bflo(wv.x) + bfhi(wv.x) * bfhi(wv.x) + bflo(wv.y) * bflo(wv.y) + bfhi(wv.y) * bfhi(wv.y);
              *(LAS u32x2*)(QA + ((r32 * 8 + h) * 128 + 32 * cb + 8 * r4 + 4 * hi) * 2) = wv; }
      }
      qs += __shfl_xor(qs, 32);
      if (hi == 0) QN2[r32 * 8 + h] = qs; }
    __syncthreads();

    const int n = lane & 15, g = lane >> 4;
    const float slope2 = exp2f(-(float)((n & 7) + 1)) * LOG2E;
    const int qq = n >> 2, pp = n & 3;
    const unsigned gwr = off_c((unsigned)(lane >> 4), (unsigned)(lane & 15));
    const unsigned wrA0 = off_c(n, g), trA0 = off_c(4u * g + qq, (unsigned)(pp >> 1)) + 8u * (pp & 1);
    const bf16_t* ckvb = F_CKV + (size_t)b * SEQ * 128 + 8 * g;
    const int grow = lane >> 4, gch = lane & 15;
    const bf16_t* ckvg = F_CKV + (size_t)b * SEQ * 128 + 8 * gch;
#define DSA_GATHER(dst, q_, ch_) do { _Pragma("unroll") for (int j = 0; j < 8; ++j) { unsigned key = sel[(q_) * 256 + 32 * (ch_) + 4 * j + grow]; key = key == 0xffffu ? 0u : key; \
        dst[j >> 2][j & 3] = *(const bf16x8*)(ckvg + (size_t)key * 128); } } while (0)
    bf16x8 afA[2][4], afB[2][4];
    DSA_GATHER(afA, 4 * wave, 0);
#pragma unroll 1
    for (int qi = 0; qi < 4; ++qi) {
        const int q = 4 * wave + qi; const int qpos = q0 + q;
        bf16x8 bq[4];
#pragma unroll
        for (int s = 0; s < 4; ++s) { bf16x8 v = *(const LAS bf16x8*)(QA + ((q * 8 + (n & 7)) * 128 + 32 * s + 8 * g) * 2); if (n >= 8) v = (bf16x8){0, 0, 0, 0, 0, 0, 0, 0}; bq[s] = v; }
        float lrow = 0.f;
        f32x4 o[8];
#pragma unroll
        for (int cb = 0; cb < 8; ++cb) o[cb] = (f32x4){0.f, 0.f, 0.f, 0.f};
        float cq;
        { const u32x2 kv4 = *(const LAS u32x2*)(sel + q * 256 + 4 * lane); int km = -1;
          { const int k0 = (int)(kv4.x & 0xffffu), k1 = (int)(kv4.x >> 16), k2 = (int)(kv4.y & 0xffffu), k3 = (int)(kv4.y >> 16);
            km = (k0 != 0xffff && k0 > km) ? k0 : km; km = (k1 != 0xffff && k1 > km) ? k1 : km; km = (k2 != 0xffff && k2 > km) ? k2 : km; km = (k3 != 0xffff && k3 > km) ? k3 : km; }
#pragma unroll
          for (int o_ = 1; o_ < 64; o_ <<= 1) { const int t = __shfl_xor(km, o_); km = t > km ? t : km; }
          const float bound = sqrtf(QN2[q * 8 + (n & 7)]) * kvmax * DSA_SCALE2;
          cq = slope2 * (float)(qpos - km) - bound; }
#pragma unroll 1
        for (int ch2 = 0; ch2 < 4; ++ch2) {
            DSA_GATHER(afB, q, 2 * ch2 + 1);
            dsa_chunk(afA, bq, o, lrow, GI, sel, q, qpos, 2 * ch2, g, slope2, cq, wrA0, trA0, gwr);
            { const int nq_ = (ch2 < 3) ? q : ((qi < 3) ? q + 1 : q), nc_ = (ch2 < 3) ? 2 * ch2 + 2 : 0; DSA_GATHER(afA, nq_, nc_); }
            dsa_chunk(afB, bq, o, lrow, GI, sel, q, qpos, 2 * ch2 + 1, g, slope2, cq, wrA0, trA0, gwr);
        }
        lrow += __shfl_xor(lrow, 16); lrow += __shfl_xor(lrow, 32);
        const float rl = 1.f / lrow;
        if (n < 8) {
#pragma unroll
            for (int cb = 0; cb < 8; ++cb) { u32x2 wv; wv.x = pk2(o[cb][0] * rl, o[cb][1] * rl); wv.y = pk2(o[cb][2] * rl, o[cb][3] * rl);
                *(LAS u32x2*)(QA + ((q * 8 + n) * 128 + 16 * cb + 4 * g) * 2) = wv; }
        }
    }
#undef DSA_GATHER
    __syncthreads();

    { const int h = wave;
      bf16x8 bo[8];
#pragma unroll
      for (int s = 0; s < 8; ++s) bo[s] = *(const LAS bf16x8*)(QA + ((r32 * 8 + h) * 128 + 16 * s + 8 * hi) * 2);
      bf16x8 wo[2][8];
#pragma unroll
      for (int db = 0; db < 2; ++db) { const bf16_t* wp = F_WuvT + ((size_t)((h * 2 + db) * 8) * 64 + lane) * 8;
#pragma unroll
          for (int s = 0; s < 8; ++s) wo[db][s] = *(const bf16x8*)(wp + 512 * s); }
      __builtin_amdgcn_sched_barrier(0);
#pragma unroll
      for (int db = 0; db < 2; ++db) {
          f32x16 acc;
#pragma unroll
          for (int r = 0; r < 16; ++r) acc[r] = 0.f;
#pragma unroll
          for (int s = 0; s < 8; ++s) acc = MFMA32(wo[db][s], bo[s], acc);
          bf16_t* op = F_O + (t0 + r32) * DM + h * 64 + 32 * db + 4 * hi;
#pragma unroll
          for (int r4 = 0; r4 < 4; ++r4) { u32x2 wv; wv.x = pk2(acc[4 * r4], acc[4 * r4 + 1]); wv.y = pk2(acc[4 * r4 + 2], acc[4 * r4 + 3]);
              *(u32x2*)(op + 8 * r4) = wv; }
      } }
    __syncthreads();

}
__device__ __forceinline__ void dsa_unit(Frame& F, int b, int qt, float kvmax) {
    dsa_topk(F, b, qt);
    dsa_attend(F, b, qt, kvmax);
}
__device__ __forceinline__ void dsa_phase(Frame& F) {
    if (F.G != 256) return;
    const int b = F.vcu >> 5;
    float gm = fmaxf(fabsf(F_g_kv[F.lane]), fabsf(F_g_kv[F.lane + 64]));
#pragma unroll
    for (int o = 1; o < 64; o <<= 1) gm = fmaxf(gm, __shfl_xor(gm, o));
    const float kvmax = 11.313708499f * gm * 1.01f;
#pragma unroll 1
    for (;;) { const int u = wq_next(F, 2 * b + 1); if (u >= 256) break; dsa_unit(F, b, 255 - u, kvmax); }
}

constexpr int N_PHASES = 12;
__global__ void __launch_bounds__(NTHREADS, 2) fwd_kernel(Args args) {
    extern __shared__ __attribute__((aligned(16))) unsigned char lds[];
    Frame F;
    F.lds = (LAS unsigned char*)lds;
    F.MISC = (volatile LAS unsigned*)(F.lds + MISC_OFF);
    F.tid = threadIdx.x; F.lane = F.tid & 63; F.wave = __builtin_amdgcn_readfirstlane(F.tid >> 6);
    F.G = gridDim.x; { const int bx = blockIdx.x; F.vcu = (F.G % 8 == 0) ? (bx % 8) * (F.G / 8) + bx / 8 : bx; }
    F.a = &args; F.ws = args.ws; F.ctl = (unsigned*)(args.ws + WS_CTL);
    for (int u = F.tid; u < (LDS_BYTES - MISC_OFF) / 4; u += NTHREADS) ((LAS unsigned*)(F.lds + MISC_OFF))[u] = 0u;
    __syncthreads();
    XcdBarrier bar; bar.bar = (unsigned*)(F.ctl + CW_BAR); bar.x = 0; bar.st = nullptr;
    if (!MK_SPLIT) bar = xcd_barrier_post((unsigned*)(F.ctl + CW_BAR), F.MISC + 8);
    const int lo = args.ph_lo, hi = args.ph_hi;
#define IN(k) (lo <= (k) && (k) < hi)
#define RUN(k, ...) do { if (IN(k)) { __VA_ARGS__; } } while (0)
#define SEAM(k) do { if (IN(k) && (IN((k) + 1) || ((k) == 7 && IN(9)))) xcd_barrier(bar); } while (0)


    RUN(0, p0_mod(F); __syncthreads(); p0_weights(F));
    SEAM(0);
    RUN(1, modnorm_rows(F, F_x, F_g_attn, 0, 1024, F_XN));
    SEAM(1);
    RUN(2, pg8::StaticOrder S; S.init(NT, NPROJ, DM, F.G, (int)blockIdx.x); EpiProj E{F_DQ, F_FQ, F_FK, F_FV, F_DLAT, F_IQ, F_IK, F_IW, F.lds + 131072}; pg8::gemm_phase<EpiProj, pg8::StaticOrder, true>(F.lds, F_XN, F_Win, DM, S, E));
    SEAM(2);
    RUN(3, ckv_rows(F); knorm_rows(F));
    SEAM(3);
    RUN(4, diff_phase(F); dsa_phase(F));
    SEAM(4);
    RUN(5, pg8::StaticOrder S; S.init(NT, DM, DM, F.G, (int)blockIdx.x); EpiX1 E{F_x, F_mod, F_out, F.lds + 131072}; pg8::gemm_phase<EpiX1, pg8::StaticOrder, true>(F.lds, F_O, F_Wout, DM, S, E));
    SEAM(5);
    RUN(6, modnorm_rows(F, F_out, F_g_moe, 3072, 4096, F_XN));
    SEAM(6);
    RUN(7, pg8::StaticOrder S; S.init(NT, 256, DM, F.G, (int)blockIdx.x); EpiLogits E{F_LOG, F_b_router, F_b_group}; pg8::gemm_phase<EpiLogits, pg8::StaticOrder, false>(F.lds, F_XN, F_Wrt, DM, S, E);
        VM_WAIT(); __syncthreads(); { pg8::Unit u; for (int i = 0; S.next(i, u); ++i) route_panel(F, u.pm); });
    SEAM(7);
    RUN(9, const MoeTab tab = moe_tables(F); MoeOrder<2, true> S{tab, F.G, (int)blockIdx.x, DM, F_TOK}; EpiUp E{F_HS, F.lds + 131072}; pg8::gemm_phase<EpiUp, MoeOrder<2, true>, true>(F.lds, F_XN, F_Wup, DM, S, E));
    SEAM(9);
    RUN(10, const MoeTab tab = moe_tables(F); MoeOrder<4, false> S{tab, F.G, (int)blockIdx.x, DEXP, F_TOK}; EpiDown E{F_YS, F_GL, tab.ecnt, F.lds + 131072}; pg8::gemm_phase<EpiDown, MoeOrder<4, false>, true>(F.lds, F_HS, F_Wdn, DEXP, S, E));
    SEAM(10);
    RUN(11, const MoeTab tab = moe_tables(F); combine_rows(F, tab));
#undef IN
#undef SEAM
}

extern "C" void kernel_launch(void* const* d_in, const int* in_sizes, int n_in, void* d_out, int out_size, void* d_ws, size_t ws_size, hipStream_t stream) {
    static int grid = 0;
    if (grid == 0) {
        if (n_in != 24 || in_sizes[0] != NT * DM || out_size != NT * DM || ws_size < WS_END) { fprintf(stderr, "kernel_launch: unexpected problem (n_in %d, in0 %d, out %d, ws %zu)\n", n_in, n_in > 0 ? in_sizes[0] : -1, out_size, ws_size); grid = -1; return; }
        int dev = 0, cus = 0, per_cu = 0;
        if (hipGetDevice(&dev) != hipSuccess || hipDeviceGetAttribute(&cus, hipDeviceAttributeMultiprocessorCount, dev) != hipSuccess) { grid = -1; return; }
        if (hipFuncSetAttribute((const void*)fwd_kernel, hipFuncAttributeMaxDynamicSharedMemorySize, LDS_BYTES) != hipSuccess) { fprintf(stderr, "kernel_launch: hipFuncSetAttribute failed\n"); grid = -1; return; }
        if (hipOccupancyMaxActiveBlocksPerMultiprocessor(&per_cu, (const void*)fwd_kernel, NTHREADS, LDS_BYTES) != hipSuccess || per_cu < 1) { fprintf(stderr, "kernel_launch: occupancy query reports %d\n", per_cu); }
        (void)hipGetLastError();
        grid = cus;
    }
    if (grid < 0) return;
    if (hipMemsetAsync((char*)d_ws + WS_CTL, 0, CTL_ZERO_BYTES, stream) != hipSuccess) return;
    Args a{};
    for (int i = 0; i < 24; ++i) a.in[i] = (const float*)d_in[i];
    a.out = (float*)d_out; a.ws = (unsigned char*)d_ws;
#if MK_SPLIT
    for (int p = 0; p < N_PHASES; ++p) { a.ph_lo = p; a.ph_hi = p + 1; hipLaunchKernelGGL(fwd_kernel, dim3(grid), dim3(NTHREADS), LDS_BYTES, stream, a); }
#else
    a.ph_lo = 0; a.ph_hi = N_PHASES;
    hipLaunchKernelGGL(fwd_kernel, dim3(grid), dim3(NTHREADS), LDS_BYTES, stream, a);
#endif
}
```
